# Optimizing an MI355X kernel written in HIP

```python
import jax, jax.numpy as jnp
from jax import lax
import numpy as np

D_MODEL = 1024
BATCH = 16
SEQ = 2048
DEPTH = 2

HEAD_DIM = 64
N_FOX_HEADS = 6
N_RET_HEADS = 6
N_SB_HEADS = 4
N_HEADS = N_FOX_HEADS + N_RET_HEADS + N_SB_HEADS
D_MIX = N_HEADS * HEAD_DIM
D_FOX = N_FOX_HEADS * HEAD_DIM
D_RET = N_RET_HEADS * HEAD_DIM
D_SB = N_SB_HEADS * HEAD_DIM
D_IN = 4 * D_MIX + N_FOX_HEADS
Q_BLOCK = 128
RET_CHUNK = 128
ROPE_BASE = 10000.0
LN_EPS = 1e-5
GN_EPS = 1e-5
DEEPNORM_ALPHA = (2 * DEPTH) ** 0.25
DEEPNORM_BETA = (8 * DEPTH) ** -0.25
FGATE_BIAS_MEAN = 3.0

kernel_name = 'hybrid_fox_retnet_stickbreaking'


def _layernorm(x, gain, bias):
    xf = x.astype(jnp.float32)
    mu = jnp.mean(xf, axis=-1, keepdims=True)
    var = jnp.mean(jnp.square(xf - mu), axis=-1, keepdims=True)
    return ((xf - mu) * lax.rsqrt(var + LN_EPS) * gain + bias).astype(x.dtype)


def _rotary(t, pos):
    half = t.shape[-1] // 2
    inv_freq = 1.0 / (ROPE_BASE ** (jnp.arange(half, dtype=jnp.float32) / half))
    ang = pos[:, None] * inv_freq[None, :]
    cos, sin = jnp.cos(ang), jnp.sin(ang)
    t1, t2 = t[..., :half], t[..., half:]
    return jnp.concatenate([t1 * cos - t2 * sin, t1 * sin + t2 * cos], axis=-1)


def _to_blocks(t, n_blocks, block):
    B, H = t.shape[0], t.shape[1]
    t = t.reshape((B, H, n_blocks, block) + t.shape[3:])
    return jnp.moveaxis(t, 2, 0)


def _from_blocks(o):
    nb, B, H, blk, d = o.shape
    return o.transpose(1, 0, 3, 2, 4).reshape(B, nb * blk, H * d)


def _fox_attention(q, k, v, c):
    B, H, S, d = q.shape
    nb = S // Q_BLOCK
    scale = d ** -0.5
    k_pos = jnp.arange(S)

    def block(args):
        qi, ci, i = args
        q_pos = i * Q_BLOCK + jnp.arange(Q_BLOCK)
        s = jnp.einsum('bhqd,bhkd->bhqk', qi, k).astype(jnp.float32) * scale
        s = s + ci[..., None] - c[:, :, None, :]
        s = jnp.where(k_pos[None, :] <= q_pos[:, None], s, -jnp.inf)
        p = jax.nn.softmax(s, axis=-1)
        return jnp.einsum('bhqk,bhkd->bhqd', p.astype(v.dtype), v)

    o = lax.map(block, (_to_blocks(q, nb, Q_BLOCK), _to_blocks(c, nb, Q_BLOCK), jnp.arange(nb)))
    return _from_blocks(o)


def _stick_breaking(q, k, v):
    B, H, S, d = q.shape
    nb = S // Q_BLOCK
    scale = d ** -0.5
    k_pos = jnp.arange(S)

    def block(args):
        qi, i = args
        q_pos = i * Q_BLOCK + jnp.arange(Q_BLOCK)
        z = jnp.einsum('bhqd,bhkd->bhqk', qi, k).astype(jnp.float32) * scale
        strict = k_pos[None, :] < q_pos[:, None]
        log_rem = jnp.where(strict, jax.nn.log_sigmoid(-z), 0.0)
        tail = lax.cumsum(log_rem, axis=3, reverse=True) - log_rem
        log_a = jax.nn.log_sigmoid(z) + tail
        a = jnp.where(strict, jnp.exp(log_a), 0.0)
        return jnp.einsum('bhqk,bhkd->bhqd', a.astype(v.dtype), v)

    o = lax.map(block, (_to_blocks(q, nb, Q_BLOCK), jnp.arange(nb)))
    return _from_blocks(o)


def _retention(q, k, v, gn_gain):
    B, H, S, d = q.shape
    C = RET_CHUNK
    nc = S // C
    pos = jnp.arange(S, dtype=jnp.float32)
    q = _rotary(q, pos)
    k = _rotary(k, pos) * (d ** -0.5)
    log_g = jnp.log(1.0 - 2.0 ** (-5.0 - jnp.arange(H, dtype=jnp.float32)))
    idx = jnp.arange(C, dtype=jnp.float32)
    diff = idx[:, None] - idx[None, :]
    intra_decay = jnp.where(diff >= 0, jnp.exp(jnp.maximum(diff, 0.0)[None] * log_g[:, None, None]), 0.0)
    query_decay = jnp.exp((idx[None, :] + 1.0) * log_g[:, None])
    key_decay = jnp.exp((C - 1.0 - idx[None, :]) * log_g[:, None])
    chunk_decay = jnp.exp(C * log_g)

    def step(state, inp):
        qc, kc, vc = inp
        scores = jnp.einsum('bhnd,bhmd->bhnm', qc, kc) * intra_decay
        o = jnp.einsum('bhnm,bhmv->bhnv', scores, vc)
        o = o + jnp.einsum('bhnd,bhdv->bhnv', qc, state) * query_decay[:, :, None]
        new_state = chunk_decay[:, None, None] * state + jnp.einsum(
            'bhmd,bhmv->bhdv', kc * key_decay[:, :, None], vc)
        return new_state, o

    state0 = jnp.zeros((B, H, d, d), jnp.float32)
    _, o = lax.scan(step, state0, (_to_blocks(q, nc, C), _to_blocks(k, nc, C), _to_blocks(v, nc, C)))
    o = o.transpose(1, 0, 3, 2, 4)
    o = o.reshape(B, S, H, d)
    mu = jnp.mean(o, axis=-1, keepdims=True)
    var = jnp.mean(jnp.square(o - mu), axis=-1, keepdims=True)
    o = (o - mu) * lax.rsqrt(var + GN_EPS) * gn_gain.astype(jnp.float32).reshape(H, d)
    return o.reshape(B, S, H * d)


def _hybrid_layer(x, w_in, b_fgate, gn_gain, w_out, ln_gain, ln_bias):
    B, S, _ = x.shape
    proj = jnp.einsum('bsd,de->bse', x, w_in)
    q = proj[..., :D_MIX]
    k = proj[..., D_MIX:2 * D_MIX]
    v = proj[..., 2 * D_MIX:3 * D_MIX]
    gate = proj[..., 3 * D_MIX:4 * D_MIX]
    f_logit = (proj[..., 4 * D_MIX:] + b_fgate).astype(jnp.float32)

    def heads(t):
        return t.reshape(B, S, N_HEADS, HEAD_DIM).transpose(0, 2, 1, 3)

    q, k, v = heads(q), heads(k), heads(v)
    f0, f1 = 0, N_FOX_HEADS
    r0, r1 = N_FOX_HEADS, N_FOX_HEADS + N_RET_HEADS

    c = lax.cumsum(jax.nn.log_sigmoid(f_logit), axis=1).transpose(0, 2, 1)
    o_fox = _fox_attention(q[:, f0:f1], k[:, f0:f1], v[:, f0:f1], c)
    o_ret = _retention(q[:, r0:r1].astype(jnp.float32), k[:, r0:r1].astype(jnp.float32),
                       v[:, r0:r1].astype(jnp.float32), gn_gain).astype(x.dtype)
    o_sb = _stick_breaking(q[:, r1:], k[:, r1:], v[:, r1:])

    y = jnp.concatenate([o_fox.astype(x.dtype), o_ret, o_sb.astype(x.dtype)], axis=-1) * jax.nn.silu(gate)
    out = jnp.einsum('bse,ed->bsd', y, w_out)
    return _layernorm(DEEPNORM_ALPHA * x + out, ln_gain, ln_bias)


def setup_inputs(seed: int = 0) -> dict:
    key = jax.random.key(seed)
    ks = jax.random.split(key, 10)
    std_in = D_MODEL ** -0.5
    x = jax.random.normal(ks[0], (BATCH, SEQ, D_MODEL), jnp.float32)
    w_qk = jax.random.normal(ks[1], (DEPTH, D_MODEL, 2 * D_MIX), jnp.float32) * std_in
    w_v = jax.random.normal(ks[2], (DEPTH, D_MODEL, D_MIX), jnp.float32) * (std_in * DEEPNORM_BETA)
    w_g = jax.random.normal(ks[3], (DEPTH, D_MODEL, D_MIX), jnp.float32) * std_in
    w_f = jax.random.normal(ks[4], (DEPTH, D_MODEL, N_FOX_HEADS), jnp.float32) * std_in
    w_in = jnp.concatenate([w_qk, w_v, w_g, w_f], axis=-1)
    b_fgate = FGATE_BIAS_MEAN + jax.random.normal(ks[5], (DEPTH, N_FOX_HEADS), jnp.float32)
    ret_gn_gain = 1.0 + 0.02 * jax.random.normal(ks[6], (DEPTH, D_RET), jnp.float32)
    w_out = jax.random.normal(ks[7], (DEPTH, D_MIX, D_MODEL), jnp.float32) * (D_MIX ** -0.5 * DEEPNORM_BETA)
    ln_gain = 1.0 + 0.02 * jax.random.normal(ks[8], (DEPTH, D_MODEL), jnp.float32)
    ln_bias = 0.02 * jax.random.normal(ks[9], (DEPTH, D_MODEL), jnp.float32)
    return {'x': x, 'w_in': w_in, 'b_fgate': b_fgate, 'ret_gn_gain': ret_gn_gain,
            'w_out': w_out, 'ln_gain': ln_gain, 'ln_bias': ln_bias}


def reference(x, w_in, b_fgate, ret_gn_gain, w_out, ln_gain, ln_bias):
    for layer in range(DEPTH):
        x = _hybrid_layer(x, w_in[layer], b_fgate[layer], ret_gn_gain[layer],
                          w_out[layer], ln_gain[layer], ln_bias[layer])
    return x
```

```cpp
#include <hip/hip_runtime.h>
#include <hip/hip_cooperative_groups.h>
#include <cstdio>
#include <cstdint>
#include <cmath>
namespace cg = cooperative_groups;
namespace pg8 {
#define PG8_LAS __attribute__((address_space(3)))
typedef unsigned short bf16_t;
typedef short bf16x8 __attribute__((ext_vector_type(8)));
typedef float f32x4 __attribute__((ext_vector_type(4)));
typedef unsigned u32x4 __attribute__((ext_vector_type(4)));
constexpr int BM = 256, BK = 64, HALF = 128, HTB = HALF * BK * 2  , STAGE_BYTES = 8 * HTB, NXCD = 8, WGM = 8;

__host__ __device__ __forceinline__ int lds_byte(int r, int c) { const int st = (r >> 4) * 2 + (c >> 5), rr = r & 15, cc = c & 31, ob = rr * 64 + cc * 2; return st * 1024 + (ob ^ (((ob >> 9) & 1) << 5)); }
__host__ __device__ __forceinline__ void stage_rc(int b, int& R, int& C) { const int st = b / 1024, sb = b % 1024, swz = sb ^ (((sb >> 9) & 1) << 5); R = (st >> 1) * 16 + swz / 64; C = (st & 1) * 32 + (swz % 64) / 2; }
__host__ __device__ __forceinline__ int perm32(int rho) { const int n = rho >> 4, i = rho & 15; return 8 * (i >> 2) + 4 * n + (i & 3); }

struct Unit { int pm, pn; };
struct Gemm { const bf16_t* A; const bf16_t* Bt; int M, N, K; };

struct StaticOrder {
    int nM, nN, nwg, G, c;
    __host__ __device__ void init(int M, int N, int G_, int c_) { nM = M / BM; nN = N / BM; nwg = nM * nN; G = G_; c = c_; }
    __host__ __device__ bool next(int i, Unit& u) const {
        const long L = (long)i * G + c; if (L >= nwg) return false;
        int wgid = (int)L; { const int q = nwg / NXCD, r = nwg % NXCD, xcd = wgid % NXCD, off = wgid / NXCD; wgid = (xcd < r ? xcd * (q + 1) : r * (q + 1) + (xcd - r) * q) + off; }
        const int nig = WGM * nN, gid = wgid / nig, fm = gid * WGM, gsz = (nM - fm) < WGM ? (nM - fm) : WGM;
        u.pm = fm + ((wgid % nig) % gsz); u.pn = (wgid % nig) / gsz; return true;
    }
    __device__ __forceinline__ void a_ready(const Unit&) const {}
    __device__ __forceinline__ void done(const Unit&) const {}
};

__device__ __forceinline__ unsigned cvt_pk_bf16(float lo, float hi) { unsigned r; asm volatile("v_cvt_pk_bf16_f32 %0, %1, %2" : "=v"(r) : "v"(lo), "v"(hi)); return r; }
typedef float f32x2 __attribute__((ext_vector_type(2)));
__device__ __forceinline__ f32x2 gelu_pk(f32x2 v) {
    const f32x2 av = __builtin_elementwise_abs(v), d = av * 0.2316418882f + 1.0f;
    f32x2 t; t.x = __builtin_amdgcn_rcpf(d.x); t.y = __builtin_amdgcn_rcpf(d.y);
    f32x2 q = t * 0.5307027145f + (-0.7265760135f); q = q * t + 0.7107068705f; q = q * t + (-0.142248368f); q = q * t + 0.127414796f; q = q * t;
    const f32x2 s = (v * v) * (-0.72134752044f);
    f32x2 e; e.x = __builtin_amdgcn_exp2f(s.x); e.y = __builtin_amdgcn_exp2f(s.y);
    const f32x2 m = v * (q * e), r = v - m;
    f32x2 o; o.x = v.x < 0.f ? m.x : r.x; o.y = v.y < 0.f ? m.y : r.y; return o;
}

template <int ACT  > struct EpiBf16 {
    static constexpr bool PERM = true, AFTER_DRAIN = false; static_assert(ACT == 0 || ACT == 1, "EpiBf16: ACT is 0 (none) or 1 (gelu_pk)");
    bf16_t* O; int ldc; const float* bias; int split_cols; size_t split_stride; float scale0;
    __device__ __forceinline__ void operator()(const f32x4 (&acc)[2][2][4][2], const Unit& u, int wr, int wc, int fr, int fq) const {
        const int row0 = u.pm * BM + wr * 64 + fr; int colt = u.pn * BM; bf16_t* base = O;
        float sc = 1.f; if (split_cols) { const int t = colt / split_cols; base += (size_t)t * split_stride; colt -= t * split_cols; if (t == 0) sc = scale0; }
        const int col0 = colt + wc * 32 + 8 * fq, bcol0 = u.pn * BM + wc * 32 + 8 * fq;
        f32x4 bv[2][2];
#pragma unroll
        for (int bj = 0; bj < 2; ++bj)
#pragma unroll
            for (int n = 0; n < 2; ++n) bv[bj][n] = bias ? *(const f32x4*)(bias + bcol0 + bj * HALF + 4 * n) : (f32x4){0.f, 0.f, 0.f, 0.f};
#pragma unroll
        for (int ai = 0; ai < 2; ++ai)
#pragma unroll
            for (int m = 0; m < 4; ++m) { bf16_t* rowp = base + (size_t)(row0 + ai * HALF + m * 16) * ldc + col0;
#pragma unroll
                for (int bj = 0; bj < 2; ++bj) { f32x4 v0 = acc[ai][bj][m][0] + bv[bj][0], v1 = acc[ai][bj][m][1] + bv[bj][1];
                    if (ACT == 1) { f32x2 a = gelu_pk((f32x2){v0[0], v0[1]}), b = gelu_pk((f32x2){v0[2], v0[3]}), c = gelu_pk((f32x2){v1[0], v1[1]}), d = gelu_pk((f32x2){v1[2], v1[3]});
                        v0 = (f32x4){a.x, a.y, b.x, b.y}; v1 = (f32x4){c.x, c.y, d.x, d.y}; }
                    v0 = v0 * sc; v1 = v1 * sc; u32x4 w; w.x = cvt_pk_bf16(v0[0], v0[1]); w.y = cvt_pk_bf16(v0[2], v0[3]); w.z = cvt_pk_bf16(v1[0], v1[1]); w.w = cvt_pk_bf16(v1[2], v1[3]);
                    *(u32x4*)(rowp + bj * HALF) = w; } }
    }
};
struct EpiResid {
    static constexpr bool PERM = true, AFTER_DRAIN = false;
    const float* res; float* out; int ldc; float alpha;
    __device__ __forceinline__ void operator()(const f32x4 (&acc)[2][2][4][2], const Unit& u, int wr, int wc, int fr, int fq) const {
        const int row0 = u.pm * BM + wr * 64 + fr; const int col0 = u.pn * BM + wc * 32 + 8 * fq;
#pragma unroll
        for (int ai = 0; ai < 2; ++ai)
#pragma unroll
            for (int m = 0; m < 4; ++m) { const size_t ro = (size_t)(row0 + ai * HALF + m * 16) * ldc + col0;
#pragma unroll
                for (int bj = 0; bj < 2; ++bj) {
                    const f32x4 r0 = *(const f32x4*)(res + ro + bj * HALF), r1 = *(const f32x4*)(res + ro + bj * HALF + 4);
                    const f32x4 v0 = acc[ai][bj][m][0] + r0 * alpha, v1 = acc[ai][bj][m][1] + r1 * alpha;
                    *(f32x4*)(out + ro + bj * HALF) = v0; *(f32x4*)(out + ro + bj * HALF + 4) = v1; } }
    }
};
struct EpiInProj {
    static constexpr bool PERM = true, AFTER_DRAIN = false;
    bf16_t* O; const float* rope;
    __device__ __forceinline__ void operator()(const f32x4 (&acc)[2][2][4][2], const Unit& u, int wr, int wc, int fr, int fq) const {
        const int row0 = u.pm * BM + wr * 64 + fr;
#pragma unroll
        for (int bj = 0; bj < 2; ++bj) {
            const int colg = u.pn * BM + bj * HALF + wc * 32, col0 = colg + 8 * fq, head = colg >> 6;
            const bool isrot = (head >= 6 && head < 12) || (head >= 22 && head < 28);
            const float sc = head >= 16 ? 0.125f : 1.f;
            const int i0 = ((colg & 63) + 8 * fq) >> 1;
#pragma unroll
            for (int ai = 0; ai < 2; ++ai)
#pragma unroll
                for (int m = 0; m < 4; ++m) {
                    const int row = row0 + ai * HALF + m * 16;
                    f32x4 v0 = acc[ai][bj][m][0], v1 = acc[ai][bj][m][1];
                    if (isrot) {
                        const int pos = row & 2047;
                        const f32x4 c = *(const f32x4*)(rope + pos * 32 + i0), s = *(const f32x4*)(rope + 2048 * 32 + pos * 32 + i0);
                        f32x4 w0, w1;
                        w0[0] = (v0[0] * c[0] - v0[1] * s[0]) * sc; w0[1] = (v0[0] * s[0] + v0[1] * c[0]) * sc;
                        w0[2] = (v0[2] * c[1] - v0[3] * s[1]) * sc; w0[3] = (v0[2] * s[1] + v0[3] * c[1]) * sc;
                        w1[0] = (v1[0] * c[2] - v1[1] * s[2]) * sc; w1[1] = (v1[0] * s[2] + v1[1] * c[2]) * sc;
                        w1[2] = (v1[2] * c[3] - v1[3] * s[3]) * sc; w1[3] = (v1[2] * s[3] + v1[3] * c[3]) * sc;
                        v0 = w0; v1 = w1;
                    }
                    u32x4 w; w.x = cvt_pk_bf16(v0[0], v0[1]); w.y = cvt_pk_bf16(v0[2], v0[3]); w.z = cvt_pk_bf16(v1[0], v1[1]); w.w = cvt_pk_bf16(v1[2], v1[3]);
                    *(u32x4*)(O + (size_t)row * 4096 + col0) = w;
                }
        }
    }
};
template <class Epi, class Sched, bool ALIGN_EPI = false, bool SP2 = false>
__device__ __forceinline__ void gemm_phase(PG8_LAS unsigned char* lds, const Gemm g, const Sched& S, const Epi& E) {
    const int tid = threadIdx.x, wid = __builtin_amdgcn_readfirstlane(tid >> 6), lane = tid & 63, wr = wid >> 2, wc = wid & 3, fr = lane & 15, fq = lane >> 4;
    const int K = g.K, nt = K / BK;
    unsigned voffA[2], voffB[2];
#pragma unroll
    for (int i = 0; i < 2; ++i) { int R, C; stage_rc(tid * 16 + i * 8192, R, C); const int Rb = Epi::PERM ? ((R & ~31) + perm32(R & 31)) : R;
        voffA[i] = (unsigned)(R * K + C) * 2u; voffB[i] = (unsigned)(Rb * K + C) * 2u; }
    const size_t kstep = (size_t)(BK * 2);
    const size_t hstep = (size_t)HALF * K * 2;
    const size_t tstep = 2 * hstep;
    const unsigned ldsw = (unsigned)wid * 1024u;
    const int aoff = lds_byte(wr * 64 + fr, fq * 8), boff = lds_byte(wc * 32 + fr, fq * 8);
#define PG8_SA(b, h) (((b) * 2 + (h)) * HTB)
#define PG8_SB(b, h) ((4 + (b) * 2 + (h)) * HTB)
#define PG8_STAGE(bufoff, gbase, voff) do { _Pragma("unroll") for (int _i = 0; _i < 2; ++_i) \
        __builtin_amdgcn_global_load_lds((const unsigned*)((const char*)(gbase) + (voff)[_i]), (PG8_LAS unsigned*)(lds + (bufoff) + ldsw + _i * 8192), 16, 0, 0); } while (0)
#define PG8_LDA(dst, b, h) do { _Pragma("unroll") for (int m = 0; m < 4; ++m) _Pragma("unroll") for (int k = 0; k < 2; ++k) dst[m][k] = *(const PG8_LAS bf16x8*)(lds + PG8_SA(b, h) + aoff + m * 2048 + k * 1024); } while (0)
#define PG8_LDB(dst, b, h) do { _Pragma("unroll") for (int n = 0; n < 2; ++n) _Pragma("unroll") for (int k = 0; k < 2; ++k) dst[n][k] = *(const PG8_LAS bf16x8*)(lds + PG8_SB(b, h) + boff + n * 2048 + k * 1024); } while (0)
#define PG8_MMA(ai, bj, At, Bt) do { __builtin_amdgcn_s_setprio(1); _Pragma("unroll") for (int m = 0; m < 4; ++m) _Pragma("unroll") for (int n = 0; n < 2; ++n) _Pragma("unroll") for (int k = 0; k < 2; ++k) \
        acc[ai][bj][m][n] = __builtin_amdgcn_mfma_f32_16x16x32_bf16(Bt[n][k], At[m][k], acc[ai][bj][m][n], 0, 0, 0); __builtin_amdgcn_s_setprio(0); } while (0)
#define PG8_WAIT_V(n) asm volatile("s_waitcnt vmcnt(" #n ")" ::: "memory")
#define PG8_WAIT_L(n) asm volatile("s_waitcnt lgkmcnt(" #n ")" ::: "memory")
#define PG8_BAR __builtin_amdgcn_s_barrier()
#define PG8_SCHED __builtin_amdgcn_sched_barrier(0)
    Unit cur, nxt; int ui = 0;
    if (!S.next(0, cur)) return;
    f32x4 acc[2][2][4][2];
#pragma unroll
    for (int a = 0; a < 2; ++a)
#pragma unroll
        for (int b = 0; b < 2; ++b)
#pragma unroll
            for (int m = 0; m < 4; ++m)
#pragma unroll
                for (int n = 0; n < 2; ++n) acc[a][b][m][n] = (f32x4){0.f, 0.f, 0.f, 0.f};
    bf16x8 At[4][2], B0[2][2], B1[2][2];
    const char* cA = (const char*)g.A + (size_t)cur.pm * tstep; const char* cB = (const char*)g.Bt + (size_t)cur.pn * tstep;
    S.a_ready(cur);
    if constexpr (SP2) {
        PG8_STAGE(PG8_SB(0, 0), cB, voffB); PG8_STAGE(PG8_SB(0, 1), cB + hstep, voffB); PG8_STAGE(PG8_SA(0, 0), cA, voffA); PG8_STAGE(PG8_SA(0, 1), cA + hstep, voffA);
        if (wr == 1) PG8_BAR;
        PG8_WAIT_V(2); PG8_BAR;
        PG8_STAGE(PG8_SB(1, 0), cB + kstep, voffB); PG8_STAGE(PG8_SA(1, 0), cA + kstep, voffA); PG8_STAGE(PG8_SB(1, 1), cB + hstep + kstep, voffB);
        PG8_WAIT_V(6); PG8_BAR;
    } else {
        PG8_STAGE(PG8_SB(0, 0), cB, voffB); PG8_STAGE(PG8_SA(0, 0), cA, voffA); PG8_STAGE(PG8_SB(0, 1), cB + hstep, voffB); PG8_STAGE(PG8_SA(0, 1), cA + hstep, voffA);
        if (wr == 1) PG8_BAR;
        PG8_WAIT_V(4); PG8_BAR;
        PG8_STAGE(PG8_SB(1, 0), cB + kstep, voffB); PG8_STAGE(PG8_SA(1, 0), cA + kstep, voffA); PG8_STAGE(PG8_SB(1, 1), cB + hstep + kstep, voffB);
        PG8_WAIT_V(6); PG8_BAR;
    }
    for (;;) {
        const bool has_next = S.next(ui + 1, nxt);
        const char* nA = has_next ? (const char*)g.A + (size_t)nxt.pm * tstep : cA; const char* nB = has_next ? (const char*)g.Bt + (size_t)nxt.pn * tstep : cB;
        for (int t = 0; t < nt; t += 2) {
            const bool last = (t == nt - 2);
            const char* a1 = cA + (size_t)(t + 1) * kstep;
            const char* a2 = last ? nA : cA + (size_t)(t + 2) * kstep; const char* b2 = last ? nB : cB + (size_t)(t + 2) * kstep;
            const char* a3 = a2 + kstep; const char* b3 = b2 + kstep;
            if (last && has_next) S.a_ready(nxt);
            if constexpr (SP2) {
            PG8_LDB(B0, 0, 0); PG8_LDB(B1, 0, 1); PG8_SCHED; PG8_LDA(At, 0, 0); PG8_STAGE(PG8_SA(1, 1), a1 + hstep, voffA);
            PG8_WAIT_V(8); PG8_WAIT_L(0); PG8_BAR; PG8_MMA(0, 0, At, B0); PG8_MMA(0, 1, At, B1); PG8_BAR; PG8_SCHED;
            PG8_LDA(At, 0, 1); PG8_STAGE(PG8_SB(0, 0), b2, voffB); PG8_STAGE(PG8_SB(0, 1), b2 + hstep, voffB); PG8_STAGE(PG8_SA(0, 0), a2, voffA);
            PG8_WAIT_V(8); PG8_WAIT_L(0); PG8_BAR; PG8_MMA(1, 0, At, B0); PG8_MMA(1, 1, At, B1); PG8_BAR; PG8_SCHED;
            PG8_LDB(B0, 1, 0); PG8_LDB(B1, 1, 1); PG8_SCHED; PG8_LDA(At, 1, 0); PG8_STAGE(PG8_SA(0, 1), a2 + hstep, voffA);
            PG8_WAIT_V(8); PG8_WAIT_L(0); PG8_BAR; PG8_MMA(0, 0, At, B0); PG8_MMA(0, 1, At, B1); PG8_BAR; PG8_SCHED;
            PG8_LDA(At, 1, 1); PG8_STAGE(PG8_SB(1, 0), b3, voffB); PG8_STAGE(PG8_SB(1, 1), b3 + hstep, voffB); PG8_STAGE(PG8_SA(1, 0), a3, voffA);
            PG8_WAIT_V(8); PG8_WAIT_L(0); PG8_BAR; PG8_MMA(1, 0, At, B0); PG8_MMA(1, 1, At, B1); PG8_BAR; PG8_SCHED;
            } else {
            PG8_LDB(B0, 0, 0); PG8_SCHED; PG8_LDA(At, 0, 0); PG8_STAGE(PG8_SA(1, 1), a1 + hstep, voffA);
            PG8_WAIT_L(8); PG8_BAR; PG8_WAIT_L(0); PG8_MMA(0, 0, At, B0); PG8_BAR; PG8_SCHED;
            PG8_LDB(B1, 0, 1); PG8_STAGE(PG8_SB(0, 0), b2, voffB);
            PG8_BAR; PG8_WAIT_L(0); PG8_MMA(0, 1, At, B1); PG8_BAR;
            PG8_LDA(At, 0, 1); PG8_STAGE(PG8_SA(0, 0), a2, voffA);
            PG8_BAR; PG8_WAIT_L(0); PG8_MMA(1, 0, At, B0); PG8_BAR; PG8_SCHED;
            PG8_STAGE(PG8_SB(0, 1), b2 + hstep, voffB);
            PG8_WAIT_V(6); PG8_BAR; PG8_MMA(1, 1, At, B1); PG8_BAR;
            PG8_LDB(B0, 1, 0); PG8_SCHED; PG8_LDA(At, 1, 0); PG8_STAGE(PG8_SA(0, 1), a2 + hstep, voffA);
            PG8_WAIT_L(8); PG8_BAR; PG8_WAIT_L(0); PG8_MMA(0, 0, At, B0); PG8_BAR; PG8_SCHED;
            PG8_LDB(B1, 1, 1); PG8_STAGE(PG8_SB(1, 0), b3, voffB);
            PG8_BAR; PG8_WAIT_L(0); PG8_MMA(0, 1, At, B1); PG8_BAR;
            PG8_LDA(At, 1, 1); PG8_STAGE(PG8_SA(1, 0), a3, voffA);
            PG8_BAR; PG8_WAIT_L(0); PG8_MMA(1, 0, At, B0); PG8_BAR; PG8_SCHED;
            PG8_STAGE(PG8_SB(1, 1), b3 + hstep, voffB);
            PG8_WAIT_V(6); PG8_BAR; PG8_MMA(1, 1, At, B1); PG8_BAR;
            }
        }
        if constexpr (ALIGN_EPI) { if (wr == 0) PG8_BAR; }
        if constexpr (!Epi::AFTER_DRAIN) { E(acc, cur, wr, wc, fr, fq); S.done(cur); }
        if (!has_next) break;
#pragma unroll
        for (int a = 0; a < 2; ++a)
#pragma unroll
            for (int b = 0; b < 2; ++b)
#pragma unroll
                for (int m = 0; m < 4; ++m)
#pragma unroll
                    for (int n = 0; n < 2; ++n) acc[a][b][m][n] = (f32x4){0.f, 0.f, 0.f, 0.f};
        cur = nxt; cA = nA; cB = nB; ++ui;
        if constexpr (ALIGN_EPI) { if (wr == 1) PG8_BAR; }
    }
    PG8_WAIT_V(0);
    if constexpr (!ALIGN_EPI) { if (wr == 0) PG8_BAR; }
    PG8_BAR;
    if constexpr (Epi::AFTER_DRAIN) { E.fused(acc, cur, wr, wc, fr, fq, lds, wid, lane); S.done(cur); }
#undef PG8_SA
#undef PG8_SB
#undef PG8_STAGE
#undef PG8_LDA
#undef PG8_LDB
#undef PG8_MMA
#undef PG8_WAIT_V
#undef PG8_WAIT_L
#undef PG8_BAR
#undef PG8_SCHED
}
}

constexpr int NB = 16, SEQ = 2048, DM = 1024, MTOK = NB * SEQ, NQ = 4096, DIN = 4102, NL = 2;
constexpr int HF = 6, HR = 6, HS = 4, HD = 64;
constexpr float LN_EPS = 1e-5f, GN_EPS = 1e-5f;
constexpr float DN_ALPHA = 1.4142135623730951f;
constexpr float LOG2E = 1.4426950408889634f;
typedef unsigned short bf16_t;
typedef float f32x4 __attribute__((ext_vector_type(4)));
typedef unsigned u32x4 __attribute__((ext_vector_type(4)));
typedef unsigned u32x2 __attribute__((ext_vector_type(2)));

constexpr size_t MiB = 1u << 20;
constexpr size_t WS_QKVG = 0;
constexpr size_t WS_Y    = 256 * MiB;
constexpr size_t WS_XB   = 320 * MiB;
constexpr size_t WS_WIN  = 384 * MiB;
constexpr size_t WS_WOUT = 400 * MiB;
constexpr size_t WS_FLOG = 404 * MiB;
constexpr size_t WS_C    = 405 * MiB;
constexpr size_t WS_ROPE = 406 * MiB;
constexpr size_t WS_CTR  = 407 * MiB;
constexpr size_t WS_END  = 408 * MiB;

constexpr int LDS_BYTES = 147456;

struct Params {
    const float *x, *w_in, *b_fgate, *gn_gain, *w_out, *ln_gain, *ln_bias;
    float* out; unsigned char* ws;
    int ph_lo, ph_hi;
};

__device__ __forceinline__ unsigned f2bf(float f) { unsigned u = __builtin_bit_cast(unsigned, f); return (u + 0x7fffu + ((u >> 16) & 1u)) >> 16; }
__device__ __forceinline__ unsigned pk2(float lo, float hi) { return f2bf(lo) | (f2bf(hi) << 16); }
__device__ __forceinline__ float bflo(unsigned u) { return __builtin_bit_cast(float, u << 16); }
__device__ __forceinline__ float bfhi(unsigned u) { return __builtin_bit_cast(float, u & 0xffff0000u); }
__device__ __forceinline__ float wave_sum(float v) {
#pragma unroll
    for (int o = 1; o < 64; o <<= 1) v += __shfl_xor(v, o);
    return v;
}
__device__ __forceinline__ float logsig_acc(float z) { return fminf(z, 0.f) - log1pf(expf(-fabsf(z))); }

__device__ __forceinline__ int rowmap_in(int n) {
    const bool r = (n >= 384 && n < 768) || (n >= 1408 && n < 1792); const int d = n & 63; return r ? (n & ~63) + ((d & 31) << 1) + (d >> 5) : n;
}
template <bool MAP> __device__ __forceinline__ void transpose_item(const float* W, int ldw, int K, bf16_t* WT, float* scr, int kb, int nb, int lane) {
    const int k0 = 64 * kb, n0 = 32 * nb;
#pragma unroll 8
    for (int i = 0; i < 32; ++i) { const int kk = 2 * i + (lane >> 5); scr[kk * 33 + (lane & 31)] = W[(size_t)(k0 + kk) * ldw + n0 + (lane & 31)]; }
    __builtin_amdgcn_wave_barrier(); asm volatile("s_waitcnt lgkmcnt(0)" ::: "memory");
    const int c = lane & 7;
#pragma unroll
    for (int j = 0; j < 4; ++j) { const int n = (lane >> 3) + 8 * j; const float* s = scr + (8 * c) * 33 + n;
        u32x4 o; o.x = pk2(s[0 * 33], s[1 * 33]); o.y = pk2(s[2 * 33], s[3 * 33]); o.z = pk2(s[4 * 33], s[5 * 33]); o.w = pk2(s[6 * 33], s[7 * 33]);
        const int nr = MAP ? rowmap_in(n0 + n) : (n0 + n); *(u32x4*)(WT + (size_t)nr * K + k0 + 8 * c) = o; }
    __builtin_amdgcn_wave_barrier(); asm volatile("s_waitcnt lgkmcnt(0)" ::: "memory");
}

__device__ __forceinline__ void stage_wf(const Params& P, int l, float* wfs) {
    for (int i = threadIdx.x; i < 6 * 1024; i += 512) { const int k = i / 6, h = i % 6; wfs[h * 1024 + k] = P.w_in[((size_t)l * DM + k) * DIN + NQ + h]; }
}
__device__ __forceinline__ void row_emit(const f32x4 (&v)[4], bf16_t* xbrow, const float* wfs, float* flogrow, int lane) {
#pragma unroll
    for (int j = 0; j < 4; ++j) { u32x2 o; o.x = pk2(v[j].x, v[j].y); o.y = pk2(v[j].z, v[j].w); ((u32x2*)xbrow)[lane + 64 * j] = o; }
    float a0 = 0.f, a1 = 0.f, a2 = 0.f, a3 = 0.f, a4 = 0.f, a5 = 0.f;
#pragma unroll
    for (int j = 0; j < 4; ++j) {
        const float* wp = wfs + 4 * lane + 256 * j;
        f32x4 w;
        w = *(const f32x4*)(wp);          a0 += v[j].x * w.x + v[j].y * w.y + v[j].z * w.z + v[j].w * w.w;
        w = *(const f32x4*)(wp + 1024);   a1 += v[j].x * w.x + v[j].y * w.y + v[j].z * w.z + v[j].w * w.w;
        w = *(const f32x4*)(wp + 2048);   a2 += v[j].x * w.x + v[j].y * w.y + v[j].z * w.z + v[j].w * w.w;
        w = *(const f32x4*)(wp + 3072);   a3 += v[j].x * w.x + v[j].y * w.y + v[j].z * w.z + v[j].w * w.w;
        w = *(const f32x4*)(wp + 4096);   a4 += v[j].x * w.x + v[j].y * w.y + v[j].z * w.z + v[j].w * w.w;
        w = *(const f32x4*)(wp + 5120);   a5 += v[j].x * w.x + v[j].y * w.y + v[j].z * w.z + v[j].w * w.w;
    }
    a0 = wave_sum(a0); a1 = wave_sum(a1); a2 = wave_sum(a2); a3 = wave_sum(a3); a4 = wave_sum(a4); a5 = wave_sum(a5);
    float r = a0; if (lane == 1) r = a1; if (lane == 2) r = a2; if (lane == 3) r = a3; if (lane == 4) r = a4; if (lane == 5) r = a5;
    if (lane < 6) flogrow[lane] = r;
}

__device__ __forceinline__ void phase0(const Params& P, unsigned char* lds) {
    const int tid = threadIdx.x, lane = tid & 63, wave = tid >> 6;
    const int gw = blockIdx.x * 8 + wave, NGW = gridDim.x * 8;
    unsigned char* ws = P.ws;
    if (blockIdx.x == 0 && tid < 64) ((unsigned*)(ws + WS_CTR))[tid] = 0u;
    float* scr = (float*)lds + wave * (64 * 33);
    float* wfs = (float*)(lds + 8 * 64 * 33 * 4);
    stage_wf(P, 0, wfs);
    constexpr int I_IN = (DM / 64) * (NQ / 32), I_OUT = (DM / 64) * (DM / 32);
    for (int it = gw; it < NL * (I_IN + I_OUT); it += NGW) {
        int r = it; const int l = r / (I_IN + I_OUT); r -= l * (I_IN + I_OUT);
        if (r < I_IN) transpose_item<true>(P.w_in + (size_t)l * DM * DIN, DIN, DM, (bf16_t*)(ws + WS_WIN) + (size_t)l * NQ * DM, scr, r / (NQ / 32), r % (NQ / 32), lane);
        else { r -= I_IN; transpose_item<false>(P.w_out + (size_t)l * DM * DM, DM, DM, (bf16_t*)(ws + WS_WOUT) + (size_t)l * DM * DM, scr, r / (DM / 32), r % (DM / 32), lane); }
    }
    for (int i = blockIdx.x * 512 + tid; i < SEQ * 32; i += gridDim.x * 512) {
        const int pos = i >> 5, f = i & 31; const float invf = (float)(1.0 / exp2((double)f * (13.287712379549449 / 32.0))); const float ang = (float)pos * invf;
        const double t = (double)ang * 0.15915494309189535; const float fr = (float)(t - floor(t));
        ((float*)(ws + WS_ROPE))[i] = __builtin_amdgcn_cosf(fr); ((float*)(ws + WS_ROPE))[SEQ * 32 + i] = __builtin_amdgcn_sinf(fr);
    }
    __syncthreads();
    for (int m = gw; m < MTOK; m += NGW) {
        const f32x4* xr = (const f32x4*)(P.x + (size_t)m * DM) + lane; f32x4 v[4];
#pragma unroll
        for (int j = 0; j < 4; ++j) v[j] = xr[64 * j];
        row_emit(v, (bf16_t*)(ws + WS_XB) + (size_t)m * DM, wfs, (float*)(ws + WS_FLOG) + (size_t)m * 8, lane);
    }
    __syncthreads();
}

__device__ __forceinline__ void fgate_cumsum(const Params& P, int l) {
    const int tid = threadIdx.x, lane = tid & 63, wave = tid >> 6;
    const int gw = blockIdx.x * 8 + wave;
    if (gw >= NB * HF) return;
    const int b = gw / HF, h = gw % HF; const float bias = P.b_fgate[l * HF + h];
    const float* fl = (const float*)(P.ws + WS_FLOG) + ((size_t)b * SEQ + lane * 32) * 8 + h;
    float vals[32]; float run = 0.f;
#pragma unroll
    for (int i = 0; i < 32; ++i) { run += logsig_acc(fl[i * 8] + bias); vals[i] = run; }
    float incl = run;
#pragma unroll
    for (int o = 1; o < 64; o <<= 1) { const float t = __shfl_up(incl, o); if (lane >= o) incl += t; }
    const float excl = incl - run;
    float* c = (float*)(P.ws + WS_C) + ((size_t)(b * HF + h)) * SEQ + lane * 32;
#pragma unroll
    for (int i = 0; i < 32; ++i) c[i] = vals[i] + excl;
}

__device__ __forceinline__ void load_row64(const bf16_t* p, float (&f)[64]) {
    const u32x4* q = (const u32x4*)p;
#pragma unroll
    for (int i = 0; i < 8; ++i) { const u32x4 u = q[i];
        f[8 * i + 0] = bflo(u.x); f[8 * i + 1] = bfhi(u.x); f[8 * i + 2] = bflo(u.y); f[8 * i + 3] = bfhi(u.y);
        f[8 * i + 4] = bflo(u.z); f[8 * i + 5] = bfhi(u.z); f[8 * i + 6] = bflo(u.w); f[8 * i + 7] = bfhi(u.w); }
}
__device__ __forceinline__ void unpack8(const u32x4 u, float (&f)[8]) {
    f[0] = bflo(u.x); f[1] = bfhi(u.x); f[2] = bflo(u.y); f[3] = bfhi(u.y); f[4] = bflo(u.z); f[5] = bfhi(u.z); f[6] = bflo(u.w); f[7] = bfhi(u.w);
}
__device__ __forceinline__ float dot64(const float (&q)[64], const bf16_t* krow) {
    float dot = 0.f;
#pragma unroll
    for (int i = 0; i < 8; ++i) { float k[8]; unpack8(((const u32x4*)krow)[i], k);
#pragma unroll
        for (int e = 0; e < 8; ++e) dot += q[8 * i + e] * k[e]; }
    return dot;
}
__device__ __forceinline__ void axpy64(float (&o)[32], float f, float p, const bf16_t* vrow) {
#pragma unroll
    for (int i = 0; i < 4; ++i) { float v[8]; unpack8(((const u32x4*)vrow)[i], v);
#pragma unroll
        for (int e = 0; e < 8; ++e) o[8 * i + e] = o[8 * i + e] * f + p * v[e]; }
}
__device__ __forceinline__ void naive_mixers(const Params& P, int l) {
    const bf16_t* qkvg = (const bf16_t*)(P.ws + WS_QKVG);
    const float* cc = (const float*)(P.ws + WS_C);
    bf16_t* Y = (bf16_t*)(P.ws + WS_Y);
    for (int it = blockIdx.x * 512 + threadIdx.x; it < NB * 16 * SEQ * 2; it += gridDim.x * 512) {
        const int dh = it & 1, t = (it >> 1) % SEQ, hh = (it / (SEQ * 2)) % 16, b = it / (SEQ * 32);
        const bf16_t* base = qkvg + (size_t)b * SEQ * NQ + hh * 64;
        float q[64], o[32];
        load_row64(base + (size_t)t * NQ, q);
#pragma unroll
        for (int d = 0; d < 32; ++d) o[d] = 0.f;
        if (hh < HF) {
            const float* c = cc + (size_t)(b * HF + hh) * SEQ; const float ct = c[t];
            float m = -INFINITY, lsum = 0.f;
            for (int s = 0; s <= t; ++s) {
                const float sc = dot64(q, base + (size_t)s * NQ + 1024) * 0.125f + ct - c[s];
                const float mn = fmaxf(m, sc), f = expf(m - mn), p = expf(sc - mn);
                lsum = lsum * f + p; m = mn;
                axpy64(o, f, p, base + (size_t)s * NQ + 2048 + dh * 32);
            }
            const float inv = 1.f / lsum;
#pragma unroll
            for (int d = 0; d < 32; ++d) o[d] *= inv;
        } else if (hh < HF + HR) {
            const int hr = hh - HF; const float lg = logf(1.f - exp2f(-5.f - (float)hr));
            for (int s = 0; s <= t; ++s) {
                const float w = dot64(q, base + (size_t)s * NQ + 1024) * expf((float)(t - s) * lg);
                axpy64(o, 1.f, w, base + (size_t)s * NQ + 2048 + dh * 32);
            }
            float mu = 0.f;
#pragma unroll
            for (int d = 0; d < 32; ++d) mu += o[d];
            float var = 0.f;
            mu = (mu + __shfl_xor(mu, 1)) * (1.f / 64.f);
#pragma unroll
            for (int d = 0; d < 32; ++d) { o[d] -= mu; var += o[d] * o[d]; }
            var += __shfl_xor(var, 1);
            const float rs = rsqrtf(var * (1.f / 64.f) + GN_EPS); const float* gg = P.gn_gain + l * (HR * 64) + hr * 64 + dh * 32;
#pragma unroll
            for (int d = 0; d < 32; ++d) o[d] = o[d] * rs * gg[d];
        } else {
            float R = 0.f;
            for (int s = t - 1; s >= 0; --s) {
                const float z = dot64(q, base + (size_t)s * NQ + 1024) * 0.125f, ls = logsig_acc(z), a = expf(ls + R); R += ls - z;
                axpy64(o, 1.f, a, base + (size_t)s * NQ + 2048 + dh * 32);
            }
        }
        const bf16_t* gr = base + (size_t)t * NQ + 3072 + dh * 32;
        bf16_t* yr = Y + ((size_t)b * SEQ + t) * DM + hh * 64 + dh * 32;
#pragma unroll
        for (int i = 0; i < 4; ++i) { float g[8], gt[8]; unpack8(((const u32x4*)gr)[i], gt);
#pragma unroll
            for (int e = 0; e < 8; ++e) g[e] = o[8 * i + e] * gt[e] / (1.f + expf(-gt[e]));
            u32x4 w; w.x = pk2(g[0], g[1]); w.y = pk2(g[2], g[3]); w.z = pk2(g[4], g[5]); w.w = pk2(g[6], g[7]); ((u32x4*)yr)[i] = w; }
    }
}

__device__ __forceinline__ void phase4(const Params& P, int l, unsigned char* lds) {
    const int tid = threadIdx.x, lane = tid & 63, wave = tid >> 6;
    const int gw = blockIdx.x * 8 + wave, NGW = gridDim.x * 8;
    float* wfs = (float*)lds;
    if (l + 1 < NL) { stage_wf(P, l + 1, wfs); }
    __syncthreads();
    const float* gp = P.ln_gain + l * DM; const float* bp = P.ln_bias + l * DM;
    f32x4 g[4], bb[4];
#pragma unroll
    for (int j = 0; j < 4; ++j) { g[j] = ((const f32x4*)gp)[lane + 64 * j]; bb[j] = ((const f32x4*)bp)[lane + 64 * j]; }
    for (int m = gw; m < MTOK; m += NGW) {
        f32x4* xr = (f32x4*)(P.out + (size_t)m * DM) + lane; f32x4 v[4]; float s = 0.f;
#pragma unroll
        for (int j = 0; j < 4; ++j) { v[j] = xr[64 * j]; s += (v[j].x + v[j].y) + (v[j].z + v[j].w); }
        const float mean = wave_sum(s) * (1.f / DM); float s2 = 0.f;
#pragma unroll
        for (int j = 0; j < 4; ++j) { v[j] = v[j] - mean; s2 += (v[j].x * v[j].x + v[j].y * v[j].y) + (v[j].z * v[j].z + v[j].w * v[j].w); }
        const float rstd = rsqrtf(wave_sum(s2) * (1.f / DM) + LN_EPS);
#pragma unroll
        for (int j = 0; j < 4; ++j) { v[j] = v[j] * rstd * g[j] + bb[j]; xr[64 * j] = v[j]; }
        if (l + 1 < NL) row_emit(v, (bf16_t*)(P.ws + WS_XB) + (size_t)m * DM, wfs, (float*)(P.ws + WS_FLOG) + (size_t)m * 8, lane);
    }
    __syncthreads();
}

#ifndef NAIVE_MIX
#define NAIVE_MIX 1
#endif
#if NAIVE_MIX
__global__ void __launch_bounds__(512) naive_mix_kernel(Params P, int l) { naive_mixers(P, l); }
#endif
__global__ void __launch_bounds__(512) hybrid_fwd(Params P) {
    extern __shared__ __attribute__((aligned(16))) unsigned char lds[];
    cg::grid_group grid = cg::this_grid();
    unsigned char* ws = P.ws;
    const int lo = P.ph_lo, hi = P.ph_hi;
#define RUN(k) (lo <= (k) && (k) < hi)
#define SEAM(k) do { if (RUN(k) && RUN((k) + 1)) grid.sync(); } while (0)
    if (RUN(0)) phase0(P, lds);
    SEAM(0);
#pragma unroll
    for (int l = 0; l < NL; ++l) {
        if (RUN(1 + 4 * l)) {
          fgate_cumsum(P, l);
          pg8::Gemm g{(const bf16_t*)(ws + WS_XB), (const bf16_t*)(ws + WS_WIN) + (size_t)l * NQ * DM, MTOK, NQ, DM};
          pg8::StaticOrder S; S.init(MTOK, NQ, (int)gridDim.x, (int)blockIdx.x);
          pg8::EpiInProj E{(bf16_t*)(ws + WS_QKVG), (const float*)(ws + WS_ROPE)};
          pg8::gemm_phase<pg8::EpiInProj, pg8::StaticOrder, true, true>((PG8_LAS unsigned char*)lds, g, S, E); }
        SEAM(1 + 4 * l);
#if !NAIVE_MIX
        if (RUN(2 + 4 * l)) mixer_phase(P, l, lds);
#endif
        SEAM(2 + 4 * l);
        if (RUN(3 + 4 * l)) {
          pg8::Gemm g{(const bf16_t*)(ws + WS_Y), (const bf16_t*)(ws + WS_WOUT) + (size_t)l * DM * DM, MTOK, DM, DM};
          pg8::StaticOrder S; S.init(MTOK, DM, (int)gridDim.x, (int)blockIdx.x);
          pg8::EpiResid E{l == 0 ? P.x : P.out, P.out, DM, DN_ALPHA};
          pg8::gemm_phase<pg8::EpiResid, pg8::StaticOrder, true, true>((PG8_LAS unsigned char*)lds, g, S, E); }
        SEAM(3 + 4 * l);
        if (RUN(4 + 4 * l)) phase4(P, l, lds);
        SEAM(4 + 4 * l);
    }
#undef RUN
#undef SEAM
}

extern "C" void kernel_launch(void* const* d_in, const int* in_sizes, int n_in, void* d_out, int out_size, void* d_ws, size_t ws_size, hipStream_t stream) {
    static int grid_blocks = 0;
    if (grid_blocks == 0) {
        if (n_in != 7 || out_size != MTOK * DM || ws_size < WS_END) { fprintf(stderr, "kernel_launch: unexpected shapes (n_in %d out %d ws %zu)\n", n_in, out_size, ws_size); grid_blocks = -1; return; }
        int dev = 0, cus = 0, per_cu = 0;
        (void)hipGetDevice(&dev);
        (void)hipDeviceGetAttribute(&cus, hipDeviceAttributeMultiprocessorCount, dev);
        if (hipFuncSetAttribute((const void*)hybrid_fwd, hipFuncAttributeMaxDynamicSharedMemorySize, LDS_BYTES) != hipSuccess) { fprintf(stderr, "kernel_launch: hipFuncSetAttribute failed\n"); grid_blocks = -1; return; }
        if (hipOccupancyMaxActiveBlocksPerMultiprocessor(&per_cu, (const void*)hybrid_fwd, 512, LDS_BYTES) != hipSuccess || per_cu < 1) { fprintf(stderr, "kernel_launch: occupancy query failed (%d)\n", per_cu); per_cu = 1; (void)hipGetLastError(); }
        grid_blocks = cus * per_cu;
    }
    if (grid_blocks < 0) return;
    Params p{};
    p.x = (const float*)d_in[0]; p.w_in = (const float*)d_in[1]; p.b_fgate = (const float*)d_in[2]; p.gn_gain = (const float*)d_in[3];
    p.w_out = (const float*)d_in[4]; p.ln_gain = (const float*)d_in[5]; p.ln_bias = (const float*)d_in[6];
    p.out = (float*)d_out; p.ws = (unsigned char*)d_ws;
#if NAIVE_MIX
    const int cuts[4] = {0, 2, 6, 9};
    for (int i = 0; i < 3; ++i) {
        p.ph_lo = cuts[i] + (i > 0 ? 1 : 0); p.ph_hi = cuts[i + 1];
        void* args[] = {&p};
        hipError_t e = hipLaunchCooperativeKernel((const void*)hybrid_fwd, dim3(grid_blocks), dim3(512), args, LDS_BYTES, stream);
        if (e != hipSuccess) fprintf(stderr, "cooperative launch failed: %s (grid %d)\n", hipGetErrorString(e), grid_blocks);
        if (i < 2) hipLaunchKernelGGL(naive_mix_kernel, dim3(grid_blocks), dim3(512), 0, stream, p, i);
    }
#else
    p.ph_lo = 0; p.ph_hi = 9;
    void* args[] = {&p};
    hipError_t e = hipLaunchCooperativeKernel((const void*)hybrid_fwd, dim3(grid_blocks), dim3(512), args, LDS_BYTES, stream);
    if (e != hipSuccess) fprintf(stderr, "cooperative launch failed: %s (grid %d)\n", hipGetErrorString(e), grid_blocks);
#endif
}
```

```cpp
#include <hip/hip_runtime.h>
#include <hip/hip_cooperative_groups.h>
#include <cstdio>
#include <cstdint>
#include <cmath>
namespace cg = cooperative_groups;
namespace pg8 {
#define PG8_LAS __attribute__((address_space(3)))
typedef unsigned short bf16_t;
typedef short bf16x8 __attribute__((ext_vector_type(8)));
typedef float f32x4 __attribute__((ext_vector_type(4)));
typedef unsigned u32x4 __attribute__((ext_vector_type(4)));
constexpr int BM = 256, BK = 64, HALF = 128, HTB = HALF * BK * 2  , STAGE_BYTES = 8 * HTB, NXCD = 8, WGM = 8;

__host__ __device__ __forceinline__ int lds_byte(int r, int c) { const int st = (r >> 4) * 2 + (c >> 5), rr = r & 15, cc = c & 31, ob = rr * 64 + cc * 2; return st * 1024 + (ob ^ (((ob >> 9) & 1) << 5)); }
__host__ __device__ __forceinline__ void stage_rc(int b, int& R, int& C) { const int st = b / 1024, sb = b % 1024, swz = sb ^ (((sb >> 9) & 1) << 5); R = (st >> 1) * 16 + swz / 64; C = (st & 1) * 32 + (swz % 64) / 2; }
__host__ __device__ __forceinline__ int perm32(int rho) { const int n = rho >> 4, i = rho & 15; return 8 * (i >> 2) + 4 * n + (i & 3); }

struct Unit { int pm, pn; };
struct Gemm { const bf16_t* A; const bf16_t* Bt; int M, N, K; };

struct StaticOrder {
    int nM, nN, nwg, G, c;
    __host__ __device__ void init(int M, int N, int G_, int c_) { nM = M / BM; nN = N / BM; nwg = nM * nN; G = G_; c = c_; }
    __host__ __device__ bool next(int i, Unit& u) const {
        const long L = (long)i * G + c; if (L >= nwg) return false;
        int wgid = (int)L; { const int q = nwg / NXCD, r = nwg % NXCD, xcd = wgid % NXCD, off = wgid / NXCD; wgid = (xcd < r ? xcd * (q + 1) : r * (q + 1) + (xcd - r) * q) + off; }
        const int nig = WGM * nN, gid = wgid / nig, fm = gid * WGM, gsz = (nM - fm) < WGM ? (nM - fm) : WGM;
        u.pm = fm + ((wgid % nig) % gsz); u.pn = (wgid % nig) / gsz; return true;
    }
    __device__ __forceinline__ void a_ready(const Unit&) const {}
    __device__ __forceinline__ void done(const Unit&) const {}
};

__device__ __forceinline__ unsigned cvt_pk_bf16(float lo, float hi) { unsigned r; asm volatile("v_cvt_pk_bf16_f32 %0, %1, %2" : "=v"(r) : "v"(lo), "v"(hi)); return r; }
typedef float f32x2 __attribute__((ext_vector_type(2)));
__device__ __forceinline__ f32x2 gelu_pk(f32x2 v) {
    const f32x2 av = __builtin_elementwise_abs(v), d = av * 0.2316418882f + 1.0f;
    f32x2 t; t.x = __builtin_amdgcn_rcpf(d.x); t.y = __builtin_amdgcn_rcpf(d.y);
    f32x2 q = t * 0.5307027145f + (-0.7265760135f); q = q * t + 0.7107068705f; q = q * t + (-0.142248368f); q = q * t + 0.127414796f; q = q * t;
    const f32x2 s = (v * v) * (-0.72134752044f);
    f32x2 e; e.x = __builtin_amdgcn_exp2f(s.x); e.y = __builtin_amdgcn_exp2f(s.y);
    const f32x2 m = v * (q * e), r = v - m;
    f32x2 o; o.x = v.x < 0.f ? m.x : r.x; o.y = v.y < 0.f ? m.y : r.y; return o;
}

template <int ACT  > struct EpiBf16 {
    static constexpr bool PERM = true, AFTER_DRAIN = false; static_assert(ACT == 0 || ACT == 1, "EpiBf16: ACT is 0 (none) or 1 (gelu_pk)");
    bf16_t* O; int ldc; const float* bias; int split_cols; size_t split_stride; float scale0;
    __device__ __forceinline__ void operator()(const f32x4 (&acc)[2][2][4][2], const Unit& u, int wr, int wc, int fr, int fq) const {
        const int row0 = u.pm * BM + wr * 64 + fr; int colt = u.pn * BM; bf16_t* base = O;
        float sc = 1.f; if (split_cols) { const int t = colt / split_cols; base += (size_t)t * split_stride; colt -= t * split_cols; if (t == 0) sc = scale0; }
        const int col0 = colt + wc * 32 + 8 * fq, bcol0 = u.pn * BM + wc * 32 + 8 * fq;
        f32x4 bv[2][2];
#pragma unroll
        for (int bj = 0; bj < 2; ++bj)
#pragma unroll
            for (int n = 0; n < 2; ++n) bv[bj][n] = bias ? *(const f32x4*)(bias + bcol0 + bj * HALF + 4 * n) : (f32x4){0.f, 0.f, 0.f, 0.f};
#pragma unroll
        for (int ai = 0; ai < 2; ++ai)
#pragma unroll
            for (int m = 0; m < 4; ++m) { bf16_t* rowp = base + (size_t)(row0 + ai * HALF + m * 16) * ldc + col0;
#pragma unroll
                for (int bj = 0; bj < 2; ++bj) { f32x4 v0 = acc[ai][bj][m][0] + bv[bj][0], v1 = acc[ai][bj][m][1] + bv[bj][1];
                    if (ACT == 1) { f32x2 a = gelu_pk((f32x2){v0[0], v0[1]}), b = gelu_pk((f32x2){v0[2], v0[3]}), c = gelu_pk((f32x2){v1[0], v1[1]}), d = gelu_pk((f32x2){v1[2], v1[3]});
                        v0 = (f32x4){a.x, a.y, b.x, b.y}; v1 = (f32x4){c.x, c.y, d.x, d.y}; }
                    v0 = v0 * sc; v1 = v1 * sc; u32x4 w; w.x = cvt_pk_bf16(v0[0], v0[1]); w.y = cvt_pk_bf16(v0[2], v0[3]); w.z = cvt_pk_bf16(v1[0], v1[1]); w.w = cvt_pk_bf16(v1[2], v1[3]);
                    *(u32x4*)(rowp + bj * HALF) = w; } }
    }
};
struct EpiResid {
    static constexpr bool PERM = true, AFTER_DRAIN = false;
    const float* res; float* out; int ldc; float alpha;
    __device__ __forceinline__ void operator()(const f32x4 (&acc)[2][2][4][2], const Unit& u, int wr, int wc, int fr, int fq) const {
        const int row0 = u.pm * BM + wr * 64 + fr; const int col0 = u.pn * BM + wc * 32 + 8 * fq;
#pragma unroll
        for (int ai = 0; ai < 2; ++ai)
#pragma unroll
            for (int m = 0; m < 4; ++m) { const size_t ro = (size_t)(row0 + ai * HALF + m * 16) * ldc + col0;
#pragma unroll
                for (int bj = 0; bj < 2; ++bj) {
                    const f32x4 r0 = *(const f32x4*)(res + ro + bj * HALF), r1 = *(const f32x4*)(res + ro + bj * HALF + 4);
                    const f32x4 v0 = acc[ai][bj][m][0] + r0 * alpha, v1 = acc[ai][bj][m][1] + r1 * alpha;
                    *(f32x4*)(out + ro + bj * HALF) = v0; *(f32x4*)(out + ro + bj * HALF + 4) = v1; } }
    }
};
struct EpiInProj {
    static constexpr bool PERM = true, AFTER_DRAIN = false;
    bf16_t* O; const float* rope;
    __device__ __forceinline__ void operator()(const f32x4 (&acc)[2][2][4][2], const Unit& u, int wr, int wc, int fr, int fq) const {
        const int row0 = u.pm * BM + wr * 64 + fr;
#pragma unroll
        for (int bj = 0; bj < 2; ++bj) {
            const int colg = u.pn * BM + bj * HALF + wc * 32, col0 = colg + 8 * fq, head = colg >> 6;
            const bool isrot = (head >= 6 && head < 12) || (head >= 22 && head < 28);
            const float sc = head >= 16 ? 0.125f : 1.f;
            const int i0 = ((colg & 63) + 8 * fq) >> 1;
#pragma unroll
            for (int ai = 0; ai < 2; ++ai)
#pragma unroll
                for (int m = 0; m < 4; ++m) {
                    const int row = row0 + ai * HALF + m * 16;
                    f32x4 v0 = acc[ai][bj][m][0], v1 = acc[ai][bj][m][1];
                    if (isrot) {
                        const int pos = row & 2047;
                        const f32x4 c = *(const f32x4*)(rope + pos * 32 + i0), s = *(const f32x4*)(rope + 2048 * 32 + pos * 32 + i0);
                        f32x4 w0, w1;
                        w0[0] = (v0[0] * c[0] - v0[1] * s[0]) * sc; w0[1] = (v0[0] * s[0] + v0[1] * c[0]) * sc;
                        w0[2] = (v0[2] * c[1] - v0[3] * s[1]) * sc; w0[3] = (v0[2] * s[1] + v0[3] * c[1]) * sc;
                        w1[0] = (v1[0] * c[2] - v1[1] * s[2]) * sc; w1[1] = (v1[0] * s[2] + v1[1] * c[2]) * sc;
                        w1[2] = (v1[2] * c[3] - v1[3] * s[3]) * sc; w1[3] = (v1[2] * s[3] + v1[3] * c[3]) * sc;
                        v0 = w0; v1 = w1;
                    }
                    u32x4 w; w.x = cvt_pk_bf16(v0[0], v0[1]); w.y = cvt_pk_bf16(v0[2], v0[3]); w.z = cvt_pk_bf16(v1[0], v1[1]); w.w = cvt_pk_bf16(v1[2], v1[3]);
                    *(u32x4*)(O + (size_t)row * 4096 + col0) = w;
                }
        }
    }
};
template <class Epi, class Sched, bool ALIGN_EPI = false, bool SP2 = false>
__device__ __forceinline__ void gemm_phase(PG8_LAS unsigned char* lds, const Gemm g, const Sched& S, const Epi& E) {
    int tid = threadIdx.x; asm volatile("" : "+v"(tid));
    const int wid = __builtin_amdgcn_readfirstlane(tid >> 6), lane = tid & 63, wr = wid >> 2, wc = wid & 3, fr = lane & 15, fq = lane >> 4;
    const int K = g.K, nt = K / BK;
    unsigned voffA[2], voffB[2];
#pragma unroll
    for (int i = 0; i < 2; ++i) { int R, C; stage_rc(tid * 16 + i * 8192, R, C); const int Rb = Epi::PERM ? ((R & ~31) + perm32(R & 31)) : R;
        voffA[i] = (unsigned)(R * K + C) * 2u; voffB[i] = (unsigned)(Rb * K + C) * 2u; }
    const size_t kstep = (size_t)(BK * 2);
    const size_t hstep = (size_t)HALF * K * 2;
    const size_t tstep = 2 * hstep;
    const unsigned ldsw = (unsigned)wid * 1024u;
    const int aoff = lds_byte(wr * 64 + fr, fq * 8), boff = lds_byte(wc * 32 + fr, fq * 8);
#define PG8_SA(b, h) (((b) * 2 + (h)) * HTB)
#define PG8_SB(b, h) ((4 + (b) * 2 + (h)) * HTB)
#define PG8_STAGE(bufoff, gbase, voff) do { _Pragma("unroll") for (int _i = 0; _i < 2; ++_i) \
        __builtin_amdgcn_global_load_lds((const unsigned*)((const char*)(gbase) + (voff)[_i]), (PG8_LAS unsigned*)(lds + (bufoff) + ldsw + _i * 8192), 16, 0, 0); } while (0)
#define PG8_LDA(dst, b, h) do { _Pragma("unroll") for (int m = 0; m < 4; ++m) _Pragma("unroll") for (int k = 0; k < 2; ++k) dst[m][k] = *(const PG8_LAS bf16x8*)(lds + PG8_SA(b, h) + aoff + m * 2048 + k * 1024); } while (0)
#define PG8_LDB(dst, b, h) do { _Pragma("unroll") for (int n = 0; n < 2; ++n) _Pragma("unroll") for (int k = 0; k < 2; ++k) dst[n][k] = *(const PG8_LAS bf16x8*)(lds + PG8_SB(b, h) + boff + n * 2048 + k * 1024); } while (0)
#define PG8_MMA(ai, bj, At, Bt) do { __builtin_amdgcn_s_setprio(1); _Pragma("unroll") for (int m = 0; m < 4; ++m) _Pragma("unroll") for (int n = 0; n < 2; ++n) _Pragma("unroll") for (int k = 0; k < 2; ++k) \
        acc[ai][bj][m][n] = __builtin_amdgcn_mfma_f32_16x16x32_bf16(Bt[n][k], At[m][k], acc[ai][bj][m][n], 0, 0, 0); __builtin_amdgcn_s_setprio(0); } while (0)
#define PG8_WAIT_V(n) asm volatile("s_waitcnt vmcnt(" #n ")" ::: "memory")
#define PG8_WAIT_L(n) asm volatile("s_waitcnt lgkmcnt(" #n ")" ::: "memory")
#define PG8_BAR __builtin_amdgcn_s_barrier()
#define PG8_SCHED __builtin_amdgcn_sched_barrier(0)
    Unit cur, nxt; int ui = 0;
    if (!S.next(0, cur)) return;
    f32x4 acc[2][2][4][2];
#pragma unroll
    for (int a = 0; a < 2; ++a)
#pragma unroll
        for (int b = 0; b < 2; ++b)
#pragma unroll
            for (int m = 0; m < 4; ++m)
#pragma unroll
                for (int n = 0; n < 2; ++n) acc[a][b][m][n] = (f32x4){0.f, 0.f, 0.f, 0.f};
    bf16x8 At[4][2], B0[2][2], B1[2][2];
    const char* cA = (const char*)g.A + (size_t)cur.pm * tstep; const char* cB = (const char*)g.Bt + (size_t)cur.pn * tstep;
    S.a_ready(cur);
    if constexpr (SP2) {
        PG8_STAGE(PG8_SB(0, 0), cB, voffB); PG8_STAGE(PG8_SB(0, 1), cB + hstep, voffB); PG8_STAGE(PG8_SA(0, 0), cA, voffA); PG8_STAGE(PG8_SA(0, 1), cA + hstep, voffA);
        if (wr == 1) PG8_BAR;
        PG8_WAIT_V(2); PG8_BAR;
        PG8_STAGE(PG8_SB(1, 0), cB + kstep, voffB); PG8_STAGE(PG8_SA(1, 0), cA + kstep, voffA); PG8_STAGE(PG8_SB(1, 1), cB + hstep + kstep, voffB);
        PG8_WAIT_V(6); PG8_BAR;
    } else {
        PG8_STAGE(PG8_SB(0, 0), cB, voffB); PG8_STAGE(PG8_SA(0, 0), cA, voffA); PG8_STAGE(PG8_SB(0, 1), cB + hstep, voffB); PG8_STAGE(PG8_SA(0, 1), cA + hstep, voffA);
        if (wr == 1) PG8_BAR;
        PG8_WAIT_V(4); PG8_BAR;
        PG8_STAGE(PG8_SB(1, 0), cB + kstep, voffB); PG8_STAGE(PG8_SA(1, 0), cA + kstep, voffA); PG8_STAGE(PG8_SB(1, 1), cB + hstep + kstep, voffB);
        PG8_WAIT_V(6); PG8_BAR;
    }
    for (;;) {
        const bool has_next = S.next(ui + 1, nxt);
        const char* nA = has_next ? (const char*)g.A + (size_t)nxt.pm * tstep : cA; const char* nB = has_next ? (const char*)g.Bt + (size_t)nxt.pn * tstep : cB;
        for (int t = 0; t < nt; t += 2) {
            const bool last = (t == nt - 2);
            const char* a1 = cA + (size_t)(t + 1) * kstep;
            const char* a2 = last ? nA : cA + (size_t)(t + 2) * kstep; const char* b2 = last ? nB : cB + (size_t)(t + 2) * kstep;
            const char* a3 = a2 + kstep; const char* b3 = b2 + kstep;
            if (last && has_next) S.a_ready(nxt);
            if constexpr (SP2) {
            PG8_LDB(B0, 0, 0); PG8_LDB(B1, 0, 1); PG8_SCHED; PG8_LDA(At, 0, 0); PG8_STAGE(PG8_SA(1, 1), a1 + hstep, voffA);
            PG8_WAIT_V(8); PG8_WAIT_L(0); PG8_BAR; PG8_MMA(0, 0, At, B0); PG8_MMA(0, 1, At, B1); PG8_BAR; PG8_SCHED;
            PG8_LDA(At, 0, 1); PG8_STAGE(PG8_SB(0, 0), b2, voffB); PG8_STAGE(PG8_SB(0, 1), b2 + hstep, voffB); PG8_STAGE(PG8_SA(0, 0), a2, voffA);
            PG8_WAIT_V(8); PG8_WAIT_L(0); PG8_BAR; PG8_MMA(1, 0, At, B0); PG8_MMA(1, 1, At, B1); PG8_BAR; PG8_SCHED;
            PG8_LDB(B0, 1, 0); PG8_LDB(B1, 1, 1); PG8_SCHED; PG8_LDA(At, 1, 0); PG8_STAGE(PG8_SA(0, 1), a2 + hstep, voffA);
            PG8_WAIT_V(8); PG8_WAIT_L(0); PG8_BAR; PG8_MMA(0, 0, At, B0); PG8_MMA(0, 1, At, B1); PG8_BAR; PG8_SCHED;
            PG8_LDA(At, 1, 1); PG8_STAGE(PG8_SB(1, 0), b3, voffB); PG8_STAGE(PG8_SB(1, 1), b3 + hstep, voffB); PG8_STAGE(PG8_SA(1, 0), a3, voffA);
            PG8_WAIT_V(8); PG8_WAIT_L(0); PG8_BAR; PG8_MMA(1, 0, At, B0); PG8_MMA(1, 1, At, B1); PG8_BAR; PG8_SCHED;
            } else {
            PG8_LDB(B0, 0, 0); PG8_SCHED; PG8_LDA(At, 0, 0); PG8_STAGE(PG8_SA(1, 1), a1 + hstep, voffA);
            PG8_WAIT_L(8); PG8_BAR; PG8_WAIT_L(0); PG8_MMA(0, 0, At, B0); PG8_BAR; PG8_SCHED;
            PG8_LDB(B1, 0, 1); PG8_STAGE(PG8_SB(0, 0), b2, voffB);
            PG8_BAR; PG8_WAIT_L(0); PG8_MMA(0, 1, At, B1); PG8_BAR;
            PG8_LDA(At, 0, 1); PG8_STAGE(PG8_SA(0, 0), a2, voffA);
            PG8_BAR; PG8_WAIT_L(0); PG8_MMA(1, 0, At, B0); PG8_BAR; PG8_SCHED;
            PG8_STAGE(PG8_SB(0, 1), b2 + hstep, voffB);
            PG8_WAIT_V(6); PG8_BAR; PG8_MMA(1, 1, At, B1); PG8_BAR;
            PG8_LDB(B0, 1, 0); PG8_SCHED; PG8_LDA(At, 1, 0); PG8_STAGE(PG8_SA(0, 1), a2 + hstep, voffA);
            PG8_WAIT_L(8); PG8_BAR; PG8_WAIT_L(0); PG8_MMA(0, 0, At, B0); PG8_BAR; PG8_SCHED;
            PG8_LDB(B1, 1, 1); PG8_STAGE(PG8_SB(1, 0), b3, voffB);
            PG8_BAR; PG8_WAIT_L(0); PG8_MMA(0, 1, At, B1); PG8_BAR;
            PG8_LDA(At, 1, 1); PG8_STAGE(PG8_SA(1, 0), a3, voffA);
            PG8_BAR; PG8_WAIT_L(0); PG8_MMA(1, 0, At, B0); PG8_BAR; PG8_SCHED;
            PG8_STAGE(PG8_SB(1, 1), b3 + hstep, voffB);
            PG8_WAIT_V(6); PG8_BAR; PG8_MMA(1, 1, At, B1); PG8_BAR;
            }
        }
        if constexpr (ALIGN_EPI) { if (wr == 0) PG8_BAR; }
        if constexpr (!Epi::AFTER_DRAIN) { E(acc, cur, wr, wc, fr, fq); S.done(cur); }
        if (!has_next) break;
#pragma unroll
        for (int a = 0; a < 2; ++a)
#pragma unroll
            for (int b = 0; b < 2; ++b)
#pragma unroll
                for (int m = 0; m < 4; ++m)
#pragma unroll
                    for (int n = 0; n < 2; ++n) acc[a][b][m][n] = (f32x4){0.f, 0.f, 0.f, 0.f};
        cur = nxt; cA = nA; cB = nB; ++ui;
        if constexpr (ALIGN_EPI) { if (wr == 1) PG8_BAR; }
    }
    PG8_WAIT_V(0);
    if constexpr (!ALIGN_EPI) { if (wr == 0) PG8_BAR; }
    PG8_BAR;
    if constexpr (Epi::AFTER_DRAIN) { E.fused(acc, cur, wr, wc, fr, fq, lds, wid, lane); S.done(cur); }
#undef PG8_SA
#undef PG8_SB
#undef PG8_STAGE
#undef PG8_LDA
#undef PG8_LDB
#undef PG8_MMA
#undef PG8_WAIT_V
#undef PG8_WAIT_L
#undef PG8_BAR
#undef PG8_SCHED
}
}

#ifndef MIX_MASK
#define MIX_MASK 7
#endif
#define NAIVE_MIX (MIX_MASK != 7)
constexpr int NB = 16, SEQ = 2048, DM = 1024, MTOK = NB * SEQ, NQ = 4096, DIN = 4102, NL = 2;
constexpr int HF = 6, HR = 6, HS = 4, HD = 64;
constexpr float LN_EPS = 1e-5f, GN_EPS = 1e-5f;
constexpr float DN_ALPHA = 1.4142135623730951f;
constexpr float LOG2E = 1.4426950408889634f;
typedef unsigned short bf16_t;
typedef float f32x4 __attribute__((ext_vector_type(4)));
typedef unsigned u32x4 __attribute__((ext_vector_type(4)));
typedef unsigned u32x2 __attribute__((ext_vector_type(2)));

constexpr size_t MiB = 1u << 20;
constexpr size_t WS_QKVG = 0;
constexpr size_t WS_Y    = 256 * MiB;
constexpr size_t WS_XB   = 320 * MiB;
constexpr size_t WS_WIN  = 384 * MiB;
constexpr size_t WS_WOUT = 400 * MiB;
constexpr size_t WS_FLOG = 404 * MiB;
constexpr size_t WS_C    = 405 * MiB;
constexpr size_t WS_ROPE = 406 * MiB;
constexpr size_t WS_CTR  = 407 * MiB;
constexpr size_t WS_END  = 408 * MiB;

constexpr int LDS_BYTES = 147456;

struct Params {
    const float *x, *w_in, *b_fgate, *gn_gain, *w_out, *ln_gain, *ln_bias;
    float* out; unsigned char* ws;
    int ph_lo, ph_hi;
};

__device__ __forceinline__ unsigned f2bf(float f) { unsigned u = __builtin_bit_cast(unsigned, f); return (u + 0x7fffu + ((u >> 16) & 1u)) >> 16; }
__device__ __forceinline__ unsigned pk2(float lo, float hi) { return f2bf(lo) | (f2bf(hi) << 16); }
__device__ __forceinline__ float bflo(unsigned u) { return __builtin_bit_cast(float, u << 16); }
__device__ __forceinline__ float bfhi(unsigned u) { return __builtin_bit_cast(float, u & 0xffff0000u); }
__device__ __forceinline__ float wave_sum(float v) {
#pragma unroll
    for (int o = 1; o < 64; o <<= 1) v += __shfl_xor(v, o);
    return v;
}
__device__ __forceinline__ float logsig_acc(float z) { return fminf(z, 0.f) - log1pf(expf(-fabsf(z))); }

__device__ __forceinline__ int rowmap_in(int n) {
    const bool r = (n >= 384 && n < 768) || (n >= 1408 && n < 1792); const int d = n & 63; return r ? (n & ~63) + ((d & 31) << 1) + (d >> 5) : n;
}
template <bool MAP> __device__ __forceinline__ void transpose_item(const float* W, int ldw, int K, bf16_t* WT, float* scr, int kb, int nb, int lane) {
    const int k0 = 64 * kb, n0 = 32 * nb;
#pragma unroll 8
    for (int i = 0; i < 32; ++i) { const int kk = 2 * i + (lane >> 5); scr[kk * 33 + (lane & 31)] = W[(size_t)(k0 + kk) * ldw + n0 + (lane & 31)]; }
    __builtin_amdgcn_wave_barrier(); asm volatile("s_waitcnt lgkmcnt(0)" ::: "memory");
    const int c = lane & 7;
#pragma unroll
    for (int j = 0; j < 4; ++j) { const int n = (lane >> 3) + 8 * j; const float* s = scr + (8 * c) * 33 + n;
        u32x4 o; o.x = pk2(s[0 * 33], s[1 * 33]); o.y = pk2(s[2 * 33], s[3 * 33]); o.z = pk2(s[4 * 33], s[5 * 33]); o.w = pk2(s[6 * 33], s[7 * 33]);
        const int nr = MAP ? rowmap_in(n0 + n) : (n0 + n); *(u32x4*)(WT + (size_t)nr * K + k0 + 8 * c) = o; }
    __builtin_amdgcn_wave_barrier(); asm volatile("s_waitcnt lgkmcnt(0)" ::: "memory");
}

__device__ __forceinline__ void stage_wf(const Params& P, int l, float* wfs) {
    for (int i = threadIdx.x; i < 6 * 1024; i += 512) { const int k = i / 6, h = i % 6; wfs[h * 1024 + k] = P.w_in[((size_t)l * DM + k) * DIN + NQ + h]; }
}
__device__ __forceinline__ void row_emit(const f32x4 (&v)[4], bf16_t* xbrow, const float* wfs, float* flogrow, int lane) {
#pragma unroll
    for (int j = 0; j < 4; ++j) { u32x2 o; o.x = pk2(v[j].x, v[j].y); o.y = pk2(v[j].z, v[j].w); ((u32x2*)xbrow)[lane + 64 * j] = o; }
    float a0 = 0.f, a1 = 0.f, a2 = 0.f, a3 = 0.f, a4 = 0.f, a5 = 0.f;
#pragma unroll
    for (int j = 0; j < 4; ++j) {
        const float* wp = wfs + 4 * lane + 256 * j;
        f32x4 w;
        w = *(const f32x4*)(wp);          a0 += v[j].x * w.x + v[j].y * w.y + v[j].z * w.z + v[j].w * w.w;
        w = *(const f32x4*)(wp + 1024);   a1 += v[j].x * w.x + v[j].y * w.y + v[j].z * w.z + v[j].w * w.w;
        w = *(const f32x4*)(wp + 2048);   a2 += v[j].x * w.x + v[j].y * w.y + v[j].z * w.z + v[j].w * w.w;
        w = *(const f32x4*)(wp + 3072);   a3 += v[j].x * w.x + v[j].y * w.y + v[j].z * w.z + v[j].w * w.w;
        w = *(const f32x4*)(wp + 4096);   a4 += v[j].x * w.x + v[j].y * w.y + v[j].z * w.z + v[j].w * w.w;
        w = *(const f32x4*)(wp + 5120);   a5 += v[j].x * w.x + v[j].y * w.y + v[j].z * w.z + v[j].w * w.w;
    }
    a0 = wave_sum(a0); a1 = wave_sum(a1); a2 = wave_sum(a2); a3 = wave_sum(a3); a4 = wave_sum(a4); a5 = wave_sum(a5);
    float r = a0; if (lane == 1) r = a1; if (lane == 2) r = a2; if (lane == 3) r = a3; if (lane == 4) r = a4; if (lane == 5) r = a5;
    if (lane < 6) flogrow[lane] = r;
}

__device__ __forceinline__ void phase0(const Params& P, unsigned char* lds) {
    int tid = threadIdx.x; asm volatile("" : "+v"(tid));
    const int lane = tid & 63, wave = tid >> 6;
    const int gw = blockIdx.x * 8 + wave, NGW = gridDim.x * 8;
    unsigned char* ws = P.ws;
    if (blockIdx.x == 0 && tid < 64) ((unsigned*)(ws + WS_CTR))[tid] = 0u;
    float* scr = (float*)lds + wave * (64 * 33);
    float* wfs = (float*)(lds + 8 * 64 * 33 * 4);
    stage_wf(P, 0, wfs);
    constexpr int I_IN = (DM / 64) * (NQ / 32), I_OUT = (DM / 64) * (DM / 32);
    for (int it = gw; it < NL * (I_IN + I_OUT); it += NGW) {
        int r = it; const int l = r / (I_IN + I_OUT); r -= l * (I_IN + I_OUT);
        if (r < I_IN) transpose_item<true>(P.w_in + (size_t)l * DM * DIN, DIN, DM, (bf16_t*)(ws + WS_WIN) + (size_t)l * NQ * DM, scr, r / (NQ / 32), r % (NQ / 32), lane);
        else { r -= I_IN; transpose_item<false>(P.w_out + (size_t)l * DM * DM, DM, DM, (bf16_t*)(ws + WS_WOUT) + (size_t)l * DM * DM, scr, r / (DM / 32), r % (DM / 32), lane); }
    }
    for (int i = blockIdx.x * 512 + tid; i < SEQ * 32; i += gridDim.x * 512) {
        const int pos = i >> 5, f = i & 31; const float invf = (float)(1.0 / exp2((double)f * (13.287712379549449 / 32.0))); const float ang = (float)pos * invf;
        const double t = (double)ang * 0.15915494309189535; const float fr = (float)(t - floor(t));
        ((float*)(ws + WS_ROPE))[i] = __builtin_amdgcn_cosf(fr); ((float*)(ws + WS_ROPE))[SEQ * 32 + i] = __builtin_amdgcn_sinf(fr);
    }
    __syncthreads();
    for (int m = gw; m < MTOK; m += NGW) {
        const f32x4* xr = (const f32x4*)(P.x + (size_t)m * DM) + lane; f32x4 v[4];
#pragma unroll
        for (int j = 0; j < 4; ++j) v[j] = xr[64 * j];
        row_emit(v, (bf16_t*)(ws + WS_XB) + (size_t)m * DM, wfs, (float*)(ws + WS_FLOG) + (size_t)m * 8, lane);
    }
    __syncthreads();
}

__device__ __forceinline__ void fgate_cumsum(const Params& P, int l) {
    int tid = threadIdx.x; asm volatile("" : "+v"(tid));
    const int lane = tid & 63, wave = tid >> 6;
    const int gw = blockIdx.x * 8 + wave;
    if (gw >= NB * HF) return;
    const int b = gw / HF, h = gw % HF; const float bias = P.b_fgate[l * HF + h];
    const float* fl = (const float*)(P.ws + WS_FLOG) + ((size_t)b * SEQ + lane * 32) * 8 + h;
    float vals[32]; float run = 0.f;
#pragma unroll
    for (int i = 0; i < 32; ++i) { run += logsig_acc(fl[i * 8] + bias); vals[i] = run; }
    float incl = run;
#pragma unroll
    for (int o = 1; o < 64; o <<= 1) { const float t = __shfl_up(incl, o); if (lane >= o) incl += t; }
    const float excl = incl - run;
    float* c = (float*)(P.ws + WS_C) + ((size_t)(b * HF + h)) * SEQ + lane * 32;
#pragma unroll
    for (int i = 0; i < 32; ++i) c[i] = vals[i] + excl;
}

__device__ __forceinline__ void load_row64(const bf16_t* p, float (&f)[64]) {
    const u32x4* q = (const u32x4*)p;
#pragma unroll
    for (int i = 0; i < 8; ++i) { const u32x4 u = q[i];
        f[8 * i + 0] = bflo(u.x); f[8 * i + 1] = bfhi(u.x); f[8 * i + 2] = bflo(u.y); f[8 * i + 3] = bfhi(u.y);
        f[8 * i + 4] = bflo(u.z); f[8 * i + 5] = bfhi(u.z); f[8 * i + 6] = bflo(u.w); f[8 * i + 7] = bfhi(u.w); }
}
__device__ __forceinline__ void unpack8(const u32x4 u, float (&f)[8]) {
    f[0] = bflo(u.x); f[1] = bfhi(u.x); f[2] = bflo(u.y); f[3] = bfhi(u.y); f[4] = bflo(u.z); f[5] = bfhi(u.z); f[6] = bflo(u.w); f[7] = bfhi(u.w);
}
__device__ __forceinline__ float dot64(const float (&q)[64], const bf16_t* krow) {
    float dot = 0.f;
#pragma unroll
    for (int i = 0; i < 8; ++i) { float k[8]; unpack8(((const u32x4*)krow)[i], k);
#pragma unroll
        for (int e = 0; e < 8; ++e) dot += q[8 * i + e] * k[e]; }
    return dot;
}
__device__ __forceinline__ void axpy64(float (&o)[32], float f, float p, const bf16_t* vrow) {
#pragma unroll
    for (int i = 0; i < 4; ++i) { float v[8]; unpack8(((const u32x4*)vrow)[i], v);
#pragma unroll
        for (int e = 0; e < 8; ++e) o[8 * i + e] = o[8 * i + e] * f + p * v[e]; }
}
__device__ __forceinline__ void naive_mixers(const Params& P, int l) {
    const bf16_t* qkvg = (const bf16_t*)(P.ws + WS_QKVG);
    const float* cc = (const float*)(P.ws + WS_C);
    bf16_t* Y = (bf16_t*)(P.ws + WS_Y);
    for (int it = blockIdx.x * 512 + threadIdx.x; it < NB * 16 * SEQ * 2; it += gridDim.x * 512) {
        const int dh = it & 1, t = (it >> 1) % SEQ, hh = (it / (SEQ * 2)) % 16, b = it / (SEQ * 32);
        { const int ty = hh < HF ? 1 : (hh < HF + HR ? 2 : 4); if (MIX_MASK & ty) continue; }
        const bf16_t* base = qkvg + (size_t)b * SEQ * NQ + hh * 64;
        float q[64], o[32];
        load_row64(base + (size_t)t * NQ, q);
#pragma unroll
        for (int d = 0; d < 32; ++d) o[d] = 0.f;
        if (hh < HF) {
            const float* c = cc + (size_t)(b * HF + hh) * SEQ; const float ct = c[t];
            float m = -INFINITY, lsum = 0.f;
            for (int s = 0; s <= t; ++s) {
                const float sc = dot64(q, base + (size_t)s * NQ + 1024) * 0.125f + ct - c[s];
                const float mn = fmaxf(m, sc), f = expf(m - mn), p = expf(sc - mn);
                lsum = lsum * f + p; m = mn;
                axpy64(o, f, p, base + (size_t)s * NQ + 2048 + dh * 32);
            }
            const float inv = 1.f / lsum;
#pragma unroll
            for (int d = 0; d < 32; ++d) o[d] *= inv;
        } else if (hh < HF + HR) {
            const int hr = hh - HF; const float lg = logf(1.f - exp2f(-5.f - (float)hr));
            for (int s = 0; s <= t; ++s) {
                const float w = dot64(q, base + (size_t)s * NQ + 1024) * expf((float)(t - s) * lg);
                axpy64(o, 1.f, w, base + (size_t)s * NQ + 2048 + dh * 32);
            }
            float mu = 0.f;
#pragma unroll
            for (int d = 0; d < 32; ++d) mu += o[d];
            float var = 0.f;
            mu = (mu + __shfl_xor(mu, 1)) * (1.f / 64.f);
#pragma unroll
            for (int d = 0; d < 32; ++d) { o[d] -= mu; var += o[d] * o[d]; }
            var += __shfl_xor(var, 1);
            const float rs = rsqrtf(var * (1.f / 64.f) + GN_EPS); const float* gg = P.gn_gain + l * (HR * 64) + hr * 64 + dh * 32;
#pragma unroll
            for (int d = 0; d < 32; ++d) o[d] = o[d] * rs * gg[d];
        } else {
            float R = 0.f;
            for (int s = t - 1; s >= 0; --s) {
                const float z = dot64(q, base + (size_t)s * NQ + 1024) * 0.125f, ls = logsig_acc(z), a = expf(ls + R); R += ls - z;
                axpy64(o, 1.f, a, base + (size_t)s * NQ + 2048 + dh * 32);
            }
        }
        const bf16_t* gr = base + (size_t)t * NQ + 3072 + dh * 32;
        bf16_t* yr = Y + ((size_t)b * SEQ + t) * DM + hh * 64 + dh * 32;
#pragma unroll
        for (int i = 0; i < 4; ++i) { float g[8], gt[8]; unpack8(((const u32x4*)gr)[i], gt);
#pragma unroll
            for (int e = 0; e < 8; ++e) g[e] = o[8 * i + e] * gt[e] / (1.f + expf(-gt[e]));
            u32x4 w; w.x = pk2(g[0], g[1]); w.y = pk2(g[2], g[3]); w.z = pk2(g[4], g[5]); w.w = pk2(g[6], g[7]); ((u32x4*)yr)[i] = w; }
    }
}

typedef short bf16x8 __attribute__((ext_vector_type(8)));
typedef short s16x4 __attribute__((ext_vector_type(4)));
typedef float f32x16 __attribute__((ext_vector_type(16)));
typedef float f32x2_t __attribute__((ext_vector_type(2)));
typedef __bf16 bf16x2_t __attribute__((ext_vector_type(2)));
__device__ __forceinline__ unsigned cvtpk(float lo, float hi) { f32x2_t v = {lo, hi}; bf16x2_t b = __builtin_convertvector(v, bf16x2_t); return __builtin_bit_cast(unsigned, b); }
#define PACK8(P, B) __builtin_bit_cast(bf16x8, (u32x4){cvtpk(P[B], P[B + 1]), cvtpk(P[B + 2], P[B + 3]), cvtpk(P[B + 4], P[B + 5]), cvtpk(P[B + 6], P[B + 7])})
#define MFMA32(a, b, c) __builtin_amdgcn_mfma_f32_32x32x16_bf16((a), (b), (c), 0, 0, 0)
__device__ __forceinline__ int crow(int r, int hi) { return (r & 3) + 8 * (r >> 2) + 4 * hi; }
constexpr int KP = 72, VP = 68, SP = 68;
constexpr int L_K = 0, L_V = L_K + 2 * 64 * KP * 2, L_C2 = L_V + 2 * 64 * VP * 2, L_WSF = L_C2 + SEQ * 4, L_STG = L_WSF + 8 * 64 * 4, L_MIX_END = L_STG + 8 * 32 * SP * 4;
static_assert(L_MIX_END <= LDS_BYTES, "mixer LDS map");
constexpr float C2S = 0.125f * 1.4426950408889634f;

template <int MODE> __device__ __forceinline__ void attn_unit(const Params& P, int l, int b, int hh, int qb, unsigned char* lds) {
    int tid = threadIdx.x; asm volatile("" : "+v"(tid));
    const int lane = tid & 63, wave = __builtin_amdgcn_readfirstlane(tid >> 6), r32 = lane & 31, hi = lane >> 5;
    const bf16_t* base = (const bf16_t*)(P.ws + WS_QKVG) + (size_t)b * SEQ * NQ + hh * 64;
    const int q0 = qb * 256, qw0 = q0 + wave * 32, t = qw0 + r32;
    bf16_t* Ks = (bf16_t*)(lds + L_K); bf16_t* Vt = (bf16_t*)(lds + L_V); float* c2s = (float*)(lds + L_C2);
    float* wsf = (float*)(lds + L_WSF) + wave * 64; float* stg = (float*)(lds + L_STG) + wave * (32 * SP);
    const int NT = 4 * (qb + 1);
    __syncthreads();
    float ct2 = 0.f, lg2 = 0.f;
    if (MODE == 0) {
        const float* cg_ = (const float*)(P.ws + WS_C) + (size_t)(b * HF + hh) * SEQ;
        for (int i = tid; i < q0 + 256; i += 512) c2s[i] = cg_[i] * LOG2E;
        ct2 = cg_[t] * LOG2E;
    }
    if (MODE == 2) lg2 = log2f(1.f - exp2f(-5.f - (float)(hh - HF)));
    bf16x8 qf[4];
#pragma unroll
    for (int d0 = 0; d0 < 4; ++d0) qf[d0] = *(const bf16x8*)(base + (size_t)t * NQ + d0 * 16 + hi * 8);
    const int lk_key = tid >> 3, lk_ch = tid & 7, lv_key = tid & 63, lv_ch = tid >> 6;
    const bf16_t* kg = base + 1024 + (size_t)lk_key * NQ + lk_ch * 8;
    const bf16_t* vg = base + 2048 + (size_t)lv_key * NQ + lv_ch * 8;
    const int kt0 = (MODE == 1) ? NT - 1 : 0, kstep = (MODE == 1) ? -1 : 1;
    u32x4 kreg = *(const u32x4*)(kg + (size_t)kt0 * 64 * NQ), vreg = *(const u32x4*)(vg + (size_t)kt0 * 64 * NQ);
    f32x16 o0, o1;
#pragma unroll
    for (int r = 0; r < 16; ++r) { o0[r] = 0.f; o1[r] = 0.f; }
    float m = -INFINITY, lsum = 0.f, R = 0.f;
    for (int it = 0; it < NT; ++it) {
        const int kt = kt0 + kstep * it;
        bf16_t* Kb = Ks + (it & 1) * (64 * KP); bf16_t* Vb = Vt + (it & 1) * (64 * VP);
        *(u32x4*)(Kb + lk_key * KP + lk_ch * 8) = kreg;
        { bf16_t* vd = Vb + (lv_ch * 8) * VP + lv_key;
          vd[0 * VP] = (bf16_t)(vreg.x & 0xffffu); vd[1 * VP] = (bf16_t)(vreg.x >> 16); vd[2 * VP] = (bf16_t)(vreg.y & 0xffffu); vd[3 * VP] = (bf16_t)(vreg.y >> 16);
          vd[4 * VP] = (bf16_t)(vreg.z & 0xffffu); vd[5 * VP] = (bf16_t)(vreg.z >> 16); vd[6 * VP] = (bf16_t)(vreg.w & 0xffffu); vd[7 * VP] = (bf16_t)(vreg.w >> 16); }
        __syncthreads();
        if (it + 1 < NT) { kreg = *(const u32x4*)(kg + (size_t)(kt + kstep) * 64 * NQ); vreg = *(const u32x4*)(vg + (size_t)(kt + kstep) * 64 * NQ); }
        if (64 * kt <= qw0 + 31) {
            f32x16 p0, p1;
#pragma unroll
            for (int r = 0; r < 16; ++r) { p0[r] = 0.f; p1[r] = 0.f; }
#pragma unroll
            for (int d0 = 0; d0 < 4; ++d0) {
                const bf16x8 ka = *(const bf16x8*)(Kb + r32 * KP + d0 * 16 + hi * 8), kb2 = *(const bf16x8*)(Kb + (32 + r32) * KP + d0 * 16 + hi * 8);
                p0 = MFMA32(ka, qf[d0], p0); p1 = MFMA32(kb2, qf[d0], p1);
            }
            const int key0 = 64 * kt + 4 * hi;
            if (MODE == 0) {
                const float* cs = c2s + key0;
#pragma unroll
                for (int g = 0; g < 4; ++g) { const f32x4 ca = *(const f32x4*)(cs + 8 * g), cb = *(const f32x4*)(cs + 32 + 8 * g);
#pragma unroll
                    for (int j = 0; j < 4; ++j) { p0[4 * g + j] = p0[4 * g + j] * C2S + (ct2 - ca[j]); p1[4 * g + j] = p1[4 * g + j] * C2S + (ct2 - cb[j]); } }
                if (64 * kt + 63 > qw0) {
#pragma unroll
                    for (int r = 0; r < 16; ++r) { const int key = key0 + (r & 3) + 8 * (r >> 2); if (key > t) p0[r] = -INFINITY; if (key + 32 > t) p1[r] = -INFINITY; }
                }
                float mx = fmaxf(p0[0], p1[0]);
#pragma unroll
                for (int r = 1; r < 16; ++r) mx = fmaxf(mx, fmaxf(p0[r], p1[r]));
                mx = fmaxf(mx, __shfl_xor(mx, 32));
                const float mn = fmaxf(m, mx), alpha = __builtin_amdgcn_exp2f(m - mn);
                float ps = 0.f;
#pragma unroll
                for (int r = 0; r < 16; ++r) { p0[r] = __builtin_amdgcn_exp2f(p0[r] - mn); p1[r] = __builtin_amdgcn_exp2f(p1[r] - mn); ps += p0[r] + p1[r]; }
                lsum = lsum * alpha + ps; m = mn;
                if (__any(alpha != 1.f)) {
                    if (hi == 0) wsf[r32] = alpha;
                    __builtin_amdgcn_wave_barrier();
#pragma unroll
                    for (int g = 0; g < 4; ++g) { const f32x4 a = *(const f32x4*)(wsf + 8 * g + 4 * hi);
#pragma unroll
                        for (int j = 0; j < 4; ++j) { o0[4 * g + j] *= a[j]; o1[4 * g + j] *= a[j]; } }
                    __builtin_amdgcn_wave_barrier();
                }
            } else if (MODE == 1) {
                const bool diag = (64 * kt + 63 >= qw0);
#pragma unroll
                for (int r = 0; r < 16; ++r) { p0[r] *= C2S; p1[r] *= C2S; }
                if (diag) {
#pragma unroll
                    for (int r = 0; r < 16; ++r) { const int key = key0 + (r & 3) + 8 * (r >> 2); if (key >= t) p0[r] = -1e30f; if (key + 32 >= t) p1[r] = -1e30f; }
                }
                float lr[32];
#pragma unroll
                for (int r = 0; r < 16; ++r) {
                    const float za = p0[r], zb = p1[r];
                    const float spa = __builtin_amdgcn_logf(1.f + __builtin_amdgcn_exp2f(-fabsf(za))), spb = __builtin_amdgcn_logf(1.f + __builtin_amdgcn_exp2f(-fabsf(zb)));
                    lr[r] = (fminf(za, 0.f) - spa) - za; lr[16 + r] = (fminf(zb, 0.f) - spb) - zb;
                }
                float SI[9]; SI[8] = 0.f;
#pragma unroll
                for (int i = 7; i >= 0; --i) SI[i] = SI[i + 1] + ((lr[4 * i] + lr[4 * i + 1]) + (lr[4 * i + 2] + lr[4 * i + 3]));
                float E[8];
#pragma unroll
                for (int i = 0; i < 8; ++i) { const float snd = hi ? SI[i] : SI[i + 1]; E[i] = SI[i + 1] + __shfl_xor(snd, 32); }
                const float T = SI[0] + __shfl_xor(SI[0], 32);
#pragma unroll
                for (int i = 0; i < 8; ++i) {
                    const float bs = R + E[i];
                    const float w2 = lr[4 * i + 3], w1 = w2 + lr[4 * i + 2], w0 = w1 + lr[4 * i + 1];
                    if (i < 4) { p0[4 * i + 3] = __builtin_amdgcn_exp2f(p0[4 * i + 3] + lr[4 * i + 3] + bs); p0[4 * i + 2] = __builtin_amdgcn_exp2f(p0[4 * i + 2] + lr[4 * i + 2] + bs + w2);
                                 p0[4 * i + 1] = __builtin_amdgcn_exp2f(p0[4 * i + 1] + lr[4 * i + 1] + bs + w1); p0[4 * i + 0] = __builtin_amdgcn_exp2f(p0[4 * i + 0] + lr[4 * i + 0] + bs + w0); }
                    else { const int q = 4 * (i - 4);
                                 p1[q + 3] = __builtin_amdgcn_exp2f(p1[q + 3] + lr[4 * i + 3] + bs); p1[q + 2] = __builtin_amdgcn_exp2f(p1[q + 2] + lr[4 * i + 2] + bs + w2);
                                 p1[q + 1] = __builtin_amdgcn_exp2f(p1[q + 1] + lr[4 * i + 1] + bs + w1); p1[q + 0] = __builtin_amdgcn_exp2f(p1[q + 0] + lr[4 * i + 0] + bs + w0); }
                }
                R += T;
            } else {
                const bool diag = (64 * kt + 63 > qw0);
#pragma unroll
                for (int r = 0; r < 16; ++r) { const int key = key0 + (r & 3) + 8 * (r >> 2);
                    p0[r] *= __builtin_amdgcn_exp2f((float)(t - key) * lg2); p1[r] *= __builtin_amdgcn_exp2f((float)(t - key - 32) * lg2);
                    if (diag) { if (key > t) p0[r] = 0.f; if (key + 32 > t) p1[r] = 0.f; } }
            }
#pragma unroll
            for (int blk = 0; blk < 2; ++blk)
#pragma unroll
                for (int s = 0; s < 2; ++s) {
                    const bf16x8 pf = blk ? PACK8(p1, 8 * s) : PACK8(p0, 8 * s);
                    const bf16_t* vp = Vb + r32 * VP + blk * 32 + 16 * s + 4 * hi;
                    const s16x4 a0 = *(const s16x4*)(vp), a1 = *(const s16x4*)(vp + 8), b0 = *(const s16x4*)(vp + 32 * VP), b1 = *(const s16x4*)(vp + 32 * VP + 8);
                    o0 = MFMA32(pf, __builtin_shufflevector(a0, a1, 0, 1, 2, 3, 4, 5, 6, 7), o0);
                    o1 = MFMA32(pf, __builtin_shufflevector(b0, b1, 0, 1, 2, 3, 4, 5, 6, 7), o1);
                }
        }
    }
    if (MODE == 0) {
        lsum += __shfl_xor(lsum, 32);
        if (hi == 0) wsf[r32] = 1.f / lsum;
        __builtin_amdgcn_wave_barrier();
    }
#pragma unroll
    for (int g = 0; g < 4; ++g) {
        f32x4 a = {1.f, 1.f, 1.f, 1.f};
        if (MODE == 0) a = *(const f32x4*)(wsf + 8 * g + 4 * hi);
#pragma unroll
        for (int j = 0; j < 4; ++j) { const int row = 8 * g + 4 * hi + j; stg[row * SP + r32] = o0[4 * g + j] * a[j]; stg[row * SP + 32 + r32] = o1[4 * g + j] * a[j]; }
    }
    __builtin_amdgcn_wave_barrier();
    bf16_t* Y = (bf16_t*)(P.ws + WS_Y) + ((size_t)b * SEQ + qw0) * DM + hh * 64;
    const float* gg = P.gn_gain + l * (HR * 64) + (MODE == 2 ? (hh - HF) * 64 : 0);
#pragma unroll
    for (int i = 0; i < 8; ++i) {
        const int row = i * 4 + (lane >> 4), ch = lane & 15;
        f32x4 ov = *(const f32x4*)(stg + row * SP + ch * 4);
        if (MODE == 2) {
            float s = (ov[0] + ov[1]) + (ov[2] + ov[3]);
            s += __shfl_xor(s, 1); s += __shfl_xor(s, 2); s += __shfl_xor(s, 4); s += __shfl_xor(s, 8);
            const float mu = s * (1.f / 64.f); ov = ov - mu;
            float v2 = (ov[0] * ov[0] + ov[1] * ov[1]) + (ov[2] * ov[2] + ov[3] * ov[3]);
            v2 += __shfl_xor(v2, 1); v2 += __shfl_xor(v2, 2); v2 += __shfl_xor(v2, 4); v2 += __shfl_xor(v2, 8);
            const float rs = rsqrtf(v2 * (1.f / 64.f) + GN_EPS); const f32x4 gv = *(const f32x4*)(gg + ch * 4);
            ov = ov * rs * gv;
        }
        const u32x2 gt = *(const u32x2*)(base + (size_t)(qw0 + row) * NQ + 3072 + ch * 4);
        const float g0 = bflo(gt.x), g1 = bfhi(gt.x), g2 = bflo(gt.y), g3 = bfhi(gt.y);
        u32x2 w; w.x = cvtpk(ov[0] * g0 / (1.f + __expf(-g0)), ov[1] * g1 / (1.f + __expf(-g1))); w.y = cvtpk(ov[2] * g2 / (1.f + __expf(-g2)), ov[3] * g3 / (1.f + __expf(-g3)));
        *(u32x2*)(Y + (size_t)row * DM + ch * 4) = w;
    }
}

#ifndef MIX_MASK
#define MIX_MASK 7
#endif
__device__ __forceinline__ void mixer_phase(const Params& P, int l, unsigned char* lds) {
    for (int u = blockIdx.x; u < 8 * 256; u += gridDim.x) {
        const int qb = 7 - u / 256, hb = u % 256, b = hb >> 4, hh = hb & 15;
        if (hh < HF) { if (MIX_MASK & 1) attn_unit<0>(P, l, b, hh, qb, lds); }
        else if (hh < HF + HR) { if (MIX_MASK & 2) attn_unit<2>(P, l, b, hh, qb, lds); }
        else { if (MIX_MASK & 4) attn_unit<1>(P, l, b, hh, qb, lds); }
    }
    __syncthreads();
}

__device__ __forceinline__ void phase4(const Params& P, int l, unsigned char* lds) {
    int tid = threadIdx.x; asm volatile("" : "+v"(tid));
    const int lane = tid & 63, wave = tid >> 6;
    const int gw = blockIdx.x * 8 + wave, NGW = gridDim.x * 8;
    float* wfs = (float*)lds;
    if (l + 1 < NL) { stage_wf(P, l + 1, wfs); }
    __syncthreads();
    const float* gp = P.ln_gain + l * DM; const float* bp = P.ln_bias + l * DM;
    f32x4 g[4], bb[4];
#pragma unroll
    for (int j = 0; j < 4; ++j) { g[j] = ((const f32x4*)gp)[lane + 64 * j]; bb[j] = ((const f32x4*)bp)[lane + 64 * j]; }
    for (int m = gw; m < MTOK; m += NGW) {
        f32x4* xr = (f32x4*)(P.out + (size_t)m * DM) + lane; f32x4 v[4]; float s = 0.f;
#pragma unroll
        for (int j = 0; j < 4; ++j) { v[j] = xr[64 * j]; s += (v[j].x + v[j].y) + (v[j].z + v[j].w); }
        const float mean = wave_sum(s) * (1.f / DM); float s2 = 0.f;
#pragma unroll
        for (int j = 0; j < 4; ++j) { v[j] = v[j] - mean; s2 += (v[j].x * v[j].x + v[j].y * v[j].y) + (v[j].z * v[j].z + v[j].w * v[j].w); }
        const float rstd = rsqrtf(wave_sum(s2) * (1.f / DM) + LN_EPS);
#pragma unroll
        for (int j = 0; j < 4; ++j) { v[j] = v[j] * rstd * g[j] + bb[j]; xr[64 * j] = v[j]; }
        if (l + 1 < NL) row_emit(v, (bf16_t*)(P.ws + WS_XB) + (size_t)m * DM, wfs, (float*)(P.ws + WS_FLOG) + (size_t)m * 8, lane);
    }
    __syncthreads();
}

#if NAIVE_MIX
__global__ void __launch_bounds__(512) naive_mix_kernel(Params P, int l) { naive_mixers(P, l); }
#endif
__global__ void __launch_bounds__(512) hybrid_fwd(Params P) {
    extern __shared__ __attribute__((aligned(16))) unsigned char lds[];
    cg::grid_group grid = cg::this_grid();
    unsigned char* ws = P.ws;
    const int lo = P.ph_lo, hi = P.ph_hi;
#define RUN(k) (lo <= (k) && (k) < hi)
#define SEAM(k) do { if (RUN(k) && RUN((k) + 1)) grid.sync(); } while (0)
    if (RUN(0)) phase0(P, lds);
    SEAM(0);
#pragma unroll
    for (int l = 0; l < NL; ++l) {
        if (RUN(1 + 4 * l)) {
          fgate_cumsum(P, l);
          pg8::Gemm g{(const bf16_t*)(ws + WS_XB), (const bf16_t*)(ws + WS_WIN) + (size_t)l * NQ * DM, MTOK, NQ, DM};
          pg8::StaticOrder S; S.init(MTOK, NQ, (int)gridDim.x, (int)blockIdx.x);
          pg8::EpiInProj E{(bf16_t*)(ws + WS_QKVG), (const float*)(ws + WS_ROPE)};
          pg8::gemm_phase<pg8::EpiInProj, pg8::StaticOrder, true, true>((PG8_LAS unsigned char*)lds, g, S, E); }
        SEAM(1 + 4 * l);
        if (RUN(2 + 4 * l)) mixer_phase(P, l, lds);
        SEAM(2 + 4 * l);
        if (RUN(3 + 4 * l)) {
          pg8::Gemm g{(const bf16_t*)(ws + WS_Y), (const bf16_t*)(ws + WS_WOUT) + (size_t)l * DM * DM, MTOK, DM, DM};
          pg8::StaticOrder S; S.init(MTOK, DM, (int)gridDim.x, (int)blockIdx.x);
          pg8::EpiResid E{l == 0 ? P.x : P.out, P.out, DM, DN_ALPHA};
          pg8::gemm_phase<pg8::EpiResid, pg8::StaticOrder, true, true>((PG8_LAS unsigned char*)lds, g, S, E); }
        SEAM(3 + 4 * l);
        if (RUN(4 + 4 * l)) phase4(P, l, lds);
        SEAM(4 + 4 * l);
    }
#undef RUN
#undef SEAM
}

extern "C" void kernel_launch(void* const* d_in, const int* in_sizes, int n_in, void* d_out, int out_size, void* d_ws, size_t ws_size, hipStream_t stream) {
    static int grid_blocks = 0;
    if (grid_blocks == 0) {
        if (n_in != 7 || out_size != MTOK * DM || ws_size < WS_END) { fprintf(stderr, "kernel_launch: unexpected shapes (n_in %d out %d ws %zu)\n", n_in, out_size, ws_size); grid_blocks = -1; return; }
        int dev = 0, cus = 0, per_cu = 0;
        (void)hipGetDevice(&dev);
        (void)hipDeviceGetAttribute(&cus, hipDeviceAttributeMultiprocessorCount, dev);
        if (hipFuncSetAttribute((const void*)hybrid_fwd, hipFuncAttributeMaxDynamicSharedMemorySize, LDS_BYTES) != hipSuccess) { fprintf(stderr, "kernel_launch: hipFuncSetAttribute failed\n"); grid_blocks = -1; return; }
        if (hipOccupancyMaxActiveBlocksPerMultiprocessor(&per_cu, (const void*)hybrid_fwd, 512, LDS_BYTES) != hipSuccess || per_cu < 1) { fprintf(stderr, "kernel_launch: occupancy query failed (%d)\n", per_cu); per_cu = 1; (void)hipGetLastError(); }
        grid_blocks = cus * per_cu;
    }
    if (grid_blocks < 0) return;
    Params p{};
    p.x = (const float*)d_in[0]; p.w_in = (const float*)d_in[1]; p.b_fgate = (const float*)d_in[2]; p.gn_gain = (const float*)d_in[3];
    p.w_out = (const float*)d_in[4]; p.ln_gain = (const float*)d_in[5]; p.ln_bias = (const float*)d_in[6];
    p.out = (float*)d_out; p.ws = (unsigned char*)d_ws;
#if NAIVE_MIX
    const int cuts[4] = {0, 3, 7, 9};
    for (int i = 0; i < 3; ++i) {
        p.ph_lo = cuts[i]; p.ph_hi = cuts[i + 1];
        void* args[] = {&p};
        hipError_t e = hipLaunchCooperativeKernel((const void*)hybrid_fwd, dim3(grid_blocks), dim3(512), args, LDS_BYTES, stream);
        if (e != hipSuccess) fprintf(stderr, "cooperative launch failed: %s (grid %d)\n", hipGetErrorString(e), grid_blocks);
        if (i < 2) hipLaunchKernelGGL(naive_mix_kernel, dim3(grid_blocks), dim3(512), 0, stream, p, i);
    }
#else
    p.ph_lo = 0; p.ph_hi = 9;
    void* args[] = {&p};
    hipError_t e = hipLaunchCooperativeKernel((const void*)hybrid_fwd, dim3(grid_blocks), dim3(512), args, LDS_BYTES, stream);
    if (e != hipSuccess) fprintf(stderr, "cooperative launch failed: %s (grid %d)\n", hipGetErrorString(e), grid_blocks);
#endif
}
```

```cpp
#include <hip/hip_runtime.h>
#include <hip/hip_cooperative_groups.h>
#include <cstdio>
#include <cstdint>
#include <cmath>
namespace cg = cooperative_groups;
namespace pg8 {
#define PG8_LAS __attribute__((address_space(3)))
typedef unsigned short bf16_t;
typedef short bf16x8 __attribute__((ext_vector_type(8)));
typedef float f32x4 __attribute__((ext_vector_type(4)));
typedef unsigned u32x4 __attribute__((ext_vector_type(4)));
constexpr int BM = 256, BK = 64, HALF = 128, HTB = HALF * BK * 2  , STAGE_BYTES = 8 * HTB, NXCD = 8, WGM = 8;

__host__ __device__ __forceinline__ int lds_byte(int r, int c) { const int st = (r >> 4) * 2 + (c >> 5), rr = r & 15, cc = c & 31, ob = rr * 64 + cc * 2; return st * 1024 + (ob ^ (((ob >> 9) & 1) << 5)); }
__host__ __device__ __forceinline__ void stage_rc(int b, int& R, int& C) { const int st = b / 1024, sb = b % 1024, swz = sb ^ (((sb >> 9) & 1) << 5); R = (st >> 1) * 16 + swz / 64; C = (st & 1) * 32 + (swz % 64) / 2; }
__host__ __device__ __forceinline__ int perm32(int rho) { const int n = rho >> 4, i = rho & 15; return 8 * (i >> 2) + 4 * n + (i & 3); }

struct Unit { int pm, pn; };
struct Gemm { const bf16_t* A; const bf16_t* Bt; int M, N, K; };

struct StaticOrder {
    int nM, nN, nwg, G, c;
    __host__ __device__ void init(int M, int N, int G_, int c_) { nM = M / BM; nN = N / BM; nwg = nM * nN; G = G_; c = c_; }
    __host__ __device__ bool next(int i, Unit& u) const {
        const long L = (long)i * G + c; if (L >= nwg) return false;
        int wgid = (int)L; { const int q = nwg / NXCD, r = nwg % NXCD, xcd = wgid % NXCD, off = wgid / NXCD; wgid = (xcd < r ? xcd * (q + 1) : r * (q + 1) + (xcd - r) * q) + off; }
        const int nig = WGM * nN, gid = wgid / nig, fm = gid * WGM, gsz = (nM - fm) < WGM ? (nM - fm) : WGM;
        u.pm = fm + ((wgid % nig) % gsz); u.pn = (wgid % nig) / gsz; return true;
    }
    __device__ __forceinline__ void a_ready(const Unit&) const {}
    __device__ __forceinline__ void done(const Unit&) const {}
};

__device__ __forceinline__ unsigned cvt_pk_bf16(float lo, float hi) { unsigned r; asm volatile("v_cvt_pk_bf16_f32 %0, %1, %2" : "=v"(r) : "v"(lo), "v"(hi)); return r; }
typedef float f32x2 __attribute__((ext_vector_type(2)));
__device__ __forceinline__ f32x2 gelu_pk(f32x2 v) {
    const f32x2 av = __builtin_elementwise_abs(v), d = av * 0.2316418882f + 1.0f;
    f32x2 t; t.x = __builtin_amdgcn_rcpf(d.x); t.y = __builtin_amdgcn_rcpf(d.y);
    f32x2 q = t * 0.5307027145f + (-0.7265760135f); q = q * t + 0.7107068705f; q = q * t + (-0.142248368f); q = q * t + 0.127414796f; q = q * t;
    const f32x2 s = (v * v) * (-0.72134752044f);
    f32x2 e; e.x = __builtin_amdgcn_exp2f(s.x); e.y = __builtin_amdgcn_exp2f(s.y);
    const f32x2 m = v * (q * e), r = v - m;
    f32x2 o; o.x = v.x < 0.f ? m.x : r.x; o.y = v.y < 0.f ? m.y : r.y; return o;
}

template <int ACT  > struct EpiBf16 {
    static constexpr bool PERM = true, AFTER_DRAIN = false; static_assert(ACT == 0 || ACT == 1, "EpiBf16: ACT is 0 (none) or 1 (gelu_pk)");
    bf16_t* O; int ldc; const float* bias; int split_cols; size_t split_stride; float scale0;
    __device__ __forceinline__ void operator()(const f32x4 (&acc)[2][2][4][2], const Unit& u, int wr, int wc, int fr, int fq) const {
        const int row0 = u.pm * BM + wr * 64 + fr; int colt = u.pn * BM; bf16_t* base = O;
        float sc = 1.f; if (split_cols) { const int t = colt / split_cols; base += (size_t)t * split_stride; colt -= t * split_cols; if (t == 0) sc = scale0; }
        const int col0 = colt + wc * 32 + 8 * fq, bcol0 = u.pn * BM + wc * 32 + 8 * fq;
        f32x4 bv[2][2];
#pragma unroll
        for (int bj = 0; bj < 2; ++bj)
#pragma unroll
            for (int n = 0; n < 2; ++n) bv[bj][n] = bias ? *(const f32x4*)(bias + bcol0 + bj * HALF + 4 * n) : (f32x4){0.f, 0.f, 0.f, 0.f};
#pragma unroll
        for (int ai = 0; ai < 2; ++ai)
#pragma unroll
            for (int m = 0; m < 4; ++m) { bf16_t* rowp = base + (size_t)(row0 + ai * HALF + m * 16) * ldc + col0;
#pragma unroll
                for (int bj = 0; bj < 2; ++bj) { f32x4 v0 = acc[ai][bj][m][0] + bv[bj][0], v1 = acc[ai][bj][m][1] + bv[bj][1];
                    if (ACT == 1) { f32x2 a = gelu_pk((f32x2){v0[0], v0[1]}), b = gelu_pk((f32x2){v0[2], v0[3]}), c = gelu_pk((f32x2){v1[0], v1[1]}), d = gelu_pk((f32x2){v1[2], v1[3]});
                        v0 = (f32x4){a.x, a.y, b.x, b.y}; v1 = (f32x4){c.x, c.y, d.x, d.y}; }
                    v0 = v0 * sc; v1 = v1 * sc; u32x4 w; w.x = cvt_pk_bf16(v0[0], v0[1]); w.y = cvt_pk_bf16(v0[2], v0[3]); w.z = cvt_pk_bf16(v1[0], v1[1]); w.w = cvt_pk_bf16(v1[2], v1[3]);
                    *(u32x4*)(rowp + bj * HALF) = w; } }
    }
};
struct EpiResid {
    static constexpr bool PERM = true, AFTER_DRAIN = false;
    const float* res; float* out; int ldc; float alpha;
    __device__ __forceinline__ void operator()(const f32x4 (&acc)[2][2][4][2], const Unit& u, int wr, int wc, int fr, int fq) const {
        const int row0 = u.pm * BM + wr * 64 + fr; const int col0 = u.pn * BM + wc * 32 + 8 * fq;
#pragma unroll
        for (int ai = 0; ai < 2; ++ai)
#pragma unroll
            for (int m = 0; m < 4; ++m) { const size_t ro = (size_t)(row0 + ai * HALF + m * 16) * ldc + col0;
#pragma unroll
                for (int bj = 0; bj < 2; ++bj) {
                    const f32x4 r0 = *(const f32x4*)(res + ro + bj * HALF), r1 = *(const f32x4*)(res + ro + bj * HALF + 4);
                    const f32x4 v0 = acc[ai][bj][m][0] + r0 * alpha, v1 = acc[ai][bj][m][1] + r1 * alpha;
                    *(f32x4*)(out + ro + bj * HALF) = v0; *(f32x4*)(out + ro + bj * HALF + 4) = v1; } }
    }
};
struct EpiInProj {
    static constexpr bool PERM = true, AFTER_DRAIN = false;
    bf16_t* O; const float* rope;
    __device__ __forceinline__ void operator()(const f32x4 (&acc)[2][2][4][2], const Unit& u, int wr, int wc, int fr, int fq) const {
        const int row0 = u.pm * BM + wr * 64 + fr;
#pragma unroll
        for (int bj = 0; bj < 2; ++bj) {
            const int colg = u.pn * BM + bj * HALF + wc * 32, col0 = colg + 8 * fq, head = colg >> 6;
            const bool isrot = (head >= 6 && head < 12) || (head >= 22 && head < 28);
            const float sc = head >= 16 ? 0.125f : 1.f;
            const int i0 = ((colg & 63) + 8 * fq) >> 1;
#pragma unroll
            for (int ai = 0; ai < 2; ++ai)
#pragma unroll
                for (int m = 0; m < 4; ++m) {
                    const int row = row0 + ai * HALF + m * 16;
                    f32x4 v0 = acc[ai][bj][m][0], v1 = acc[ai][bj][m][1];
                    if (isrot) {
                        const int pos = row & 2047;
                        const f32x4 c = *(const f32x4*)(rope + pos * 32 + i0), s = *(const f32x4*)(rope + 2048 * 32 + pos * 32 + i0);
                        f32x4 w0, w1;
                        w0[0] = (v0[0] * c[0] - v0[1] * s[0]) * sc; w0[1] = (v0[0] * s[0] + v0[1] * c[0]) * sc;
                        w0[2] = (v0[2] * c[1] - v0[3] * s[1]) * sc; w0[3] = (v0[2] * s[1] + v0[3] * c[1]) * sc;
                        w1[0] = (v1[0] * c[2] - v1[1] * s[2]) * sc; w1[1] = (v1[0] * s[2] + v1[1] * c[2]) * sc;
                        w1[2] = (v1[2] * c[3] - v1[3] * s[3]) * sc; w1[3] = (v1[2] * s[3] + v1[3] * c[3]) * sc;
                        v0 = w0; v1 = w1;
                    }
                    u32x4 w; w.x = cvt_pk_bf16(v0[0], v0[1]); w.y = cvt_pk_bf16(v0[2], v0[3]); w.z = cvt_pk_bf16(v1[0], v1[1]); w.w = cvt_pk_bf16(v1[2], v1[3]);
                    *(u32x4*)(O + (size_t)row * 4096 + col0) = w;
                }
        }
    }
};
template <class Epi, class Sched, bool ALIGN_EPI = false, bool SP2 = false>
__device__ __forceinline__ void gemm_phase(PG8_LAS unsigned char* lds, const Gemm g, const Sched& S, const Epi& E) {
    int tid = threadIdx.x; asm volatile("" : "+v"(tid));
    const int wid = __builtin_amdgcn_readfirstlane(tid >> 6), lane = tid & 63, wr = wid >> 2, wc = wid & 3, fr = lane & 15, fq = lane >> 4;
    const int K = g.K, nt = K / BK;
    unsigned voffA[2], voffB[2];
#pragma unroll
    for (int i = 0; i < 2; ++i) { int R, C; stage_rc(tid * 16 + i * 8192, R, C); const int Rb = Epi::PERM ? ((R & ~31) + perm32(R & 31)) : R;
        voffA[i] = (unsigned)(R * K + C) * 2u; voffB[i] = (unsigned)(Rb * K + C) * 2u; }
    const size_t kstep = (size_t)(BK * 2);
    const size_t hstep = (size_t)HALF * K * 2;
    const size_t tstep = 2 * hstep;
    const unsigned ldsw = (unsigned)wid * 1024u;
    const int aoff = lds_byte(wr * 64 + fr, fq * 8), boff = lds_byte(wc * 32 + fr, fq * 8);
#define PG8_SA(b, h) (((b) * 2 + (h)) * HTB)
#define PG8_SB(b, h) ((4 + (b) * 2 + (h)) * HTB)
#define PG8_STAGE(bufoff, gbase, voff) do { _Pragma("unroll") for (int _i = 0; _i < 2; ++_i) \
        __builtin_amdgcn_global_load_lds((const unsigned*)((const char*)(gbase) + (voff)[_i]), (PG8_LAS unsigned*)(lds + (bufoff) + ldsw + _i * 8192), 16, 0, 0); } while (0)
#define PG8_LDA(dst, b, h) do { _Pragma("unroll") for (int m = 0; m < 4; ++m) _Pragma("unroll") for (int k = 0; k < 2; ++k) dst[m][k] = *(const PG8_LAS bf16x8*)(lds + PG8_SA(b, h) + aoff + m * 2048 + k * 1024); } while (0)
#define PG8_LDB(dst, b, h) do { _Pragma("unroll") for (int n = 0; n < 2; ++n) _Pragma("unroll") for (int k = 0; k < 2; ++k) dst[n][k] = *(const PG8_LAS bf16x8*)(lds + PG8_SB(b, h) + boff + n * 2048 + k * 1024); } while (0)
#define PG8_MMA(ai, bj, At, Bt) do { __builtin_amdgcn_s_setprio(1); _Pragma("unroll") for (int m = 0; m < 4; ++m) _Pragma("unroll") for (int n = 0; n < 2; ++n) _Pragma("unroll") for (int k = 0; k < 2; ++k) \
        acc[ai][bj][m][n] = __builtin_amdgcn_mfma_f32_16x16x32_bf16(Bt[n][k], At[m][k], acc[ai][bj][m][n], 0, 0, 0); __builtin_amdgcn_s_setprio(0); } while (0)
#define PG8_WAIT_V(n) asm volatile("s_waitcnt vmcnt(" #n ")" ::: "memory")
#define PG8_WAIT_L(n) asm volatile("s_waitcnt lgkmcnt(" #n ")" ::: "memory")
#define PG8_BAR __builtin_amdgcn_s_barrier()
#define PG8_SCHED __builtin_amdgcn_sched_barrier(0)
    Unit cur, nxt; int ui = 0;
    if (!S.next(0, cur)) return;
    f32x4 acc[2][2][4][2];
#pragma unroll
    for (int a = 0; a < 2; ++a)
#pragma unroll
        for (int b = 0; b < 2; ++b)
#pragma unroll
            for (int m = 0; m < 4; ++m)
#pragma unroll
                for (int n = 0; n < 2; ++n) acc[a][b][m][n] = (f32x4){0.f, 0.f, 0.f, 0.f};
    bf16x8 At[4][2], B0[2][2], B1[2][2];
    const char* cA = (const char*)g.A + (size_t)cur.pm * tstep; const char* cB = (const char*)g.Bt + (size_t)cur.pn * tstep;
    S.a_ready(cur);
    if constexpr (SP2) {
        PG8_STAGE(PG8_SB(0, 0), cB, voffB); PG8_STAGE(PG8_SB(0, 1), cB + hstep, voffB); PG8_STAGE(PG8_SA(0, 0), cA, voffA); PG8_STAGE(PG8_SA(0, 1), cA + hstep, voffA);
        if (wr == 1) PG8_BAR;
        PG8_WAIT_V(2); PG8_BAR;
        PG8_STAGE(PG8_SB(1, 0), cB + kstep, voffB); PG8_STAGE(PG8_SA(1, 0), cA + kstep, voffA); PG8_STAGE(PG8_SB(1, 1), cB + hstep + kstep, voffB);
        PG8_WAIT_V(6); PG8_BAR;
    } else {
        PG8_STAGE(PG8_SB(0, 0), cB, voffB); PG8_STAGE(PG8_SA(0, 0), cA, voffA); PG8_STAGE(PG8_SB(0, 1), cB + hstep, voffB); PG8_STAGE(PG8_SA(0, 1), cA + hstep, voffA);
        if (wr == 1) PG8_BAR;
        PG8_WAIT_V(4); PG8_BAR;
        PG8_STAGE(PG8_SB(1, 0), cB + kstep, voffB); PG8_STAGE(PG8_SA(1, 0), cA + kstep, voffA); PG8_STAGE(PG8_SB(1, 1), cB + hstep + kstep, voffB);
        PG8_WAIT_V(6); PG8_BAR;
    }
    for (;;) {
        const bool has_next = S.next(ui + 1, nxt);
        const char* nA = has_next ? (const char*)g.A + (size_t)nxt.pm * tstep : cA; const char* nB = has_next ? (const char*)g.Bt + (size_t)nxt.pn * tstep : cB;
        for (int t = 0; t < nt; t += 2) {
            const bool last = (t == nt - 2);
            const char* a1 = cA + (size_t)(t + 1) * kstep;
            const char* a2 = last ? nA : cA + (size_t)(t + 2) * kstep; const char* b2 = last ? nB : cB + (size_t)(t + 2) * kstep;
            const char* a3 = a2 + kstep; const char* b3 = b2 + kstep;
            if (last && has_next) S.a_ready(nxt);
            if constexpr (SP2) {
            PG8_LDB(B0, 0, 0); PG8_LDB(B1, 0, 1); PG8_SCHED; PG8_LDA(At, 0, 0); PG8_STAGE(PG8_SA(1, 1), a1 + hstep, voffA);
            PG8_WAIT_V(8); PG8_WAIT_L(0); PG8_BAR; PG8_MMA(0, 0, At, B0); PG8_MMA(0, 1, At, B1); PG8_BAR; PG8_SCHED;
            PG8_LDA(At, 0, 1); PG8_STAGE(PG8_SB(0, 0), b2, voffB); PG8_STAGE(PG8_SB(0, 1), b2 + hstep, voffB); PG8_STAGE(PG8_SA(0, 0), a2, voffA);
            PG8_WAIT_V(8); PG8_WAIT_L(0); PG8_BAR; PG8_MMA(1, 0, At, B0); PG8_MMA(1, 1, At, B1); PG8_BAR; PG8_SCHED;
            PG8_LDB(B0, 1, 0); PG8_LDB(B1, 1, 1); PG8_SCHED; PG8_LDA(At, 1, 0); PG8_STAGE(PG8_SA(0, 1), a2 + hstep, voffA);
            PG8_WAIT_V(8); PG8_WAIT_L(0); PG8_BAR; PG8_MMA(0, 0, At, B0); PG8_MMA(0, 1, At, B1); PG8_BAR; PG8_SCHED;
            PG8_LDA(At, 1, 1); PG8_STAGE(PG8_SB(1, 0), b3, voffB); PG8_STAGE(PG8_SB(1, 1), b3 + hstep, voffB); PG8_STAGE(PG8_SA(1, 0), a3, voffA);
            PG8_WAIT_V(8); PG8_WAIT_L(0); PG8_BAR; PG8_MMA(1, 0, At, B0); PG8_MMA(1, 1, At, B1); PG8_BAR; PG8_SCHED;
            } else {
            PG8_LDB(B0, 0, 0); PG8_SCHED; PG8_LDA(At, 0, 0); PG8_STAGE(PG8_SA(1, 1), a1 + hstep, voffA);
            PG8_WAIT_L(8); PG8_BAR; PG8_WAIT_L(0); PG8_MMA(0, 0, At, B0); PG8_BAR; PG8_SCHED;
            PG8_LDB(B1, 0, 1); PG8_STAGE(PG8_SB(0, 0), b2, voffB);
            PG8_BAR; PG8_WAIT_L(0); PG8_MMA(0, 1, At, B1); PG8_BAR;
            PG8_LDA(At, 0, 1); PG8_STAGE(PG8_SA(0, 0), a2, voffA);
            PG8_BAR; PG8_WAIT_L(0); PG8_MMA(1, 0, At, B0); PG8_BAR; PG8_SCHED;
            PG8_STAGE(PG8_SB(0, 1), b2 + hstep, voffB);
            PG8_WAIT_V(6); PG8_BAR; PG8_MMA(1, 1, At, B1); PG8_BAR;
            PG8_LDB(B0, 1, 0); PG8_SCHED; PG8_LDA(At, 1, 0); PG8_STAGE(PG8_SA(0, 1), a2 + hstep, voffA);
            PG8_WAIT_L(8); PG8_BAR; PG8_WAIT_L(0); PG8_MMA(0, 0, At, B0); PG8_BAR; PG8_SCHED;
            PG8_LDB(B1, 1, 1); PG8_STAGE(PG8_SB(1, 0), b3, voffB);
            PG8_BAR; PG8_WAIT_L(0); PG8_MMA(0, 1, At, B1); PG8_BAR;
            PG8_LDA(At, 1, 1); PG8_STAGE(PG8_SA(1, 0), a3, voffA);
            PG8_BAR; PG8_WAIT_L(0); PG8_MMA(1, 0, At, B0); PG8_BAR; PG8_SCHED;
            PG8_STAGE(PG8_SB(1, 1), b3 + hstep, voffB);
            PG8_WAIT_V(6); PG8_BAR; PG8_MMA(1, 1, At, B1); PG8_BAR;
            }
        }
        if constexpr (ALIGN_EPI) { if (wr == 0) PG8_BAR; }
        if constexpr (!Epi::AFTER_DRAIN) { E(acc, cur, wr, wc, fr, fq); S.done(cur); }
        if (!has_next) break;
#pragma unroll
        for (int a = 0; a < 2; ++a)
#pragma unroll
            for (int b = 0; b < 2; ++b)
#pragma unroll
                for (int m = 0; m < 4; ++m)
#pragma unroll
                    for (int n = 0; n < 2; ++n) acc[a][b][m][n] = (f32x4){0.f, 0.f, 0.f, 0.f};
        cur = nxt; cA = nA; cB = nB; ++ui;
        if constexpr (ALIGN_EPI) { if (wr == 1) PG8_BAR; }
    }
    PG8_WAIT_V(0);
    if constexpr (!ALIGN_EPI) { if (wr == 0) PG8_BAR; }
    PG8_BAR;
    if constexpr (Epi::AFTER_DRAIN) { E.fused(acc, cur, wr, wc, fr, fq, lds, wid, lane); S.done(cur); }
#undef PG8_SA
#undef PG8_SB
#undef PG8_STAGE
#undef PG8_LDA
#undef PG8_LDB
#undef PG8_MMA
#undef PG8_WAIT_V
#undef PG8_WAIT_L
#undef PG8_BAR
#undef PG8_SCHED
}
}

#ifndef MIX_MASK
#define MIX_MASK 7
#endif
#define NAIVE_MIX (MIX_MASK != 7)
constexpr int NB = 16, SEQ = 2048, DM = 1024, MTOK = NB * SEQ, NQ = 4096, DIN = 4102, NL = 2;
constexpr int HF = 6, HR = 6, HS = 4, HD = 64;
constexpr float LN_EPS = 1e-5f, GN_EPS = 1e-5f;
constexpr float DN_ALPHA = 1.4142135623730951f;
constexpr float LOG2E = 1.4426950408889634f;
typedef unsigned short bf16_t;
typedef float f32x4 __attribute__((ext_vector_type(4)));
typedef unsigned u32x4 __attribute__((ext_vector_type(4)));
typedef unsigned u32x2 __attribute__((ext_vector_type(2)));

constexpr size_t MiB = 1u << 20;
constexpr size_t WS_QKVG = 0;
constexpr size_t WS_Y    = 256 * MiB;
constexpr size_t WS_XB   = 320 * MiB;
constexpr size_t WS_WIN  = 384 * MiB;
constexpr size_t WS_WOUT = 400 * MiB;
constexpr size_t WS_FLOG = 404 * MiB;
constexpr size_t WS_C    = 405 * MiB;
constexpr size_t WS_ROPE = 406 * MiB;
constexpr size_t WS_CTR  = 407 * MiB;
constexpr size_t WS_END  = 408 * MiB;

constexpr int LDS_BYTES = 147456;

struct Params {
    const float *x, *w_in, *b_fgate, *gn_gain, *w_out, *ln_gain, *ln_bias;
    float* out; unsigned char* ws;
    int ph_lo, ph_hi;
};

__device__ __forceinline__ unsigned f2bf(float f) { unsigned u = __builtin_bit_cast(unsigned, f); return (u + 0x7fffu + ((u >> 16) & 1u)) >> 16; }
__device__ __forceinline__ unsigned pk2(float lo, float hi) { return f2bf(lo) | (f2bf(hi) << 16); }
__device__ __forceinline__ float bflo(unsigned u) { return __builtin_bit_cast(float, u << 16); }
__device__ __forceinline__ float bfhi(unsigned u) { return __builtin_bit_cast(float, u & 0xffff0000u); }
__device__ __forceinline__ float wave_sum(float v) {
#pragma unroll
    for (int o = 1; o < 64; o <<= 1) v += __shfl_xor(v, o);
    return v;
}
__device__ __forceinline__ float logsig_acc(float z) { return fminf(z, 0.f) - log1pf(expf(-fabsf(z))); }

__device__ __forceinline__ int rowmap_in(int n) {
    const bool r = (n >= 384 && n < 768) || (n >= 1408 && n < 1792); const int d = n & 63; return r ? (n & ~63) + ((d & 31) << 1) + (d >> 5) : n;
}
template <bool MAP> __device__ __forceinline__ void transpose_item(const float* W, int ldw, int K, bf16_t* WT, float* scr, int kb, int nb, int lane) {
    const int k0 = 64 * kb, n0 = 32 * nb;
#pragma unroll 8
    for (int i = 0; i < 32; ++i) { const int kk = 2 * i + (lane >> 5); scr[kk * 33 + (lane & 31)] = W[(size_t)(k0 + kk) * ldw + n0 + (lane & 31)]; }
    __builtin_amdgcn_wave_barrier(); asm volatile("s_waitcnt lgkmcnt(0)" ::: "memory");
    const int c = lane & 7;
#pragma unroll
    for (int j = 0; j < 4; ++j) { const int n = (lane >> 3) + 8 * j; const float* s = scr + (8 * c) * 33 + n;
        u32x4 o; o.x = pk2(s[0 * 33], s[1 * 33]); o.y = pk2(s[2 * 33], s[3 * 33]); o.z = pk2(s[4 * 33], s[5 * 33]); o.w = pk2(s[6 * 33], s[7 * 33]);
        const int nr = MAP ? rowmap_in(n0 + n) : (n0 + n); *(u32x4*)(WT + (size_t)nr * K + k0 + 8 * c) = o; }
    __builtin_amdgcn_wave_barrier(); asm volatile("s_waitcnt lgkmcnt(0)" ::: "memory");
}

__device__ __forceinline__ void stage_wf(const Params& P, int l, float* wfs) {
    for (int i = threadIdx.x; i < 6 * 1024; i += 512) { const int k = i / 6, h = i % 6; wfs[h * 1024 + k] = P.w_in[((size_t)l * DM + k) * DIN + NQ + h]; }
}
__device__ __forceinline__ void row_emit(const f32x4 (&v)[4], bf16_t* xbrow, const float* wfs, float* flogrow, int lane) {
#pragma unroll
    for (int j = 0; j < 4; ++j) { u32x2 o; o.x = pk2(v[j].x, v[j].y); o.y = pk2(v[j].z, v[j].w); ((u32x2*)xbrow)[lane + 64 * j] = o; }
    float a0 = 0.f, a1 = 0.f, a2 = 0.f, a3 = 0.f, a4 = 0.f, a5 = 0.f;
#pragma unroll
    for (int j = 0; j < 4; ++j) {
        const float* wp = wfs + 4 * lane + 256 * j;
        f32x4 w;
        w = *(const f32x4*)(wp);          a0 += v[j].x * w.x + v[j].y * w.y + v[j].z * w.z + v[j].w * w.w;
        w = *(const f32x4*)(wp + 1024);   a1 += v[j].x * w.x + v[j].y * w.y + v[j].z * w.z + v[j].w * w.w;
        w = *(const f32x4*)(wp + 2048);   a2 += v[j].x * w.x + v[j].y * w.y + v[j].z * w.z + v[j].w * w.w;
        w = *(const f32x4*)(wp + 3072);   a3 += v[j].x * w.x + v[j].y * w.y + v[j].z * w.z + v[j].w * w.w;
        w = *(const f32x4*)(wp + 4096);   a4 += v[j].x * w.x + v[j].y * w.y + v[j].z * w.z + v[j].w * w.w;
        w = *(const f32x4*)(wp + 5120);   a5 += v[j].x * w.x + v[j].y * w.y + v[j].z * w.z + v[j].w * w.w;
    }
    a0 = wave_sum(a0); a1 = wave_sum(a1); a2 = wave_sum(a2); a3 = wave_sum(a3); a4 = wave_sum(a4); a5 = wave_sum(a5);
    float r = a0; if (lane == 1) r = a1; if (lane == 2) r = a2; if (lane == 3) r = a3; if (lane == 4) r = a4; if (lane == 5) r = a5;
    if (lane < 6) flogrow[lane] = r;
}

__device__ __forceinline__ void phase0(const Params& P, unsigned char* lds) {
    int tid = threadIdx.x; asm volatile("" : "+v"(tid));
    const int lane = tid & 63, wave = tid >> 6;
    const int gw = blockIdx.x * 8 + wave, NGW = gridDim.x * 8;
    unsigned char* ws = P.ws;
    if (blockIdx.x == 0 && tid < 64) ((unsigned*)(ws + WS_CTR))[tid] = 0u;
    float* scr = (float*)lds + wave * (64 * 33);
    float* wfs = (float*)(lds + 8 * 64 * 33 * 4);
    stage_wf(P, 0, wfs);
    constexpr int I_IN = (DM / 64) * (NQ / 32), I_OUT = (DM / 64) * (DM / 32);
    for (int it = gw; it < NL * (I_IN + I_OUT); it += NGW) {
        int r = it; const int l = r / (I_IN + I_OUT); r -= l * (I_IN + I_OUT);
        if (r < I_IN) transpose_item<true>(P.w_in + (size_t)l * DM * DIN, DIN, DM, (bf16_t*)(ws + WS_WIN) + (size_t)l * NQ * DM, scr, r / (NQ / 32), r % (NQ / 32), lane);
        else { r -= I_IN; transpose_item<false>(P.w_out + (size_t)l * DM * DM, DM, DM, (bf16_t*)(ws + WS_WOUT) + (size_t)l * DM * DM, scr, r / (DM / 32), r % (DM / 32), lane); }
    }
    for (int i = blockIdx.x * 512 + tid; i < SEQ * 32; i += gridDim.x * 512) {
        const int pos = i >> 5, f = i & 31; const float invf = (float)(1.0 / exp2((double)f * (13.287712379549449 / 32.0))); const float ang = (float)pos * invf;
        const double t = (double)ang * 0.15915494309189535; const float fr = (float)(t - floor(t));
        ((float*)(ws + WS_ROPE))[i] = __builtin_amdgcn_cosf(fr); ((float*)(ws + WS_ROPE))[SEQ * 32 + i] = __builtin_amdgcn_sinf(fr);
    }
    __syncthreads();
    for (int m = gw; m < MTOK; m += NGW) {
        const f32x4* xr = (const f32x4*)(P.x + (size_t)m * DM) + lane; f32x4 v[4];
#pragma unroll
        for (int j = 0; j < 4; ++j) v[j] = xr[64 * j];
        row_emit(v, (bf16_t*)(ws + WS_XB) + (size_t)m * DM, wfs, (float*)(ws + WS_FLOG) + (size_t)m * 8, lane);
    }
    __syncthreads();
}

__device__ __forceinline__ void fgate_cumsum(const Params& P, int l) {
    int tid = threadIdx.x; asm volatile("" : "+v"(tid));
    const int lane = tid & 63, wave = tid >> 6;
    const int gw = blockIdx.x * 8 + wave;
    if (gw >= NB * HF) return;
    const int b = gw / HF, h = gw % HF; const float bias = P.b_fgate[l * HF + h];
    const float* fl = (const float*)(P.ws + WS_FLOG) + ((size_t)b * SEQ + lane * 32) * 8 + h;
    float vals[32]; float run = 0.f;
#pragma unroll
    for (int i = 0; i < 32; ++i) { run += logsig_acc(fl[i * 8] + bias); vals[i] = run; }
    float incl = run;
#pragma unroll
    for (int o = 1; o < 64; o <<= 1) { const float t = __shfl_up(incl, o); if (lane >= o) incl += t; }
    const float excl = incl - run;
    float* c = (float*)(P.ws + WS_C) + ((size_t)(b * HF + h)) * SEQ + lane * 32;
#pragma unroll
    for (int i = 0; i < 32; ++i) c[i] = vals[i] + excl;
}

__device__ __forceinline__ void load_row64(const bf16_t* p, float (&f)[64]) {
    const u32x4* q = (const u32x4*)p;
#pragma unroll
    for (int i = 0; i < 8; ++i) { const u32x4 u = q[i];
        f[8 * i + 0] = bflo(u.x); f[8 * i + 1] = bfhi(u.x); f[8 * i + 2] = bflo(u.y); f[8 * i + 3] = bfhi(u.y);
        f[8 * i + 4] = bflo(u.z); f[8 * i + 5] = bfhi(u.z); f[8 * i + 6] = bflo(u.w); f[8 * i + 7] = bfhi(u.w); }
}
__device__ __forceinline__ void unpack8(const u32x4 u, float (&f)[8]) {
    f[0] = bflo(u.x); f[1] = bfhi(u.x); f[2] = bflo(u.y); f[3] = bfhi(u.y); f[4] = bflo(u.z); f[5] = bfhi(u.z); f[6] = bflo(u.w); f[7] = bfhi(u.w);
}
__device__ __forceinline__ float dot64(const float (&q)[64], const bf16_t* krow) {
    float dot = 0.f;
#pragma unroll
    for (int i = 0; i < 8; ++i) { float k[8]; unpack8(((const u32x4*)krow)[i], k);
#pragma unroll
        for (int e = 0; e < 8; ++e) dot += q[8 * i + e] * k[e]; }
    return dot;
}
__device__ __forceinline__ void axpy64(float (&o)[32], float f, float p, const bf16_t* vrow) {
#pragma unroll
    for (int i = 0; i < 4; ++i) { float v[8]; unpack8(((const u32x4*)vrow)[i], v);
#pragma unroll
        for (int e = 0; e < 8; ++e) o[8 * i + e] = o[8 * i + e] * f + p * v[e]; }
}
__device__ __forceinline__ void naive_mixers(const Params& P, int l) {
    const bf16_t* qkvg = (const bf16_t*)(P.ws + WS_QKVG);
    const float* cc = (const float*)(P.ws + WS_C);
    bf16_t* Y = (bf16_t*)(P.ws + WS_Y);
    for (int it = blockIdx.x * 512 + threadIdx.x; it < NB * 16 * SEQ * 2; it += gridDim.x * 512) {
        const int dh = it & 1, t = (it >> 1) % SEQ, hh = (it / (SEQ * 2)) % 16, b = it / (SEQ * 32);
        { const int ty = hh < HF ? 1 : (hh < HF + HR ? 2 : 4); if (MIX_MASK & ty) continue; }
        const bf16_t* base = qkvg + (size_t)b * SEQ * NQ + hh * 64;
        float q[64], o[32];
        load_row64(base + (size_t)t * NQ, q);
#pragma unroll
        for (int d = 0; d < 32; ++d) o[d] = 0.f;
        if (hh < HF) {
            const float* c = cc + (size_t)(b * HF + hh) * SEQ; const float ct = c[t];
            float m = -INFINITY, lsum = 0.f;
            for (int s = 0; s <= t; ++s) {
                const float sc = dot64(q, base + (size_t)s * NQ + 1024) * 0.125f + ct - c[s];
                const float mn = fmaxf(m, sc), f = expf(m - mn), p = expf(sc - mn);
                lsum = lsum * f + p; m = mn;
                axpy64(o, f, p, base + (size_t)s * NQ + 2048 + dh * 32);
            }
            const float inv = 1.f / lsum;
#pragma unroll
            for (int d = 0; d < 32; ++d) o[d] *= inv;
        } else if (hh < HF + HR) {
            const int hr = hh - HF; const float lg = logf(1.f - exp2f(-5.f - (float)hr));
            for (int s = 0; s <= t; ++s) {
                const float w = dot64(q, base + (size_t)s * NQ + 1024) * expf((float)(t - s) * lg);
                axpy64(o, 1.f, w, base + (size_t)s * NQ + 2048 + dh * 32);
            }
            float mu = 0.f;
#pragma unroll
            for (int d = 0; d < 32; ++d) mu += o[d];
            float var = 0.f;
            mu = (mu + __shfl_xor(mu, 1)) * (1.f / 64.f);
#pragma unroll
            for (int d = 0; d < 32; ++d) { o[d] -= mu; var += o[d] * o[d]; }
            var += __shfl_xor(var, 1);
            const float rs = rsqrtf(var * (1.f / 64.f) + GN_EPS); const float* gg = P.gn_gain + l * (HR * 64) + hr * 64 + dh * 32;
#pragma unroll
            for (int d = 0; d < 32; ++d) o[d] = o[d] * rs * gg[d];
        } else {
            float R = 0.f;
            for (int s = t - 1; s >= 0; --s) {
                const float z = dot64(q, base + (size_t)s * NQ + 1024) * 0.125f, ls = logsig_acc(z), a = expf(ls + R); R += ls - z;
                axpy64(o, 1.f, a, base + (size_t)s * NQ + 2048 + dh * 32);
            }
        }
        const bf16_t* gr = base + (size_t)t * NQ + 3072 + dh * 32;
        bf16_t* yr = Y + ((size_t)b * SEQ + t) * DM + hh * 64 + dh * 32;
#pragma unroll
        for (int i = 0; i < 4; ++i) { float g[8], gt[8]; unpack8(((const u32x4*)gr)[i], gt);
#pragma unroll
            for (int e = 0; e < 8; ++e) g[e] = o[8 * i + e] * gt[e] / (1.f + expf(-gt[e]));
            u32x4 w; w.x = pk2(g[0], g[1]); w.y = pk2(g[2], g[3]); w.z = pk2(g[4], g[5]); w.w = pk2(g[6], g[7]); ((u32x4*)yr)[i] = w; }
    }
}

typedef short bf16x8 __attribute__((ext_vector_type(8)));
typedef short s16x4 __attribute__((ext_vector_type(4)));
typedef float f32x16 __attribute__((ext_vector_type(16)));
typedef float f32x2_t __attribute__((ext_vector_type(2)));
typedef __bf16 bf16x2_t __attribute__((ext_vector_type(2)));
__device__ __forceinline__ unsigned cvtpk(float lo, float hi) { f32x2_t v = {lo, hi}; bf16x2_t b = __builtin_convertvector(v, bf16x2_t); return __builtin_bit_cast(unsigned, b); }
#define PACK8(P, B) __builtin_bit_cast(bf16x8, (u32x4){cvtpk(P[B], P[B + 1]), cvtpk(P[B + 2], P[B + 3]), cvtpk(P[B + 4], P[B + 5]), cvtpk(P[B + 6], P[B + 7])})
#define MFMA32(a, b, c) __builtin_amdgcn_mfma_f32_32x32x16_bf16((a), (b), (c), 0, 0, 0)
__device__ __forceinline__ int crow(int r, int hi) { return (r & 3) + 8 * (r >> 2) + 4 * hi; }
constexpr int KP = 72, VP = 68, SP = 68;
constexpr int L_K = 0, L_V = L_K + 2 * 64 * KP * 2, L_C2 = L_V + 2 * 64 * VP * 2, L_WSF = L_C2 + SEQ * 4, L_STG = L_WSF + 8 * 64 * 4, L_FLG = L_STG + 8 * 32 * SP * 4, L_QW = L_FLG + 64, L_MIX_END = L_QW + 16;
static_assert(L_MIX_END <= LDS_BYTES, "mixer LDS map");
constexpr float C2S = 0.125f * 1.4426950408889634f;
constexpr float SB_CUT = -160.f;

template <int MODE> __device__ __forceinline__ void attn_unit(const Params& P, int l, int b, int hh, int qb, unsigned char* lds) {
    int tid = threadIdx.x; asm volatile("" : "+v"(tid));
    const int lane = tid & 63, wave = __builtin_amdgcn_readfirstlane(tid >> 6), r32 = lane & 31, hi = lane >> 5;
    const bf16_t* base = (const bf16_t*)(P.ws + WS_QKVG) + (size_t)b * SEQ * NQ + hh * 64;
    const int q0 = qb * 256, qw0 = q0 + wave * 32, t = qw0 + r32;
    bf16_t* Ks = (bf16_t*)(lds + L_K); bf16_t* Vt = (bf16_t*)(lds + L_V); float* c2s = (float*)(lds + L_C2);
    float* wsf = (float*)(lds + L_WSF) + wave * 64; float* stg = (float*)(lds + L_STG) + wave * (32 * SP);
    const int NT = 4 * (qb + 1);
    __syncthreads();
    float ct2 = 0.f, lg2 = 0.f;
    if (MODE == 0) {
        const float* cg_ = (const float*)(P.ws + WS_C) + (size_t)(b * HF + hh) * SEQ;
        for (int i = tid; i < q0 + 256; i += 512) c2s[i] = cg_[i] * LOG2E;
        ct2 = cg_[t] * LOG2E;
    }
    if (MODE == 2) lg2 = log2f(1.f - exp2f(-5.f - (float)(hh - HF)));
    bf16x8 qf[4];
#pragma unroll
    for (int d0 = 0; d0 < 4; ++d0) qf[d0] = *(const bf16x8*)(base + (size_t)t * NQ + d0 * 16 + hi * 8);
    const int lk_key = tid >> 3, lk_ch = tid & 7, lv_key = tid & 63, lv_ch = tid >> 6;
    const bf16_t* kg = base + 1024 + (size_t)lk_key * NQ + lk_ch * 8;
    const bf16_t* vg = base + 2048 + (size_t)lv_key * NQ + lv_ch * 8;
    const int kt0 = (MODE == 1) ? NT - 1 : 0, kstep = (MODE == 1) ? -1 : 1;
    u32x4 kreg = *(const u32x4*)(kg + (size_t)kt0 * 64 * NQ), vreg = *(const u32x4*)(vg + (size_t)kt0 * 64 * NQ);
    f32x16 o0, o1;
#pragma unroll
    for (int r = 0; r < 16; ++r) { o0[r] = 0.f; o1[r] = 0.f; }
    float m = -INFINITY, lsum = 0.f, R = 0.f;
    bool wdone = false;
    volatile int* flg = (volatile int*)(lds + L_FLG);
    for (int it = 0; it < NT; ++it) {
        const int kt = kt0 + kstep * it;
        if (MODE == 1) { if (lane == 0) flg[(it & 1) * 8 + wave] = wdone ? 1 : 0; }
        bf16_t* Kb = Ks + (it & 1) * (64 * KP); bf16_t* Vb = Vt + (it & 1) * (64 * VP);
        *(u32x4*)(Kb + lk_key * KP + lk_ch * 8) = kreg;
        { bf16_t* vd = Vb + (lv_ch * 8) * VP + lv_key;
          vd[0 * VP] = (bf16_t)(vreg.x & 0xffffu); vd[1 * VP] = (bf16_t)(vreg.x >> 16); vd[2 * VP] = (bf16_t)(vreg.y & 0xffffu); vd[3 * VP] = (bf16_t)(vreg.y >> 16);
          vd[4 * VP] = (bf16_t)(vreg.z & 0xffffu); vd[5 * VP] = (bf16_t)(vreg.z >> 16); vd[6 * VP] = (bf16_t)(vreg.w & 0xffffu); vd[7 * VP] = (bf16_t)(vreg.w >> 16); }
        __syncthreads();
        if (MODE == 1) { int alld = 1;
#pragma unroll
            for (int w = 0; w < 8; ++w) alld &= flg[(it & 1) * 8 + w];
            if (alld) break; }
        if (it + 1 < NT) { kreg = *(const u32x4*)(kg + (size_t)(kt + kstep) * 64 * NQ); vreg = *(const u32x4*)(vg + (size_t)(kt + kstep) * 64 * NQ); }
        if (64 * kt <= qw0 + 31 && !(MODE == 1 && wdone)) {
            f32x16 p0, p1;
#pragma unroll
            for (int r = 0; r < 16; ++r) { p0[r] = 0.f; p1[r] = 0.f; }
#pragma unroll
            for (int d0 = 0; d0 < 4; ++d0) {
                const bf16x8 ka = *(const bf16x8*)(Kb + r32 * KP + d0 * 16 + hi * 8), kb2 = *(const bf16x8*)(Kb + (32 + r32) * KP + d0 * 16 + hi * 8);
                p0 = MFMA32(ka, qf[d0], p0); p1 = MFMA32(kb2, qf[d0], p1);
            }
            const int key0 = 64 * kt + 4 * hi;
            if (MODE == 0) {
                const float* cs = c2s + key0;
#pragma unroll
                for (int g = 0; g < 4; ++g) { const f32x4 ca = *(const f32x4*)(cs + 8 * g), cb = *(const f32x4*)(cs + 32 + 8 * g);
#pragma unroll
                    for (int j = 0; j < 4; ++j) { p0[4 * g + j] = p0[4 * g + j] * C2S + (ct2 - ca[j]); p1[4 * g + j] = p1[4 * g + j] * C2S + (ct2 - cb[j]); } }
                if (64 * kt + 63 > qw0) {
#pragma unroll
                    for (int r = 0; r < 16; ++r) { const int key = key0 + (r & 3) + 8 * (r >> 2); if (key > t) p0[r] = -INFINITY; if (key + 32 > t) p1[r] = -INFINITY; }
                }
                float mx = fmaxf(p0[0], p1[0]);
#pragma unroll
                for (int r = 1; r < 16; ++r) mx = fmaxf(mx, fmaxf(p0[r], p1[r]));
                mx = fmaxf(mx, __shfl_xor(mx, 32));
                const float mn = fmaxf(m, mx), alpha = __builtin_amdgcn_exp2f(m - mn);
                float ps = 0.f;
#pragma unroll
                for (int r = 0; r < 16; ++r) { p0[r] = __builtin_amdgcn_exp2f(p0[r] - mn); p1[r] = __builtin_amdgcn_exp2f(p1[r] - mn); ps += p0[r] + p1[r]; }
                lsum = lsum * alpha + ps; m = mn;
                if (__any(alpha != 1.f)) {
                    if (hi == 0) wsf[r32] = alpha;
                    __builtin_amdgcn_wave_barrier();
#pragma unroll
                    for (int g = 0; g < 4; ++g) { const f32x4 a = *(const f32x4*)(wsf + 8 * g + 4 * hi);
#pragma unroll
                        for (int j = 0; j < 4; ++j) { o0[4 * g + j] *= a[j]; o1[4 * g + j] *= a[j]; } }
                    __builtin_amdgcn_wave_barrier();
                }
            } else if (MODE == 1) {
                const bool diag = (64 * kt + 63 >= qw0);
#pragma unroll
                for (int r = 0; r < 16; ++r) { p0[r] *= C2S; p1[r] *= C2S; }
                if (diag) {
#pragma unroll
                    for (int r = 0; r < 16; ++r) { const int key = key0 + (r & 3) + 8 * (r >> 2); if (key >= t) p0[r] = -1e30f; if (key + 32 >= t) p1[r] = -1e30f; }
                }
                float lr[32];
#pragma unroll
                for (int r = 0; r < 16; ++r) {
                    const float za = p0[r], zb = p1[r];
                    const float spa = __builtin_amdgcn_logf(1.f + __builtin_amdgcn_exp2f(-fabsf(za))), spb = __builtin_amdgcn_logf(1.f + __builtin_amdgcn_exp2f(-fabsf(zb)));
                    lr[r] = (fminf(za, 0.f) - spa) - za; lr[16 + r] = (fminf(zb, 0.f) - spb) - zb;
                }
                float SI[9]; SI[8] = 0.f;
#pragma unroll
                for (int i = 7; i >= 0; --i) SI[i] = SI[i + 1] + ((lr[4 * i] + lr[4 * i + 1]) + (lr[4 * i + 2] + lr[4 * i + 3]));
                float E[8];
#pragma unroll
                for (int i = 0; i < 8; ++i) { const float snd = hi ? SI[i] : SI[i + 1]; E[i] = SI[i + 1] + __shfl_xor(snd, 32); }
                const float T = SI[0] + __shfl_xor(SI[0], 32);
#pragma unroll
                for (int i = 0; i < 8; ++i) {
                    const float bs = R + E[i];
                    const float w2 = lr[4 * i + 3], w1 = w2 + lr[4 * i + 2], w0 = w1 + lr[4 * i + 1];
                    if (i < 4) { p0[4 * i + 3] = __builtin_amdgcn_exp2f(p0[4 * i + 3] + lr[4 * i + 3] + bs); p0[4 * i + 2] = __builtin_amdgcn_exp2f(p0[4 * i + 2] + lr[4 * i + 2] + bs + w2);
                                 p0[4 * i + 1] = __builtin_amdgcn_exp2f(p0[4 * i + 1] + lr[4 * i + 1] + bs + w1); p0[4 * i + 0] = __builtin_amdgcn_exp2f(p0[4 * i + 0] + lr[4 * i + 0] + bs + w0); }
                    else { const int q = 4 * (i - 4);
                                 p1[q + 3] = __builtin_amdgcn_exp2f(p1[q + 3] + lr[4 * i + 3] + bs); p1[q + 2] = __builtin_amdgcn_exp2f(p1[q + 2] + lr[4 * i + 2] + bs + w2);
                                 p1[q + 1] = __builtin_amdgcn_exp2f(p1[q + 1] + lr[4 * i + 1] + bs + w1); p1[q + 0] = __builtin_amdgcn_exp2f(p1[q + 0] + lr[4 * i + 0] + bs + w0); }
                }
                R += T;
                wdone = __all(R < SB_CUT);
            } else {
                const bool diag = (64 * kt + 63 > qw0);
#pragma unroll
                for (int r = 0; r < 16; ++r) { const int key = key0 + (r & 3) + 8 * (r >> 2);
                    p0[r] *= __builtin_amdgcn_exp2f((float)(t - key) * lg2); p1[r] *= __builtin_amdgcn_exp2f((float)(t - key - 32) * lg2);
                    if (diag) { if (key > t) p0[r] = 0.f; if (key + 32 > t) p1[r] = 0.f; } }
            }
#pragma unroll
            for (int blk = 0; blk < 2; ++blk)
#pragma unroll
                for (int s = 0; s < 2; ++s) {
                    const bf16x8 pf = blk ? PACK8(p1, 8 * s) : PACK8(p0, 8 * s);
                    const bf16_t* vp = Vb + r32 * VP + blk * 32 + 16 * s + 4 * hi;
                    const s16x4 a0 = *(const s16x4*)(vp), a1 = *(const s16x4*)(vp + 8), b0 = *(const s16x4*)(vp + 32 * VP), b1 = *(const s16x4*)(vp + 32 * VP + 8);
                    o0 = MFMA32(pf, __builtin_shufflevector(a0, a1, 0, 1, 2, 3, 4, 5, 6, 7), o0);
                    o1 = MFMA32(pf, __builtin_shufflevector(b0, b1, 0, 1, 2, 3, 4, 5, 6, 7), o1);
                }
        }
    }
    if (MODE == 0) {
        lsum += __shfl_xor(lsum, 32);
        if (hi == 0) wsf[r32] = 1.f / lsum;
        __builtin_amdgcn_wave_barrier();
    }
#pragma unroll
    for (int g = 0; g < 4; ++g) {
        f32x4 a = {1.f, 1.f, 1.f, 1.f};
        if (MODE == 0) a = *(const f32x4*)(wsf + 8 * g + 4 * hi);
#pragma unroll
        for (int j = 0; j < 4; ++j) { const int row = 8 * g + 4 * hi + j; stg[row * SP + r32] = o0[4 * g + j] * a[j]; stg[row * SP + 32 + r32] = o1[4 * g + j] * a[j]; }
    }
    __builtin_amdgcn_wave_barrier();
    bf16_t* Y = (bf16_t*)(P.ws + WS_Y) + ((size_t)b * SEQ + qw0) * DM + hh * 64;
    const float* gg = P.gn_gain + l * (HR * 64) + (MODE == 2 ? (hh - HF) * 64 : 0);
#pragma unroll
    for (int i = 0; i < 8; ++i) {
        const int row = i * 4 + (lane >> 4), ch = lane & 15;
        f32x4 ov = *(const f32x4*)(stg + row * SP + ch * 4);
        if (MODE == 2) {
            float s = (ov[0] + ov[1]) + (ov[2] + ov[3]);
            s += __shfl_xor(s, 1); s += __shfl_xor(s, 2); s += __shfl_xor(s, 4); s += __shfl_xor(s, 8);
            const float mu = s * (1.f / 64.f); ov = ov - mu;
            float v2 = (ov[0] * ov[0] + ov[1] * ov[1]) + (ov[2] * ov[2] + ov[3] * ov[3]);
            v2 += __shfl_xor(v2, 1); v2 += __shfl_xor(v2, 2); v2 += __shfl_xor(v2, 4); v2 += __shfl_xor(v2, 8);
            const float rs = rsqrtf(v2 * (1.f / 64.f) + GN_EPS); const f32x4 gv = *(const f32x4*)(gg + ch * 4);
            ov = ov * rs * gv;
        }
        const u32x2 gt = *(const u32x2*)(base + (size_t)(qw0 + row) * NQ + 3072 + ch * 4);
        const float g0 = bflo(gt.x), g1 = bfhi(gt.x), g2 = bflo(gt.y), g3 = bfhi(gt.y);
        u32x2 w; w.x = cvtpk(ov[0] * g0 / (1.f + __expf(-g0)), ov[1] * g1 / (1.f + __expf(-g1))); w.y = cvtpk(ov[2] * g2 / (1.f + __expf(-g2)), ov[3] * g3 / (1.f + __expf(-g3)));
        *(u32x2*)(Y + (size_t)row * DM + ch * 4) = w;
    }
}

#ifndef MIX_MASK
#define MIX_MASK 7
#endif
__device__ __forceinline__ void mixer_phase(const Params& P, int l, unsigned char* lds) {
    unsigned* ctr = (unsigned*)(P.ws + WS_CTR) + 16 * l;
    volatile int* qw = (volatile int*)(lds + L_QW);
    for (;;) {
        __syncthreads();
        if (threadIdx.x == 0) qw[0] = (int)atomicAdd(ctr, 1u);
        __syncthreads();
        const int u = qw[0];
        if (u >= 8 * 256) break;
        const int qb = 7 - u / 256, idx = u % 256;
        if (idx < 96) { if (MIX_MASK & 1) attn_unit<0>(P, l, idx / 6, idx % 6, qb, lds); }
        else if (idx < 192) { if (MIX_MASK & 2) attn_unit<2>(P, l, (idx - 96) / 6, HF + (idx - 96) % 6, qb, lds); }
        else { if (MIX_MASK & 4) attn_unit<1>(P, l, (idx - 192) / 4, HF + HR + (idx - 192) % 4, qb, lds); }
    }
    __syncthreads();
}

__device__ __forceinline__ void phase4(const Params& P, int l, unsigned char* lds) {
    int tid = threadIdx.x; asm volatile("" : "+v"(tid));
    const int lane = tid & 63, wave = tid >> 6;
    const int gw = blockIdx.x * 8 + wave, NGW = gridDim.x * 8;
    float* wfs = (float*)lds;
    if (l + 1 < NL) { stage_wf(P, l + 1, wfs); }
    __syncthreads();
    const float* gp = P.ln_gain + l * DM; const float* bp = P.ln_bias + l * DM;
    f32x4 g[4], bb[4];
#pragma unroll
    for (int j = 0; j < 4; ++j) { g[j] = ((const f32x4*)gp)[lane + 64 * j]; bb[j] = ((const f32x4*)bp)[lane + 64 * j]; }
    for (int m = gw; m < MTOK; m += NGW) {
        f32x4* xr = (f32x4*)(P.out + (size_t)m * DM) + lane; f32x4 v[4]; float s = 0.f;
#pragma unroll
        for (int j = 0; j < 4; ++j) { v[j] = xr[64 * j]; s += (v[j].x + v[j].y) + (v[j].z + v[j].w); }
        const float mean = wave_sum(s) * (1.f / DM); float s2 = 0.f;
#pragma unroll
        for (int j = 0; j < 4; ++j) { v[j] = v[j] - mean; s2 += (v[j].x * v[j].x + v[j].y * v[j].y) + (v[j].z * v[j].z + v[j].w * v[j].w); }
        const float rstd = rsqrtf(wave_sum(s2) * (1.f / DM) + LN_EPS);
#pragma unroll
        for (int j = 0; j < 4; ++j) { v[j] = v[j] * rstd * g[j] + bb[j]; xr[64 * j] = v[j]; }
        if (l + 1 < NL) row_emit(v, (bf16_t*)(P.ws + WS_XB) + (size_t)m * DM, wfs, (float*)(P.ws + WS_FLOG) + (size_t)m * 8, lane);
    }
    __syncthreads();
}

#if NAIVE_MIX
__global__ void __launch_bounds__(512) naive_mix_kernel(Params P, int l) { naive_mixers(P, l); }
#endif
__global__ void __launch_bounds__(512) hybrid_fwd(Params P) {
    extern __shared__ __attribute__((aligned(16))) unsigned char lds[];
    cg::grid_group grid = cg::this_grid();
    unsigned char* ws = P.ws;
    const int lo = P.ph_lo, hi = P.ph_hi;
#define RUN(k) (lo <= (k) && (k) < hi)
#define SEAM(k) do { if (RUN(k) && RUN((k) + 1)) grid.sync(); } while (0)
    if (RUN(0)) phase0(P, lds);
    SEAM(0);
#pragma unroll
    for (int l = 0; l < NL; ++l) {
        if (RUN(1 + 4 * l)) {
          fgate_cumsum(P, l);
          pg8::Gemm g{(const bf16_t*)(ws + WS_XB), (const bf16_t*)(ws + WS_WIN) + (size_t)l * NQ * DM, MTOK, NQ, DM};
          pg8::StaticOrder S; S.init(MTOK, NQ, (int)gridDim.x, (int)blockIdx.x);
          pg8::EpiInProj E{(bf16_t*)(ws + WS_QKVG), (const float*)(ws + WS_ROPE)};
          pg8::gemm_phase<pg8::EpiInProj, pg8::StaticOrder, true, true>((PG8_LAS unsigned char*)lds, g, S, E); }
        SEAM(1 + 4 * l);
        if (RUN(2 + 4 * l)) mixer_phase(P, l, lds);
        SEAM(2 + 4 * l);
        if (RUN(3 + 4 * l)) {
          pg8::Gemm g{(const bf16_t*)(ws + WS_Y), (const bf16_t*)(ws + WS_WOUT) + (size_t)l * DM * DM, MTOK, DM, DM};
          pg8::StaticOrder S; S.init(MTOK, DM, (int)gridDim.x, (int)blockIdx.x);
          pg8::EpiResid E{l == 0 ? P.x : P.out, P.out, DM, DN_ALPHA};
          pg8::gemm_phase<pg8::EpiResid, pg8::StaticOrder, true, true>((PG8_LAS unsigned char*)lds, g, S, E); }
        SEAM(3 + 4 * l);
        if (RUN(4 + 4 * l)) phase4(P, l, lds);
        SEAM(4 + 4 * l);
    }
#undef RUN
#undef SEAM
}

extern "C" void kernel_launch(void* const* d_in, const int* in_sizes, int n_in, void* d_out, int out_size, void* d_ws, size_t ws_size, hipStream_t stream) {
    static int grid_blocks = 0;
    if (grid_blocks == 0) {
        if (n_in != 7 || out_size != MTOK * DM || ws_size < WS_END) { fprintf(stderr, "kernel_launch: unexpected shapes (n_in %d out %d ws %zu)\n", n_in, out_size, ws_size); grid_blocks = -1; return; }
        int dev = 0, cus = 0, per_cu = 0;
        (void)hipGetDevice(&dev);
        (void)hipDeviceGetAttribute(&cus, hipDeviceAttributeMultiprocessorCount, dev);
        if (hipFuncSetAttribute((const void*)hybrid_fwd, hipFuncAttributeMaxDynamicSharedMemorySize, LDS_BYTES) != hipSuccess) { fprintf(stderr, "kernel_launch: hipFuncSetAttribute failed\n"); grid_blocks = -1; return; }
        if (hipOccupancyMaxActiveBlocksPerMultiprocessor(&per_cu, (const void*)hybrid_fwd, 512, LDS_BYTES) != hipSuccess || per_cu < 1) { fprintf(stderr, "kernel_launch: occupancy query failed (%d)\n", per_cu); per_cu = 1; (void)hipGetLastError(); }
        grid_blocks = cus * per_cu;
    }
    if (grid_blocks < 0) return;
    Params p{};
    p.x = (const float*)d_in[0]; p.w_in = (const float*)d_in[1]; p.b_fgate = (const float*)d_in[2]; p.gn_gain = (const float*)d_in[3];
    p.w_out = (const float*)d_in[4]; p.ln_gain = (const float*)d_in[5]; p.ln_bias = (const float*)d_in[6];
    p.out = (float*)d_out; p.ws = (unsigned char*)d_ws;
#if NAIVE_MIX
    const int cuts[4] = {0, 3, 7, 9};
    for (int i = 0; i < 3; ++i) {
        p.ph_lo = cuts[i]; p.ph_hi = cuts[i + 1];
        void* args[] = {&p};
        hipError_t e = hipLaunchCooperativeKernel((const void*)hybrid_fwd, dim3(grid_blocks), dim3(512), args, LDS_BYTES, stream);
        if (e != hipSuccess) fprintf(stderr, "cooperative launch failed: %s (grid %d)\n", hipGetErrorString(e), grid_blocks);
        if (i < 2) hipLaunchKernelGGL(naive_mix_kernel, dim3(grid_blocks), dim3(512), 0, stream, p, i);
    }
#else
    p.ph_lo = 0; p.ph_hi = 9;
    void* args[] = {&p};
    hipError_t e = hipLaunchCooperativeKernel((const void*)hybrid_fwd, dim3(grid_blocks), dim3(512), args, LDS_BYTES, stream);
    if (e != hipSuccess) fprintf(stderr, "cooperative launch failed: %s (grid %d)\n", hipGetErrorString(e), grid_blocks);
#endif
}
```

```cpp
#include <hip/hip_runtime.h>
#include <hip/hip_cooperative_groups.h>
#include <cstdio>
#include <cstdint>
#include <cmath>
namespace cg = cooperative_groups;
namespace pg8 {
#define PG8_LAS __attribute__((address_space(3)))
typedef unsigned short bf16_t;
typedef short bf16x8 __attribute__((ext_vector_type(8)));
typedef float f32x4 __attribute__((ext_vector_type(4)));
typedef unsigned u32x4 __attribute__((ext_vector_type(4)));
constexpr int BM = 256, BK = 64, HALF = 128, HTB = HALF * BK * 2  , STAGE_BYTES = 8 * HTB, NXCD = 8, WGM = 8;

__host__ __device__ __forceinline__ int lds_byte(int r, int c) { const int st = (r >> 4) * 2 + (c >> 5), rr = r & 15, cc = c & 31, ob = rr * 64 + cc * 2; return st * 1024 + (ob ^ (((ob >> 9) & 1) << 5)); }
__host__ __device__ __forceinline__ void stage_rc(int b, int& R, int& C) { const int st = b / 1024, sb = b % 1024, swz = sb ^ (((sb >> 9) & 1) << 5); R = (st >> 1) * 16 + swz / 64; C = (st & 1) * 32 + (swz % 64) / 2; }
__host__ __device__ __forceinline__ int perm32(int rho) { const int n = rho >> 4, i = rho & 15; return 8 * (i >> 2) + 4 * n + (i & 3); }

struct Unit { int pm, pn; };
struct Gemm { const bf16_t* A; const bf16_t* Bt; int M, N, K; };

struct StaticOrder {
    int nM, nN, nwg, G, c;
    __host__ __device__ void init(int M, int N, int G_, int c_) { nM = M / BM; nN = N / BM; nwg = nM * nN; G = G_; c = c_; }
    __host__ __device__ bool next(int i, Unit& u) const {
        const long L = (long)i * G + c; if (L >= nwg) return false;
        int wgid = (int)L; { const int q = nwg / NXCD, r = nwg % NXCD, xcd = wgid % NXCD, off = wgid / NXCD; wgid = (xcd < r ? xcd * (q + 1) : r * (q + 1) + (xcd - r) * q) + off; }
        const int nig = WGM * nN, gid = wgid / nig, fm = gid * WGM, gsz = (nM - fm) < WGM ? (nM - fm) : WGM;
        u.pm = fm + ((wgid % nig) % gsz); u.pn = (wgid % nig) / gsz; return true;
    }
    __device__ __forceinline__ void a_ready(const Unit&) const {}
    __device__ __forceinline__ void done(const Unit&) const {}
};

__device__ __forceinline__ unsigned cvt_pk_bf16(float lo, float hi) { unsigned r; asm volatile("v_cvt_pk_bf16_f32 %0, %1, %2" : "=v"(r) : "v"(lo), "v"(hi)); return r; }
typedef float f32x2 __attribute__((ext_vector_type(2)));
__device__ __forceinline__ f32x2 gelu_pk(f32x2 v) {
    const f32x2 av = __builtin_elementwise_abs(v), d = av * 0.2316418882f + 1.0f;
    f32x2 t; t.x = __builtin_amdgcn_rcpf(d.x); t.y = __builtin_amdgcn_rcpf(d.y);
    f32x2 q = t * 0.5307027145f + (-0.7265760135f); q = q * t + 0.7107068705f; q = q * t + (-0.142248368f); q = q * t + 0.127414796f; q = q * t;
    const f32x2 s = (v * v) * (-0.72134752044f);
    f32x2 e; e.x = __builtin_amdgcn_exp2f(s.x); e.y = __builtin_amdgcn_exp2f(s.y);
    const f32x2 m = v * (q * e), r = v - m;
    f32x2 o; o.x = v.x < 0.f ? m.x : r.x; o.y = v.y < 0.f ? m.y : r.y; return o;
}

template <int ACT  > struct EpiBf16 {
    static constexpr bool PERM = true, AFTER_DRAIN = false; static_assert(ACT == 0 || ACT == 1, "EpiBf16: ACT is 0 (none) or 1 (gelu_pk)");
    bf16_t* O; int ldc; const float* bias; int split_cols; size_t split_stride; float scale0;
    __device__ __forceinline__ void operator()(const f32x4 (&acc)[2][2][4][2], const Unit& u, int wr, int wc, int fr, int fq) const {
        const int row0 = u.pm * BM + wr * 64 + fr; int colt = u.pn * BM; bf16_t* base = O;
        float sc = 1.f; if (split_cols) { const int t = colt / split_cols; base += (size_t)t * split_stride; colt -= t * split_cols; if (t == 0) sc = scale0; }
        const int col0 = colt + wc * 32 + 8 * fq, bcol0 = u.pn * BM + wc * 32 + 8 * fq;
        f32x4 bv[2][2];
#pragma unroll
        for (int bj = 0; bj < 2; ++bj)
#pragma unroll
            for (int n = 0; n < 2; ++n) bv[bj][n] = bias ? *(const f32x4*)(bias + bcol0 + bj * HALF + 4 * n) : (f32x4){0.f, 0.f, 0.f, 0.f};
#pragma unroll
        for (int ai = 0; ai < 2; ++ai)
#pragma unroll
            for (int m = 0; m < 4; ++m) { bf16_t* rowp = base + (size_t)(row0 + ai * HALF + m * 16) * ldc + col0;
#pragma unroll
                for (int bj = 0; bj < 2; ++bj) { f32x4 v0 = acc[ai][bj][m][0] + bv[bj][0], v1 = acc[ai][bj][m][1] + bv[bj][1];
                    if (ACT == 1) { f32x2 a = gelu_pk((f32x2){v0[0], v0[1]}), b = gelu_pk((f32x2){v0[2], v0[3]}), c = gelu_pk((f32x2){v1[0], v1[1]}), d = gelu_pk((f32x2){v1[2], v1[3]});
                        v0 = (f32x4){a.x, a.y, b.x, b.y}; v1 = (f32x4){c.x, c.y, d.x, d.y}; }
                    v0 = v0 * sc; v1 = v1 * sc; u32x4 w; w.x = cvt_pk_bf16(v0[0], v0[1]); w.y = cvt_pk_bf16(v0[2], v0[3]); w.z = cvt_pk_bf16(v1[0], v1[1]); w.w = cvt_pk_bf16(v1[2], v1[3]);
                    *(u32x4*)(rowp + bj * HALF) = w; } }
    }
};
struct EpiResid {
    static constexpr bool PERM = true, AFTER_DRAIN = false;
    const float* res; float* out; int ldc; float alpha;
    __device__ __forceinline__ void operator()(const f32x4 (&acc)[2][2][4][2], const Unit& u, int wr, int wc, int fr, int fq) const {
        const int row0 = u.pm * BM + wr * 64 + fr; const int col0 = u.pn * BM + wc * 32 + 8 * fq;
#pragma unroll
        for (int ai = 0; ai < 2; ++ai)
#pragma unroll
            for (int m = 0; m < 4; ++m) { const size_t ro = (size_t)(row0 + ai * HALF + m * 16) * ldc + col0;
#pragma unroll
                for (int bj = 0; bj < 2; ++bj) {
                    const f32x4 r0 = *(const f32x4*)(res + ro + bj * HALF), r1 = *(const f32x4*)(res + ro + bj * HALF + 4);
                    const f32x4 v0 = acc[ai][bj][m][0] + r0 * alpha, v1 = acc[ai][bj][m][1] + r1 * alpha;
                    *(f32x4*)(out + ro + bj * HALF) = v0; *(f32x4*)(out + ro + bj * HALF + 4) = v1; } }
    }
};
struct EpiInProj {
    static constexpr bool PERM = true, AFTER_DRAIN = false;
    bf16_t* O; const float* rope;
    __device__ __forceinline__ void operator()(const f32x4 (&acc)[2][2][4][2], const Unit& u, int wr, int wc, int fr, int fq) const {
        const int row0 = u.pm * BM + wr * 64 + fr;
#pragma unroll
        for (int bj = 0; bj < 2; ++bj) {
            const int colg = u.pn * BM + bj * HALF + wc * 32, col0 = colg + 8 * fq, head = colg >> 6;
            const bool isrot = (head >= 6 && head < 12) || (head >= 22 && head < 28);
            const float sc = head >= 16 ? 0.125f : 1.f;
            const int i0 = ((colg & 63) + 8 * fq) >> 1;
#pragma unroll
            for (int ai = 0; ai < 2; ++ai)
#pragma unroll
                for (int m = 0; m < 4; ++m) {
                    const int row = row0 + ai * HALF + m * 16;
                    f32x4 v0 = acc[ai][bj][m][0], v1 = acc[ai][bj][m][1];
                    if (isrot) {
                        const int pos = row & 2047;
                        const f32x4 c = *(const f32x4*)(rope + pos * 32 + i0), s = *(const f32x4*)(rope + 2048 * 32 + pos * 32 + i0);
                        f32x4 w0, w1;
                        w0[0] = (v0[0] * c[0] - v0[1] * s[0]) * sc; w0[1] = (v0[0] * s[0] + v0[1] * c[0]) * sc;
                        w0[2] = (v0[2] * c[1] - v0[3] * s[1]) * sc; w0[3] = (v0[2] * s[1] + v0[3] * c[1]) * sc;
                        w1[0] = (v1[0] * c[2] - v1[1] * s[2]) * sc; w1[1] = (v1[0] * s[2] + v1[1] * c[2]) * sc;
                        w1[2] = (v1[2] * c[3] - v1[3] * s[3]) * sc; w1[3] = (v1[2] * s[3] + v1[3] * c[3]) * sc;
                        v0 = w0; v1 = w1;
                    }
                    u32x4 w; w.x = cvt_pk_bf16(v0[0], v0[1]); w.y = cvt_pk_bf16(v0[2], v0[3]); w.z = cvt_pk_bf16(v1[0], v1[1]); w.w = cvt_pk_bf16(v1[2], v1[3]);
                    *(u32x4*)(O + (size_t)row * 4096 + col0) = w;
                }
        }
    }
};
template <class Epi, class Sched, bool ALIGN_EPI = false, bool SP2 = false>
__device__ __forceinline__ void gemm_phase(PG8_LAS unsigned char* lds, const Gemm g, const Sched& S, const Epi& E) {
    int tid = threadIdx.x; asm volatile("" : "+v"(tid));
    const int wid = __builtin_amdgcn_readfirstlane(tid >> 6), lane = tid & 63, wr = wid >> 2, wc = wid & 3, fr = lane & 15, fq = lane >> 4;
    const int K = g.K, nt = K / BK;
    unsigned voffA[2], voffB[2];
#pragma unroll
    for (int i = 0; i < 2; ++i) { int R, C; stage_rc(tid * 16 + i * 8192, R, C); const int Rb = Epi::PERM ? ((R & ~31) + perm32(R & 31)) : R;
        voffA[i] = (unsigned)(R * K + C) * 2u; voffB[i] = (unsigned)(Rb * K + C) * 2u; }
    const size_t kstep = (size_t)(BK * 2);
    const size_t hstep = (size_t)HALF * K * 2;
    const size_t tstep = 2 * hstep;
    const unsigned ldsw = (unsigned)wid * 1024u;
    const int aoff = lds_byte(wr * 64 + fr, fq * 8), boff = lds_byte(wc * 32 + fr, fq * 8);
#define PG8_SA(b, h) (((b) * 2 + (h)) * HTB)
#define PG8_SB(b, h) ((4 + (b) * 2 + (h)) * HTB)
#define PG8_STAGE(bufoff, gbase, voff) do { _Pragma("unroll") for (int _i = 0; _i < 2; ++_i) \
        __builtin_amdgcn_global_load_lds((const unsigned*)((const char*)(gbase) + (voff)[_i]), (PG8_LAS unsigned*)(lds + (bufoff) + ldsw + _i * 8192), 16, 0, 0); } while (0)
#define PG8_LDA(dst, b, h) do { _Pragma("unroll") for (int m = 0; m < 4; ++m) _Pragma("unroll") for (int k = 0; k < 2; ++k) dst[m][k] = *(const PG8_LAS bf16x8*)(lds + PG8_SA(b, h) + aoff + m * 2048 + k * 1024); } while (0)
#define PG8_LDB(dst, b, h) do { _Pragma("unroll") for (int n = 0; n < 2; ++n) _Pragma("unroll") for (int k = 0; k < 2; ++k) dst[n][k] = *(const PG8_LAS bf16x8*)(lds + PG8_SB(b, h) + boff + n * 2048 + k * 1024); } while (0)
#define PG8_MMA(ai, bj, At, Bt) do { __builtin_amdgcn_s_setprio(1); _Pragma("unroll") for (int m = 0; m < 4; ++m) _Pragma("unroll") for (int n = 0; n < 2; ++n) _Pragma("unroll") for (int k = 0; k < 2; ++k) \
        acc[ai][bj][m][n] = __builtin_amdgcn_mfma_f32_16x16x32_bf16(Bt[n][k], At[m][k], acc[ai][bj][m][n], 0, 0, 0); __builtin_amdgcn_s_setprio(0); } while (0)
#define PG8_WAIT_V(n) asm volatile("s_waitcnt vmcnt(" #n ")" ::: "memory")
#define PG8_WAIT_L(n) asm volatile("s_waitcnt lgkmcnt(" #n ")" ::: "memory")
#define PG8_BAR __builtin_amdgcn_s_barrier()
#define PG8_SCHED __builtin_amdgcn_sched_barrier(0)
    Unit cur, nxt; int ui = 0;
    if (!S.next(0, cur)) return;
    f32x4 acc[2][2][4][2];
#pragma unroll
    for (int a = 0; a < 2; ++a)
#pragma unroll
        for (int b = 0; b < 2; ++b)
#pragma unroll
            for (int m = 0; m < 4; ++m)
#pragma unroll
                for (int n = 0; n < 2; ++n) acc[a][b][m][n] = (f32x4){0.f, 0.f, 0.f, 0.f};
    bf16x8 At[4][2], B0[2][2], B1[2][2];
    const char* cA = (const char*)g.A + (size_t)cur.pm * tstep; const char* cB = (const char*)g.Bt + (size_t)cur.pn * tstep;
    S.a_ready(cur);
    if constexpr (SP2) {
        PG8_STAGE(PG8_SB(0, 0), cB, voffB); PG8_STAGE(PG8_SB(0, 1), cB + hstep, voffB); PG8_STAGE(PG8_SA(0, 0), cA, voffA); PG8_STAGE(PG8_SA(0, 1), cA + hstep, voffA);
        if (wr == 1) PG8_BAR;
        PG8_WAIT_V(2); PG8_BAR;
        PG8_STAGE(PG8_SB(1, 0), cB + kstep, voffB); PG8_STAGE(PG8_SA(1, 0), cA + kstep, voffA); PG8_STAGE(PG8_SB(1, 1), cB + hstep + kstep, voffB);
        PG8_WAIT_V(6); PG8_BAR;
    } else {
        PG8_STAGE(PG8_SB(0, 0), cB, voffB); PG8_STAGE(PG8_SA(0, 0), cA, voffA); PG8_STAGE(PG8_SB(0, 1), cB + hstep, voffB); PG8_STAGE(PG8_SA(0, 1), cA + hstep, voffA);
        if (wr == 1) PG8_BAR;
        PG8_WAIT_V(4); PG8_BAR;
        PG8_STAGE(PG8_SB(1, 0), cB + kstep, voffB); PG8_STAGE(PG8_SA(1, 0), cA + kstep, voffA); PG8_STAGE(PG8_SB(1, 1), cB + hstep + kstep, voffB);
        PG8_WAIT_V(6); PG8_BAR;
    }
    for (;;) {
        const bool has_next = S.next(ui + 1, nxt);
        const char* nA = has_next ? (const char*)g.A + (size_t)nxt.pm * tstep : cA; const char* nB = has_next ? (const char*)g.Bt + (size_t)nxt.pn * tstep : cB;
        for (int t = 0; t < nt; t += 2) {
            const bool last = (t == nt - 2);
            const char* a1 = cA + (size_t)(t + 1) * kstep;
            const char* a2 = last ? nA : cA + (size_t)(t + 2) * kstep; const char* b2 = last ? nB : cB + (size_t)(t + 2) * kstep;
            const char* a3 = a2 + kstep; const char* b3 = b2 + kstep;
            if (last && has_next) S.a_ready(nxt);
            if constexpr (SP2) {
            PG8_LDB(B0, 0, 0); PG8_LDB(B1, 0, 1); PG8_SCHED; PG8_LDA(At, 0, 0); PG8_STAGE(PG8_SA(1, 1), a1 + hstep, voffA);
            PG8_WAIT_V(8); PG8_WAIT_L(0); PG8_BAR; PG8_MMA(0, 0, At, B0); PG8_MMA(0, 1, At, B1); PG8_BAR; PG8_SCHED;
            PG8_LDA(At, 0, 1); PG8_STAGE(PG8_SB(0, 0), b2, voffB); PG8_STAGE(PG8_SB(0, 1), b2 + hstep, voffB); PG8_STAGE(PG8_SA(0, 0), a2, voffA);
            PG8_WAIT_V(8); PG8_WAIT_L(0); PG8_BAR; PG8_MMA(1, 0, At, B0); PG8_MMA(1, 1, At, B1); PG8_BAR; PG8_SCHED;
            PG8_LDB(B0, 1, 0); PG8_LDB(B1, 1, 1); PG8_SCHED; PG8_LDA(At, 1, 0); PG8_STAGE(PG8_SA(0, 1), a2 + hstep, voffA);
            PG8_WAIT_V(8); PG8_WAIT_L(0); PG8_BAR; PG8_MMA(0, 0, At, B0); PG8_MMA(0, 1, At, B1); PG8_BAR; PG8_SCHED;
            PG8_LDA(At, 1, 1); PG8_STAGE(PG8_SB(1, 0), b3, voffB); PG8_STAGE(PG8_SB(1, 1), b3 + hstep, voffB); PG8_STAGE(PG8_SA(1, 0), a3, voffA);
            PG8_WAIT_V(8); PG8_WAIT_L(0); PG8_BAR; PG8_MMA(1, 0, At, B0); PG8_MMA(1, 1, At, B1); PG8_BAR; PG8_SCHED;
            } else {
            PG8_LDB(B0, 0, 0); PG8_SCHED; PG8_LDA(At, 0, 0); PG8_STAGE(PG8_SA(1, 1), a1 + hstep, voffA);
            PG8_WAIT_L(8); PG8_BAR; PG8_WAIT_L(0); PG8_MMA(0, 0, At, B0); PG8_BAR; PG8_SCHED;
            PG8_LDB(B1, 0, 1); PG8_STAGE(PG8_SB(0, 0), b2, voffB);
            PG8_BAR; PG8_WAIT_L(0); PG8_MMA(0, 1, At, B1); PG8_BAR;
            PG8_LDA(At, 0, 1); PG8_STAGE(PG8_SA(0, 0), a2, voffA);
            PG8_BAR; PG8_WAIT_L(0); PG8_MMA(1, 0, At, B0); PG8_BAR; PG8_SCHED;
            PG8_STAGE(PG8_SB(0, 1), b2 + hstep, voffB);
            PG8_WAIT_V(6); PG8_BAR; PG8_MMA(1, 1, At, B1); PG8_BAR;
            PG8_LDB(B0, 1, 0); PG8_SCHED; PG8_LDA(At, 1, 0); PG8_STAGE(PG8_SA(0, 1), a2 + hstep, voffA);
            PG8_WAIT_L(8); PG8_BAR; PG8_WAIT_L(0); PG8_MMA(0, 0, At, B0); PG8_BAR; PG8_SCHED;
            PG8_LDB(B1, 1, 1); PG8_STAGE(PG8_SB(1, 0), b3, voffB);
            PG8_BAR; PG8_WAIT_L(0); PG8_MMA(0, 1, At, B1); PG8_BAR;
            PG8_LDA(At, 1, 1); PG8_STAGE(PG8_SA(1, 0), a3, voffA);
            PG8_BAR; PG8_WAIT_L(0); PG8_MMA(1, 0, At, B0); PG8_BAR; PG8_SCHED;
            PG8_STAGE(PG8_SB(1, 1), b3 + hstep, voffB);
            PG8_WAIT_V(6); PG8_BAR; PG8_MMA(1, 1, At, B1); PG8_BAR;
            }
        }
        if constexpr (ALIGN_EPI) { if (wr == 0) PG8_BAR; }
        if constexpr (!Epi::AFTER_DRAIN) { E(acc, cur, wr, wc, fr, fq); S.done(cur); }
        if (!has_next) break;
#pragma unroll
        for (int a = 0; a < 2; ++a)
#pragma unroll
            for (int b = 0; b < 2; ++b)
#pragma unroll
                for (int m = 0; m < 4; ++m)
#pragma unroll
                    for (int n = 0; n < 2; ++n) acc[a][b][m][n] = (f32x4){0.f, 0.f, 0.f, 0.f};
        cur = nxt; cA = nA; cB = nB; ++ui;
        if constexpr (ALIGN_EPI) { if (wr == 1) PG8_BAR; }
    }
    PG8_WAIT_V(0);
    if constexpr (!ALIGN_EPI) { if (wr == 0) PG8_BAR; }
    PG8_BAR;
    if constexpr (Epi::AFTER_DRAIN) { E.fused(acc, cur, wr, wc, fr, fq, lds, wid, lane); S.done(cur); }
#undef PG8_SA
#undef PG8_SB
#undef PG8_STAGE
#undef PG8_LDA
#undef PG8_LDB
#undef PG8_MMA
#undef PG8_WAIT_V
#undef PG8_WAIT_L
#undef PG8_BAR
#undef PG8_SCHED
}
}

#ifndef MIX_MASK
#define MIX_MASK 7
#endif
#define NAIVE_MIX (MIX_MASK != 7)
constexpr int NB = 16, SEQ = 2048, DM = 1024, MTOK = NB * SEQ, NQ = 4096, DIN = 4102, NL = 2;
constexpr int HF = 6, HR = 6, HS = 4, HD = 64;
constexpr float LN_EPS = 1e-5f, GN_EPS = 1e-5f;
constexpr float DN_ALPHA = 1.4142135623730951f;
constexpr float LOG2E = 1.4426950408889634f;
typedef unsigned short bf16_t;
typedef float f32x4 __attribute__((ext_vector_type(4)));
typedef unsigned u32x4 __attribute__((ext_vector_type(4)));
typedef unsigned u32x2 __attribute__((ext_vector_type(2)));

constexpr size_t MiB = 1u << 20;
constexpr size_t WS_QKVG = 0;
constexpr size_t WS_Y    = 256 * MiB;
constexpr size_t WS_XB   = 320 * MiB;
constexpr size_t WS_WIN  = 384 * MiB;
constexpr size_t WS_WOUT = 400 * MiB;
constexpr size_t WS_FLOG = 404 * MiB;
constexpr size_t WS_C    = 405 * MiB;
constexpr size_t WS_ROPE = 406 * MiB;
constexpr size_t WS_CTR  = 407 * MiB;
constexpr size_t WS_END  = 408 * MiB;

constexpr int LDS_BYTES = 147456;

struct Params {
    const float *x, *w_in, *b_fgate, *gn_gain, *w_out, *ln_gain, *ln_bias;
    float* out; unsigned char* ws;
    int ph_lo, ph_hi;
};

__device__ __forceinline__ unsigned f2bf(float f) { unsigned u = __builtin_bit_cast(unsigned, f); return (u + 0x7fffu + ((u >> 16) & 1u)) >> 16; }
__device__ __forceinline__ unsigned pk2(float lo, float hi) { return f2bf(lo) | (f2bf(hi) << 16); }
__device__ __forceinline__ float bflo(unsigned u) { return __builtin_bit_cast(float, u << 16); }
__device__ __forceinline__ float bfhi(unsigned u) { return __builtin_bit_cast(float, u & 0xffff0000u); }
__device__ __forceinline__ float wave_sum(float v) {
#pragma unroll
    for (int o = 1; o < 64; o <<= 1) v += __shfl_xor(v, o);
    return v;
}
__device__ __forceinline__ float logsig_acc(float z) { return fminf(z, 0.f) - log1pf(expf(-fabsf(z))); }

__device__ __forceinline__ int rowmap_in(int n) {
    const bool r = (n >= 384 && n < 768) || (n >= 1408 && n < 1792); const int d = n & 63; return r ? (n & ~63) + ((d & 31) << 1) + (d >> 5) : n;
}
template <bool MAP> __device__ __forceinline__ void transpose_item(const float* W, int ldw, int K, bf16_t* WT, float* scr, int kb, int nb, int lane) {
    const int k0 = 64 * kb, n0 = 32 * nb;
#pragma unroll 8
    for (int i = 0; i < 32; ++i) { const int kk = 2 * i + (lane >> 5); scr[kk * 33 + (lane & 31)] = W[(size_t)(k0 + kk) * ldw + n0 + (lane & 31)]; }
    __builtin_amdgcn_wave_barrier(); asm volatile("s_waitcnt lgkmcnt(0)" ::: "memory");
    const int c = lane & 7;
#pragma unroll
    for (int j = 0; j < 4; ++j) { const int n = (lane >> 3) + 8 * j; const float* s = scr + (8 * c) * 33 + n;
        u32x4 o; o.x = pk2(s[0 * 33], s[1 * 33]); o.y = pk2(s[2 * 33], s[3 * 33]); o.z = pk2(s[4 * 33], s[5 * 33]); o.w = pk2(s[6 * 33], s[7 * 33]);
        const int nr = MAP ? rowmap_in(n0 + n) : (n0 + n); *(u32x4*)(WT + (size_t)nr * K + k0 + 8 * c) = o; }
    __builtin_amdgcn_wave_barrier(); asm volatile("s_waitcnt lgkmcnt(0)" ::: "memory");
}

__device__ __forceinline__ void stage_wf(const Params& P, int l, float* wfs) {
    for (int i = threadIdx.x; i < 6 * 1024; i += 512) { const int k = i / 6, h = i % 6; wfs[h * 1024 + k] = P.w_in[((size_t)l * DM + k) * DIN + NQ + h]; }
}
__device__ __forceinline__ void row_emit(const f32x4 (&v)[4], bf16_t* xbrow, const float* wfs, float* flogrow, int lane) {
#pragma unroll
    for (int j = 0; j < 4; ++j) { u32x2 o; o.x = pk2(v[j].x, v[j].y); o.y = pk2(v[j].z, v[j].w); ((u32x2*)xbrow)[lane + 64 * j] = o; }
    float a0 = 0.f, a1 = 0.f, a2 = 0.f, a3 = 0.f, a4 = 0.f, a5 = 0.f;
#pragma unroll
    for (int j = 0; j < 4; ++j) {
        const float* wp = wfs + 4 * lane + 256 * j;
        f32x4 w;
        w = *(const f32x4*)(wp);          a0 += v[j].x * w.x + v[j].y * w.y + v[j].z * w.z + v[j].w * w.w;
        w = *(const f32x4*)(wp + 1024);   a1 += v[j].x * w.x + v[j].y * w.y + v[j].z * w.z + v[j].w * w.w;
        w = *(const f32x4*)(wp + 2048);   a2 += v[j].x * w.x + v[j].y * w.y + v[j].z * w.z + v[j].w * w.w;
        w = *(const f32x4*)(wp + 3072);   a3 += v[j].x * w.x + v[j].y * w.y + v[j].z * w.z + v[j].w * w.w;
        w = *(const f32x4*)(wp + 4096);   a4 += v[j].x * w.x + v[j].y * w.y + v[j].z * w.z + v[j].w * w.w;
        w = *(const f32x4*)(wp + 5120);   a5 += v[j].x * w.x + v[j].y * w.y + v[j].z * w.z + v[j].w * w.w;
    }
    a0 = wave_sum(a0); a1 = wave_sum(a1); a2 = wave_sum(a2); a3 = wave_sum(a3); a4 = wave_sum(a4); a5 = wave_sum(a5);
    float r = a0; if (lane == 1) r = a1; if (lane == 2) r = a2; if (lane == 3) r = a3; if (lane == 4) r = a4; if (lane == 5) r = a5;
    if (lane < 6) flogrow[lane] = r;
}

__device__ __forceinline__ void phase0(const Params& P, unsigned char* lds) {
    int tid = threadIdx.x; asm volatile("" : "+v"(tid));
    const int lane = tid & 63, wave = tid >> 6;
    const int gw = blockIdx.x * 8 + wave, NGW = gridDim.x * 8;
    unsigned char* ws = P.ws;
    if (blockIdx.x == 0 && tid < 64) ((unsigned*)(ws + WS_CTR))[tid] = 0u;
    float* scr = (float*)lds + wave * (64 * 33);
    float* wfs = (float*)(lds + 8 * 64 * 33 * 4);
    stage_wf(P, 0, wfs);
    constexpr int I_IN = (DM / 64) * (NQ / 32), I_OUT = (DM / 64) * (DM / 32);
    for (int it = gw; it < NL * (I_IN + I_OUT); it += NGW) {
        int r = it; const int l = r / (I_IN + I_OUT); r -= l * (I_IN + I_OUT);
        if (r < I_IN) transpose_item<true>(P.w_in + (size_t)l * DM * DIN, DIN, DM, (bf16_t*)(ws + WS_WIN) + (size_t)l * NQ * DM, scr, r / (NQ / 32), r % (NQ / 32), lane);
        else { r -= I_IN; transpose_item<false>(P.w_out + (size_t)l * DM * DM, DM, DM, (bf16_t*)(ws + WS_WOUT) + (size_t)l * DM * DM, scr, r / (DM / 32), r % (DM / 32), lane); }
    }
    for (int i = blockIdx.x * 512 + tid; i < SEQ * 32; i += gridDim.x * 512) {
        const int pos = i >> 5, f = i & 31; const float invf = (float)(1.0 / exp2((double)f * (13.287712379549449 / 32.0))); const float ang = (float)pos * invf;
        const double t = (double)ang * 0.15915494309189535; const float fr = (float)(t - floor(t));
        ((float*)(ws + WS_ROPE))[i] = __builtin_amdgcn_cosf(fr); ((float*)(ws + WS_ROPE))[SEQ * 32 + i] = __builtin_amdgcn_sinf(fr);
    }
    __syncthreads();
    for (int m = gw; m < MTOK; m += NGW) {
        const f32x4* xr = (const f32x4*)(P.x + (size_t)m * DM) + lane; f32x4 v[4];
#pragma unroll
        for (int j = 0; j < 4; ++j) v[j] = xr[64 * j];
        row_emit(v, (bf16_t*)(ws + WS_XB) + (size_t)m * DM, wfs, (float*)(ws + WS_FLOG) + (size_t)m * 8, lane);
    }
    __syncthreads();
}

__device__ __forceinline__ void fgate_cumsum(const Params& P, int l) {
    int tid = threadIdx.x; asm volatile("" : "+v"(tid));
    const int lane = tid & 63, wave = tid >> 6;
    const int gw = blockIdx.x * 8 + wave;
    if (gw >= NB * HF) return;
    const int b = gw / HF, h = gw % HF; const float bias = P.b_fgate[l * HF + h];
    const float* fl = (const float*)(P.ws + WS_FLOG) + ((size_t)b * SEQ + lane * 32) * 8 + h;
    float vals[32]; float run = 0.f;
#pragma unroll
    for (int i = 0; i < 32; ++i) { run += logsig_acc(fl[i * 8] + bias); vals[i] = run; }
    float incl = run;
#pragma unroll
    for (int o = 1; o < 64; o <<= 1) { const float t = __shfl_up(incl, o); if (lane >= o) incl += t; }
    const float excl = incl - run;
    float* c = (float*)(P.ws + WS_C) + ((size_t)(b * HF + h)) * SEQ + lane * 32;
#pragma unroll
    for (int i = 0; i < 32; ++i) c[i] = vals[i] + excl;
}

__device__ __forceinline__ void load_row64(const bf16_t* p, float (&f)[64]) {
    const u32x4* q = (const u32x4*)p;
#pragma unroll
    for (int i = 0; i < 8; ++i) { const u32x4 u = q[i];
        f[8 * i + 0] = bflo(u.x); f[8 * i + 1] = bfhi(u.x); f[8 * i + 2] = bflo(u.y); f[8 * i + 3] = bfhi(u.y);
        f[8 * i + 4] = bflo(u.z); f[8 * i + 5] = bfhi(u.z); f[8 * i + 6] = bflo(u.w); f[8 * i + 7] = bfhi(u.w); }
}
__device__ __forceinline__ void unpack8(const u32x4 u, float (&f)[8]) {
    f[0] = bflo(u.x); f[1] = bfhi(u.x); f[2] = bflo(u.y); f[3] = bfhi(u.y); f[4] = bflo(u.z); f[5] = bfhi(u.z); f[6] = bflo(u.w); f[7] = bfhi(u.w);
}
__device__ __forceinline__ float dot64(const float (&q)[64], const bf16_t* krow) {
    float dot = 0.f;
#pragma unroll
    for (int i = 0; i < 8; ++i) { float k[8]; unpack8(((const u32x4*)krow)[i], k);
#pragma unroll
        for (int e = 0; e < 8; ++e) dot += q[8 * i + e] * k[e]; }
    return dot;
}
__device__ __forceinline__ void axpy64(float (&o)[32], float f, float p, const bf16_t* vrow) {
#pragma unroll
    for (int i = 0; i < 4; ++i) { float v[8]; unpack8(((const u32x4*)vrow)[i], v);
#pragma unroll
        for (int e = 0; e < 8; ++e) o[8 * i + e] = o[8 * i + e] * f + p * v[e]; }
}
__device__ __forceinline__ void naive_mixers(const Params& P, int l) {
    const bf16_t* qkvg = (const bf16_t*)(P.ws + WS_QKVG);
    const float* cc = (const float*)(P.ws + WS_C);
    bf16_t* Y = (bf16_t*)(P.ws + WS_Y);
    for (int it = blockIdx.x * 512 + threadIdx.x; it < NB * 16 * SEQ * 2; it += gridDim.x * 512) {
        const int dh = it & 1, t = (it >> 1) % SEQ, hh = (it / (SEQ * 2)) % 16, b = it / (SEQ * 32);
        { const int ty = hh < HF ? 1 : (hh < HF + HR ? 2 : 4); if (MIX_MASK & ty) continue; }
        const bf16_t* base = qkvg + (size_t)b * SEQ * NQ + hh * 64;
        float q[64], o[32];
        load_row64(base + (size_t)t * NQ, q);
#pragma unroll
        for (int d = 0; d < 32; ++d) o[d] = 0.f;
        if (hh < HF) {
            const float* c = cc + (size_t)(b * HF + hh) * SEQ; const float ct = c[t];
            float m = -INFINITY, lsum = 0.f;
            for (int s = 0; s <= t; ++s) {
                const float sc = dot64(q, base + (size_t)s * NQ + 1024) * 0.125f + ct - c[s];
                const float mn = fmaxf(m, sc), f = expf(m - mn), p = expf(sc - mn);
                lsum = lsum * f + p; m = mn;
                axpy64(o, f, p, base + (size_t)s * NQ + 2048 + dh * 32);
            }
            const float inv = 1.f / lsum;
#pragma unroll
            for (int d = 0; d < 32; ++d) o[d] *= inv;
        } else if (hh < HF + HR) {
            const int hr = hh - HF; const float lg = logf(1.f - exp2f(-5.f - (float)hr));
            for (int s = 0; s <= t; ++s) {
                const float w = dot64(q, base + (size_t)s * NQ + 1024) * expf((float)(t - s) * lg);
                axpy64(o, 1.f, w, base + (size_t)s * NQ + 2048 + dh * 32);
            }
            float mu = 0.f;
#pragma unroll
            for (int d = 0; d < 32; ++d) mu += o[d];
            float var = 0.f;
            mu = (mu + __shfl_xor(mu, 1)) * (1.f / 64.f);
#pragma unroll
            for (int d = 0; d < 32; ++d) { o[d] -= mu; var += o[d] * o[d]; }
            var += __shfl_xor(var, 1);
            const float rs = rsqrtf(var * (1.f / 64.f) + GN_EPS); const float* gg = P.gn_gain + l * (HR * 64) + hr * 64 + dh * 32;
#pragma unroll
            for (int d = 0; d < 32; ++d) o[d] = o[d] * rs * gg[d];
        } else {
            float R = 0.f;
            for (int s = t - 1; s >= 0; --s) {
                const float z = dot64(q, base + (size_t)s * NQ + 1024) * 0.125f, ls = logsig_acc(z), a = expf(ls + R); R += ls - z;
                axpy64(o, 1.f, a, base + (size_t)s * NQ + 2048 + dh * 32);
            }
        }
        const bf16_t* gr = base + (size_t)t * NQ + 3072 + dh * 32;
        bf16_t* yr = Y + ((size_t)b * SEQ + t) * DM + hh * 64 + dh * 32;
#pragma unroll
        for (int i = 0; i < 4; ++i) { float g[8], gt[8]; unpack8(((const u32x4*)gr)[i], gt);
#pragma unroll
            for (int e = 0; e < 8; ++e) g[e] = o[8 * i + e] * gt[e] / (1.f + expf(-gt[e]));
            u32x4 w; w.x = pk2(g[0], g[1]); w.y = pk2(g[2], g[3]); w.z = pk2(g[4], g[5]); w.w = pk2(g[6], g[7]); ((u32x4*)yr)[i] = w; }
    }
}

typedef short bf16x8 __attribute__((ext_vector_type(8)));
typedef short s16x4 __attribute__((ext_vector_type(4)));
typedef float f32x16 __attribute__((ext_vector_type(16)));
typedef float f32x2_t __attribute__((ext_vector_type(2)));
typedef __bf16 bf16x2_t __attribute__((ext_vector_type(2)));
__device__ __forceinline__ unsigned cvtpk(float lo, float hi) { f32x2_t v = {lo, hi}; bf16x2_t b = __builtin_convertvector(v, bf16x2_t); return __builtin_bit_cast(unsigned, b); }
#define PACK8(P, B) __builtin_bit_cast(bf16x8, (u32x4){cvtpk(P[B], P[B + 1]), cvtpk(P[B + 2], P[B + 3]), cvtpk(P[B + 4], P[B + 5]), cvtpk(P[B + 6], P[B + 7])})
#define MFMA32(a, b, c) __builtin_amdgcn_mfma_f32_32x32x16_bf16((a), (b), (c), 0, 0, 0)
__device__ __forceinline__ int crow(int r, int hi) { return (r & 3) + 8 * (r >> 2) + 4 * hi; }
constexpr int KP = 72, VP = 68, SP = 68;
constexpr int L_K = 0, L_V = L_K + 2 * 64 * KP * 2, L_C2 = L_V + 2 * 64 * VP * 2, L_WSF = L_C2 + SEQ * 4, L_STG = L_WSF + 8 * 64 * 4, L_FLG = L_STG + 8 * 32 * SP * 4, L_QW = L_FLG + 64, L_KT = L_QW + 16, L_ST = L_KT + 2 * 64 * KP * 2, L_MIX_END = L_ST + 64 * KP * 2;
static_assert(L_MIX_END <= LDS_BYTES, "mixer LDS map");
constexpr float C2S = 0.125f * 1.4426950408889634f;
constexpr float SB_CUT = -160.f;

template <int MODE> __device__ __forceinline__ void attn_unit(const Params& P, int l, int b, int hh, int qb_arg, unsigned char* lds) {
    int tid = threadIdx.x; asm volatile("" : "+v"(tid));
    const int lane = tid & 63, wave = __builtin_amdgcn_readfirstlane(tid >> 6), r32 = lane & 31, hi = lane >> 5;
    const bf16_t* base = (const bf16_t*)(P.ws + WS_QKVG) + (size_t)b * SEQ * NQ + hh * 64;
    bf16_t* Ks = (bf16_t*)(lds + L_K); bf16_t* Vt = (bf16_t*)(lds + L_V); float* c2s = (float*)(lds + L_C2);
    bf16_t* Ktt = (bf16_t*)(lds + L_KT); bf16_t* St = (bf16_t*)(lds + L_ST);
    float* wsf = (float*)(lds + L_WSF) + wave * 64; float* stg = (float*)(lds + L_STG) + wave * (32 * SP);
    const float lg2 = (MODE == 2) ? log2f(1.f - exp2f(-5.f - (float)(hh - HF))) : 0.f;
    f32x16 sacc;
#pragma unroll
    for (int r = 0; r < 16; ++r) sacc[r] = 0.f;
  for (int qb = (MODE == 2 ? 0 : qb_arg); qb <= (MODE == 2 ? 7 : qb_arg); ++qb) {
    const int q0 = qb * 256, qw0 = q0 + wave * 32, t = qw0 + r32;
    const int NT = (MODE == 2) ? 4 : 4 * (qb + 1);
    __syncthreads();
    float ct2 = 0.f;
    if (MODE == 0) {
        const float* cg_ = (const float*)(P.ws + WS_C) + (size_t)(b * HF + hh) * SEQ;
        for (int i = tid; i < q0 + 256; i += 512) c2s[i] = cg_[i] * LOG2E;
        ct2 = cg_[t] * LOG2E;
    }
    bf16x8 qf[4];
#pragma unroll
    for (int d0 = 0; d0 < 4; ++d0) qf[d0] = *(const bf16x8*)(base + (size_t)t * NQ + d0 * 16 + hi * 8);
    const int lk_key = tid >> 3, lk_ch = tid & 7, lv_key = tid & 63, lv_ch = tid >> 6;
    const bf16_t* kg = base + 1024 + (size_t)lk_key * NQ + lk_ch * 8;
    const bf16_t* vg = base + 2048 + (size_t)lv_key * NQ + lv_ch * 8;
    const int kt0 = (MODE == 1) ? NT - 1 : (MODE == 2 ? 4 * qb : 0), kstep = (MODE == 1) ? -1 : 1;
    const bf16_t* kg2 = base + 1024 + (size_t)lv_key * NQ + lv_ch * 8;
    u32x4 kreg = *(const u32x4*)(kg + (size_t)kt0 * 64 * NQ), vreg = *(const u32x4*)(vg + (size_t)kt0 * 64 * NQ), kreg2 = {0u, 0u, 0u, 0u};
    if (MODE == 2) kreg2 = *(const u32x4*)(kg2 + (size_t)kt0 * 64 * NQ);
    f32x16 o0, o1;
#pragma unroll
    for (int r = 0; r < 16; ++r) { o0[r] = 0.f; o1[r] = 0.f; }
    if (MODE == 2) {
        if (qb > 0) {
#pragma unroll
            for (int d0 = 0; d0 < 4; ++d0) {
                const bf16x8 s0 = *(const bf16x8*)(St + r32 * KP + d0 * 16 + hi * 8), s1 = *(const bf16x8*)(St + (32 + r32) * KP + d0 * 16 + hi * 8);
                o0 = MFMA32(qf[d0], s0, o0); o1 = MFMA32(qf[d0], s1, o1);
            }
            if (hi == 0) wsf[r32] = __builtin_amdgcn_exp2f((float)(t - q0) * lg2);
            __builtin_amdgcn_wave_barrier();
#pragma unroll
            for (int g = 0; g < 4; ++g) { const f32x4 a = *(const f32x4*)(wsf + 8 * g + 4 * hi);
#pragma unroll
                for (int j = 0; j < 4; ++j) { o0[4 * g + j] *= a[j]; o1[4 * g + j] *= a[j]; } }
            __builtin_amdgcn_wave_barrier();
            if (wave < 4) { const float gC = __builtin_amdgcn_exp2f(256.f * lg2);
#pragma unroll
                for (int r = 0; r < 16; ++r) sacc[r] *= gC; }
        }
    }
    float m = -INFINITY, lsum = 0.f, R = 0.f;
    bool wdone = false;
    volatile int* flg = (volatile int*)(lds + L_FLG);
    for (int it = 0; it < NT; ++it) {
        const int kt = kt0 + kstep * it;
        if (MODE == 1) { if (lane == 0) flg[(it & 1) * 8 + wave] = wdone ? 1 : 0; }
        bf16_t* Kb = Ks + (it & 1) * (64 * KP); bf16_t* Vb = Vt + (it & 1) * (64 * VP);
        *(u32x4*)(Kb + lk_key * KP + lk_ch * 8) = kreg;
        { bf16_t* vd = Vb + (lv_ch * 8) * VP + lv_key;
          vd[0 * VP] = (bf16_t)(vreg.x & 0xffffu); vd[1 * VP] = (bf16_t)(vreg.x >> 16); vd[2 * VP] = (bf16_t)(vreg.y & 0xffffu); vd[3 * VP] = (bf16_t)(vreg.y >> 16);
          vd[4 * VP] = (bf16_t)(vreg.z & 0xffffu); vd[5 * VP] = (bf16_t)(vreg.z >> 16); vd[6 * VP] = (bf16_t)(vreg.w & 0xffffu); vd[7 * VP] = (bf16_t)(vreg.w >> 16); }
        if (MODE == 2) {
            bf16_t* kd = Ktt + (it & 1) * (64 * KP) + (lv_ch * 8) * KP + lv_key;
            const float f = __builtin_amdgcn_exp2f((float)(q0 + 256 - (64 * kt + lv_key)) * lg2);
            kd[0 * KP] = (bf16_t)f2bf(bflo(kreg2.x) * f); kd[1 * KP] = (bf16_t)f2bf(bfhi(kreg2.x) * f); kd[2 * KP] = (bf16_t)f2bf(bflo(kreg2.y) * f); kd[3 * KP] = (bf16_t)f2bf(bfhi(kreg2.y) * f);
            kd[4 * KP] = (bf16_t)f2bf(bflo(kreg2.z) * f); kd[5 * KP] = (bf16_t)f2bf(bfhi(kreg2.z) * f); kd[6 * KP] = (bf16_t)f2bf(bflo(kreg2.w) * f); kd[7 * KP] = (bf16_t)f2bf(bfhi(kreg2.w) * f);
        }
        __syncthreads();
        if (MODE == 1) { int alld = 1;
#pragma unroll
            for (int w = 0; w < 8; ++w) alld &= flg[(it & 1) * 8 + w];
            if (alld) break; }
        if (it + 1 < NT) { kreg = *(const u32x4*)(kg + (size_t)(kt + kstep) * 64 * NQ); vreg = *(const u32x4*)(vg + (size_t)(kt + kstep) * 64 * NQ);
            if (MODE == 2) kreg2 = *(const u32x4*)(kg2 + (size_t)(kt + kstep) * 64 * NQ); }
        if (64 * kt <= qw0 + 31 && !(MODE == 1 && wdone)) {
            f32x16 p0, p1;
#pragma unroll
            for (int r = 0; r < 16; ++r) { p0[r] = 0.f; p1[r] = 0.f; }
#pragma unroll
            for (int d0 = 0; d0 < 4; ++d0) {
                const bf16x8 ka = *(const bf16x8*)(Kb + r32 * KP + d0 * 16 + hi * 8), kb2 = *(const bf16x8*)(Kb + (32 + r32) * KP + d0 * 16 + hi * 8);
                p0 = MFMA32(ka, qf[d0], p0); p1 = MFMA32(kb2, qf[d0], p1);
            }
            const int key0 = 64 * kt + 4 * hi;
            if (MODE == 0) {
                const float* cs = c2s + key0;
#pragma unroll
                for (int g = 0; g < 4; ++g) { const f32x4 ca = *(const f32x4*)(cs + 8 * g), cb = *(const f32x4*)(cs + 32 + 8 * g);
#pragma unroll
                    for (int j = 0; j < 4; ++j) { p0[4 * g + j] = p0[4 * g + j] * C2S + (ct2 - ca[j]); p1[4 * g + j] = p1[4 * g + j] * C2S + (ct2 - cb[j]); } }
                if (64 * kt + 63 > qw0) {
#pragma unroll
                    for (int r = 0; r < 16; ++r) { const int key = key0 + (r & 3) + 8 * (r >> 2); if (key > t) p0[r] = -INFINITY; if (key + 32 > t) p1[r] = -INFINITY; }
                }
                float mx = fmaxf(p0[0], p1[0]);
#pragma unroll
                for (int r = 1; r < 16; ++r) mx = fmaxf(mx, fmaxf(p0[r], p1[r]));
                mx = fmaxf(mx, __shfl_xor(mx, 32));
                const float mn = fmaxf(m, mx), alpha = __builtin_amdgcn_exp2f(m - mn);
                float ps = 0.f;
#pragma unroll
                for (int r = 0; r < 16; ++r) { p0[r] = __builtin_amdgcn_exp2f(p0[r] - mn); p1[r] = __builtin_amdgcn_exp2f(p1[r] - mn); ps += p0[r] + p1[r]; }
                lsum = lsum * alpha + ps; m = mn;
                if (__any(alpha != 1.f)) {
                    if (hi == 0) wsf[r32] = alpha;
                    __builtin_amdgcn_wave_barrier();
#pragma unroll
                    for (int g = 0; g < 4; ++g) { const f32x4 a = *(const f32x4*)(wsf + 8 * g + 4 * hi);
#pragma unroll
                        for (int j = 0; j < 4; ++j) { o0[4 * g + j] *= a[j]; o1[4 * g + j] *= a[j]; } }
                    __builtin_amdgcn_wave_barrier();
                }
            } else if (MODE == 1) {
                const bool diag = (64 * kt + 63 >= qw0);
#pragma unroll
                for (int r = 0; r < 16; ++r) { p0[r] *= C2S; p1[r] *= C2S; }
                if (diag) {
#pragma unroll
                    for (int r = 0; r < 16; ++r) { const int key = key0 + (r & 3) + 8 * (r >> 2); if (key >= t) p0[r] = -1e30f; if (key + 32 >= t) p1[r] = -1e30f; }
                }
                float lr[32];
#pragma unroll
                for (int r = 0; r < 16; ++r) {
                    const float za = p0[r], zb = p1[r];
                    const float spa = __builtin_amdgcn_logf(1.f + __builtin_amdgcn_exp2f(-fabsf(za))), spb = __builtin_amdgcn_logf(1.f + __builtin_amdgcn_exp2f(-fabsf(zb)));
                    lr[r] = (fminf(za, 0.f) - spa) - za; lr[16 + r] = (fminf(zb, 0.f) - spb) - zb;
                }
                float SI[9]; SI[8] = 0.f;
#pragma unroll
                for (int i = 7; i >= 0; --i) SI[i] = SI[i + 1] + ((lr[4 * i] + lr[4 * i + 1]) + (lr[4 * i + 2] + lr[4 * i + 3]));
                float E[8];
#pragma unroll
                for (int i = 0; i < 8; ++i) { const float snd = hi ? SI[i] : SI[i + 1]; E[i] = SI[i + 1] + __shfl_xor(snd, 32); }
                const float T = SI[0] + __shfl_xor(SI[0], 32);
#pragma unroll
                for (int i = 0; i < 8; ++i) {
                    const float bs = R + E[i];
                    const float w2 = lr[4 * i + 3], w1 = w2 + lr[4 * i + 2], w0 = w1 + lr[4 * i + 1];
                    if (i < 4) { p0[4 * i + 3] = __builtin_amdgcn_exp2f(p0[4 * i + 3] + lr[4 * i + 3] + bs); p0[4 * i + 2] = __builtin_amdgcn_exp2f(p0[4 * i + 2] + lr[4 * i + 2] + bs + w2);
                                 p0[4 * i + 1] = __builtin_amdgcn_exp2f(p0[4 * i + 1] + lr[4 * i + 1] + bs + w1); p0[4 * i + 0] = __builtin_amdgcn_exp2f(p0[4 * i + 0] + lr[4 * i + 0] + bs + w0); }
                    else { const int q = 4 * (i - 4);
                                 p1[q + 3] = __builtin_amdgcn_exp2f(p1[q + 3] + lr[4 * i + 3] + bs); p1[q + 2] = __builtin_amdgcn_exp2f(p1[q + 2] + lr[4 * i + 2] + bs + w2);
                                 p1[q + 1] = __builtin_amdgcn_exp2f(p1[q + 1] + lr[4 * i + 1] + bs + w1); p1[q + 0] = __builtin_amdgcn_exp2f(p1[q + 0] + lr[4 * i + 0] + bs + w0); }
                }
                R += T;
                wdone = __all(R < SB_CUT);
            } else {
                const bool diag = (64 * kt + 63 > qw0);
#pragma unroll
                for (int r = 0; r < 16; ++r) { const int key = key0 + (r & 3) + 8 * (r >> 2);
                    p0[r] *= __builtin_amdgcn_exp2f((float)(t - key) * lg2); p1[r] *= __builtin_amdgcn_exp2f((float)(t - key - 32) * lg2);
                    if (diag) { if (key > t) p0[r] = 0.f; if (key + 32 > t) p1[r] = 0.f; } }
            }
#pragma unroll
            for (int blk = 0; blk < 2; ++blk)
#pragma unroll
                for (int s = 0; s < 2; ++s) {
                    const bf16x8 pf = blk ? PACK8(p1, 8 * s) : PACK8(p0, 8 * s);
                    const bf16_t* vp = Vb + r32 * VP + blk * 32 + 16 * s + 4 * hi;
                    const s16x4 a0 = *(const s16x4*)(vp), a1 = *(const s16x4*)(vp + 8), b0 = *(const s16x4*)(vp + 32 * VP), b1 = *(const s16x4*)(vp + 32 * VP + 8);
                    o0 = MFMA32(pf, __builtin_shufflevector(a0, a1, 0, 1, 2, 3, 4, 5, 6, 7), o0);
                    o1 = MFMA32(pf, __builtin_shufflevector(b0, b1, 0, 1, 2, 3, 4, 5, 6, 7), o1);
                }
        }
        if (MODE == 2 && wave < 4) {
            const bf16_t* Ktb = Ktt + (it & 1) * (64 * KP) + (32 * (wave & 1) + r32) * KP + hi * 8;
            const bf16_t* Vtb = Vb + (32 * (wave >> 1) + r32) * VP + hi * 8;
#pragma unroll
            for (int ks = 0; ks < 4; ++ks) {
                const bf16x8 ka = *(const bf16x8*)(Ktb + 16 * ks);
                const s16x4 v0 = *(const s16x4*)(Vtb + 16 * ks), v1 = *(const s16x4*)(Vtb + 16 * ks + 4);
                sacc = MFMA32(ka, __builtin_shufflevector(v0, v1, 0, 1, 2, 3, 4, 5, 6, 7), sacc);
            }
        }
    }
    if (MODE == 0) {
        lsum += __shfl_xor(lsum, 32);
        if (hi == 0) wsf[r32] = 1.f / lsum;
        __builtin_amdgcn_wave_barrier();
    }
#pragma unroll
    for (int g = 0; g < 4; ++g) {
        f32x4 a = {1.f, 1.f, 1.f, 1.f};
        if (MODE == 0) a = *(const f32x4*)(wsf + 8 * g + 4 * hi);
#pragma unroll
        for (int j = 0; j < 4; ++j) { const int row = 8 * g + 4 * hi + j; stg[row * SP + r32] = o0[4 * g + j] * a[j]; stg[row * SP + 32 + r32] = o1[4 * g + j] * a[j]; }
    }
    __builtin_amdgcn_wave_barrier();
    bf16_t* Y = (bf16_t*)(P.ws + WS_Y) + ((size_t)b * SEQ + qw0) * DM + hh * 64;
    const float* gg = P.gn_gain + l * (HR * 64) + (MODE == 2 ? (hh - HF) * 64 : 0);
#pragma unroll
    for (int i = 0; i < 8; ++i) {
        const int row = i * 4 + (lane >> 4), ch = lane & 15;
        f32x4 ov = *(const f32x4*)(stg + row * SP + ch * 4);
        if (MODE == 2) {
            float s = (ov[0] + ov[1]) + (ov[2] + ov[3]);
            s += __shfl_xor(s, 1); s += __shfl_xor(s, 2); s += __shfl_xor(s, 4); s += __shfl_xor(s, 8);
            const float mu = s * (1.f / 64.f); ov = ov - mu;
            float v2 = (ov[0] * ov[0] + ov[1] * ov[1]) + (ov[2] * ov[2] + ov[3] * ov[3]);
            v2 += __shfl_xor(v2, 1); v2 += __shfl_xor(v2, 2); v2 += __shfl_xor(v2, 4); v2 += __shfl_xor(v2, 8);
            const float rs = rsqrtf(v2 * (1.f / 64.f) + GN_EPS); const f32x4 gv = *(const f32x4*)(gg + ch * 4);
            ov = ov * rs * gv;
        }
        const u32x2 gt = *(const u32x2*)(base + (size_t)(qw0 + row) * NQ + 3072 + ch * 4);
        const float g0 = bflo(gt.x), g1 = bfhi(gt.x), g2 = bflo(gt.y), g3 = bfhi(gt.y);
        u32x2 w; w.x = cvtpk(ov[0] * g0 / (1.f + __expf(-g0)), ov[1] * g1 / (1.f + __expf(-g1))); w.y = cvtpk(ov[2] * g2 / (1.f + __expf(-g2)), ov[3] * g3 / (1.f + __expf(-g3)));
        *(u32x2*)(Y + (size_t)row * DM + ch * 4) = w;
    }
    if (MODE == 2 && wave < 4 && qb < 7) {
        bf16_t* sp = St + (32 * (wave >> 1) + r32) * KP + 32 * (wave & 1) + 4 * hi;
#pragma unroll
        for (int g = 0; g < 4; ++g) { u32x2 w; w.x = cvtpk(sacc[4 * g], sacc[4 * g + 1]); w.y = cvtpk(sacc[4 * g + 2], sacc[4 * g + 3]); *(u32x2*)(sp + 8 * g) = w; }
    }
  }
}

__device__ __forceinline__ void mixer_phase(const Params& P, int l, unsigned char* lds, int slot) {
    unsigned* ctr = (unsigned*)(P.ws + WS_CTR) + 16 * slot;
    volatile int* qw = (volatile int*)(lds + L_QW);
    for (;;) {
        __syncthreads();
        if (threadIdx.x == 0) qw[0] = (int)atomicAdd(ctr, 1u);
        __syncthreads();
        const int u = qw[0];
        if (u >= 96 + 8 * 160) break;
        if (u < 96) { if (MIX_MASK & 2) attn_unit<2>(P, l, u / 6, HF + u % 6, 0, lds); }
        else { const int v = u - 96, qb = 7 - v / 160, idx = v % 160;
            if (idx < 96) { if (MIX_MASK & 1) attn_unit<0>(P, l, idx / 6, idx % 6, qb, lds); }
            else { if (MIX_MASK & 4) attn_unit<1>(P, l, (idx - 96) / 4, HF + HR + (idx - 96) % 4, qb, lds); } }
    }
    __syncthreads();
}

__device__ __forceinline__ void phase4(const Params& P, int l, unsigned char* lds) {
    int tid = threadIdx.x; asm volatile("" : "+v"(tid));
    const int lane = tid & 63, wave = tid >> 6;
    const int gw = blockIdx.x * 8 + wave, NGW = gridDim.x * 8;
    float* wfs = (float*)lds;
    if (l + 1 < NL) { stage_wf(P, l + 1, wfs); }
    __syncthreads();
    const float* gp = P.ln_gain + l * DM; const float* bp = P.ln_bias + l * DM;
    f32x4 g[4], bb[4];
#pragma unroll
    for (int j = 0; j < 4; ++j) { g[j] = ((const f32x4*)gp)[lane + 64 * j]; bb[j] = ((const f32x4*)bp)[lane + 64 * j]; }
    for (int m = gw; m < MTOK; m += NGW) {
        f32x4* xr = (f32x4*)(P.out + (size_t)m * DM) + lane; f32x4 v[4]; float s = 0.f;
#pragma unroll
        for (int j = 0; j < 4; ++j) { v[j] = xr[64 * j]; s += (v[j].x + v[j].y) + (v[j].z + v[j].w); }
        const float mean = wave_sum(s) * (1.f / DM); float s2 = 0.f;
#pragma unroll
        for (int j = 0; j < 4; ++j) { v[j] = v[j] - mean; s2 += (v[j].x * v[j].x + v[j].y * v[j].y) + (v[j].z * v[j].z + v[j].w * v[j].w); }
        const float rstd = rsqrtf(wave_sum(s2) * (1.f / DM) + LN_EPS);
#pragma unroll
        for (int j = 0; j < 4; ++j) { v[j] = v[j] * rstd * g[j] + bb[j]; xr[64 * j] = v[j]; }
        if (l + 1 < NL) row_emit(v, (bf16_t*)(P.ws + WS_XB) + (size_t)m * DM, wfs, (float*)(P.ws + WS_FLOG) + (size_t)m * 8, lane);
    }
    __syncthreads();
}

#if NAIVE_MIX
__global__ void __launch_bounds__(512) naive_mix_kernel(Params P, int l) { naive_mixers(P, l); }
#endif
__global__ void __launch_bounds__(512) hybrid_fwd(Params P) {
    extern __shared__ __attribute__((aligned(16))) unsigned char lds[];
    cg::grid_group grid = cg::this_grid();
    unsigned char* ws = P.ws;
    const int lo = P.ph_lo, hi = P.ph_hi;
#define RUN(k) (lo <= (k) && (k) < hi)
#define SEAM(k) do { if (RUN(k) && RUN((k) + 1)) grid.sync(); } while (0)
    if (RUN(0)) phase0(P, lds);
    SEAM(0);
#pragma unroll
    for (int l = 0; l < NL; ++l) {
        if (RUN(1 + 4 * l)) {
          fgate_cumsum(P, l);
          pg8::Gemm g{(const bf16_t*)(ws + WS_XB), (const bf16_t*)(ws + WS_WIN) + (size_t)l * NQ * DM, MTOK, NQ, DM};
          pg8::StaticOrder S; S.init(MTOK, NQ, (int)gridDim.x, (int)blockIdx.x);
          pg8::EpiInProj E{(bf16_t*)(ws + WS_QKVG), (const float*)(ws + WS_ROPE)};
          pg8::gemm_phase<pg8::EpiInProj, pg8::StaticOrder, true, true>((PG8_LAS unsigned char*)lds, g, S, E);
#ifdef PROBE_GEMM2
          grid.sync(); pg8::gemm_phase<pg8::EpiInProj, pg8::StaticOrder, true, true>((PG8_LAS unsigned char*)lds, g, S, E);
#endif
        }
        SEAM(1 + 4 * l);
        if (RUN(2 + 4 * l)) { mixer_phase(P, l, lds, l);
#ifdef PROBE_MIX2
            grid.sync(); mixer_phase(P, l, lds, 2 + l);
#endif
        }
        SEAM(2 + 4 * l);
        if (RUN(3 + 4 * l)) {
          pg8::Gemm g{(const bf16_t*)(ws + WS_Y), (const bf16_t*)(ws + WS_WOUT) + (size_t)l * DM * DM, MTOK, DM, DM};
          pg8::StaticOrder S; S.init(MTOK, DM, (int)gridDim.x, (int)blockIdx.x);
          pg8::EpiResid E{l == 0 ? P.x : P.out, P.out, DM, DN_ALPHA};
          pg8::gemm_phase<pg8::EpiResid, pg8::StaticOrder, true, true>((PG8_LAS unsigned char*)lds, g, S, E); }
        SEAM(3 + 4 * l);
        if (RUN(4 + 4 * l)) phase4(P, l, lds);
        SEAM(4 + 4 * l);
    }
#undef RUN
#undef SEAM
}

extern "C" void kernel_launch(void* const* d_in, const int* in_sizes, int n_in, void* d_out, int out_size, void* d_ws, size_t ws_size, hipStream_t stream) {
    static int grid_blocks = 0;
    if (grid_blocks == 0) {
        if (n_in != 7 || out_size != MTOK * DM || ws_size < WS_END) { fprintf(stderr, "kernel_launch: unexpected shapes (n_in %d out %d ws %zu)\n", n_in, out_size, ws_size); grid_blocks = -1; return; }
        int dev = 0, cus = 0, per_cu = 0;
        (void)hipGetDevice(&dev);
        (void)hipDeviceGetAttribute(&cus, hipDeviceAttributeMultiprocessorCount, dev);
        if (hipFuncSetAttribute((const void*)hybrid_fwd, hipFuncAttributeMaxDynamicSharedMemorySize, LDS_BYTES) != hipSuccess) { fprintf(stderr, "kernel_launch: hipFuncSetAttribute failed\n"); grid_blocks = -1; return; }
        if (hipOccupancyMaxActiveBlocksPerMultiprocessor(&per_cu, (const void*)hybrid_fwd, 512, LDS_BYTES) != hipSuccess || per_cu < 1) { fprintf(stderr, "kernel_launch: occupancy query failed (%d)\n", per_cu); per_cu = 1; (void)hipGetLastError(); }
        grid_blocks = cus * per_cu;
    }
    if (grid_blocks < 0) return;
    Params p{};
    p.x = (const float*)d_in[0]; p.w_in = (const float*)d_in[1]; p.b_fgate = (const float*)d_in[2]; p.gn_gain = (const float*)d_in[3];
    p.w_out = (const float*)d_in[4]; p.ln_gain = (const float*)d_in[5]; p.ln_bias = (const float*)d_in[6];
    p.out = (float*)d_out; p.ws = (unsigned char*)d_ws;
#if NAIVE_MIX
    const int cuts[4] = {0, 3, 7, 9};
    for (int i = 0; i < 3; ++i) {
        p.ph_lo = cuts[i]; p.ph_hi = cuts[i + 1];
        void* args[] = {&p};
        hipError_t e = hipLaunchCooperativeKernel((const void*)hybrid_fwd, dim3(grid_blocks), dim3(512), args, LDS_BYTES, stream);
        if (e != hipSuccess) fprintf(stderr, "cooperative launch failed: %s (grid %d)\n", hipGetErrorString(e), grid_blocks);
        if (i < 2) hipLaunchKernelGGL(naive_mix_kernel, dim3(grid_blocks), dim3(512), 0, stream, p, i);
    }
#else
    p.ph_lo = 0; p.ph_hi = 9;
    void* args[] = {&p};
    hipError_t e = hipLaunchCooperativeKernel((const void*)hybrid_fwd, dim3(grid_blocks), dim3(512), args, LDS_BYTES, stream);
    if (e != hipSuccess) fprintf(stderr, "cooperative launch failed: %s (grid %d)\n", hipGetErrorString(e), grid_blocks);
#endif
}
```

```cpp
#include <hip/hip_runtime.h>
#include <hip/hip_cooperative_groups.h>
#include <cstdio>
#include <cstdint>
#include <cmath>
namespace cg = cooperative_groups;
namespace pg8 {
#define PG8_LAS __attribute__((address_space(3)))
typedef unsigned short bf16_t;
typedef short bf16x8 __attribute__((ext_vector_type(8)));
typedef float f32x4 __attribute__((ext_vector_type(4)));
typedef unsigned u32x4 __attribute__((ext_vector_type(4)));
constexpr int BM = 256, BK = 64, HALF = 128, HTB = HALF * BK * 2  , STAGE_BYTES = 8 * HTB, NXCD = 8, WGM = 8;

__host__ __device__ __forceinline__ int lds_byte(int r, int c) { const int st = (r >> 4) * 2 + (c >> 5), rr = r & 15, cc = c & 31, ob = rr * 64 + cc * 2; return st * 1024 + (ob ^ (((ob >> 9) & 1) << 5)); }
__host__ __device__ __forceinline__ void stage_rc(int b, int& R, int& C) { const int st = b / 1024, sb = b % 1024, swz = sb ^ (((sb >> 9) & 1) << 5); R = (st >> 1) * 16 + swz / 64; C = (st & 1) * 32 + (swz % 64) / 2; }
__host__ __device__ __forceinline__ int perm32(int rho) { const int n = rho >> 4, i = rho & 15; return 8 * (i >> 2) + 4 * n + (i & 3); }

struct Unit { int pm, pn; };
struct Gemm { const bf16_t* A; const bf16_t* Bt; int M, N, K; };

struct StaticOrder {
    int nM, nN, nwg, G, c;
    __host__ __device__ void init(int M, int N, int G_, int c_) { nM = M / BM; nN = N / BM; nwg = nM * nN; G = G_; c = c_; }
    __host__ __device__ bool next(int i, Unit& u) const {
        const long L = (long)i * G + c; if (L >= nwg) return false;
        int wgid = (int)L; { const int q = nwg / NXCD, r = nwg % NXCD, xcd = wgid % NXCD, off = wgid / NXCD; wgid = (xcd < r ? xcd * (q + 1) : r * (q + 1) + (xcd - r) * q) + off; }
        const int nig = WGM * nN, gid = wgid / nig, fm = gid * WGM, gsz = (nM - fm) < WGM ? (nM - fm) : WGM;
        u.pm = fm + ((wgid % nig) % gsz); u.pn = (wgid % nig) / gsz; return true;
    }
    __device__ __forceinline__ void a_ready(const Unit&) const {}
    __device__ __forceinline__ void done(const Unit&) const {}
};

__device__ __forceinline__ unsigned cvt_pk_bf16(float lo, float hi) { unsigned r; asm volatile("v_cvt_pk_bf16_f32 %0, %1, %2" : "=v"(r) : "v"(lo), "v"(hi)); return r; }
typedef float f32x2 __attribute__((ext_vector_type(2)));
__device__ __forceinline__ f32x2 gelu_pk(f32x2 v) {
    const f32x2 av = __builtin_elementwise_abs(v), d = av * 0.2316418882f + 1.0f;
    f32x2 t; t.x = __builtin_amdgcn_rcpf(d.x); t.y = __builtin_amdgcn_rcpf(d.y);
    f32x2 q = t * 0.5307027145f + (-0.7265760135f); q = q * t + 0.7107068705f; q = q * t + (-0.142248368f); q = q * t + 0.127414796f; q = q * t;
    const f32x2 s = (v * v) * (-0.72134752044f);
    f32x2 e; e.x = __builtin_amdgcn_exp2f(s.x); e.y = __builtin_amdgcn_exp2f(s.y);
    const f32x2 m = v * (q * e), r = v - m;
    f32x2 o; o.x = v.x < 0.f ? m.x : r.x; o.y = v.y < 0.f ? m.y : r.y; return o;
}

template <int ACT  > struct EpiBf16 {
    static constexpr bool PERM = true, AFTER_DRAIN = false; static_assert(ACT == 0 || ACT == 1, "EpiBf16: ACT is 0 (none) or 1 (gelu_pk)");
    bf16_t* O; int ldc; const float* bias; int split_cols; size_t split_stride; float scale0;
    __device__ __forceinline__ void operator()(const f32x4 (&acc)[2][2][4][2], const Unit& u, int wr, int wc, int fr, int fq) const {
        const int row0 = u.pm * BM + wr * 64 + fr; int colt = u.pn * BM; bf16_t* base = O;
        float sc = 1.f; if (split_cols) { const int t = colt / split_cols; base += (size_t)t * split_stride; colt -= t * split_cols; if (t == 0) sc = scale0; }
        const int col0 = colt + wc * 32 + 8 * fq, bcol0 = u.pn * BM + wc * 32 + 8 * fq;
        f32x4 bv[2][2];
#pragma unroll
        for (int bj = 0; bj < 2; ++bj)
#pragma unroll
            for (int n = 0; n < 2; ++n) bv[bj][n] = bias ? *(const f32x4*)(bias + bcol0 + bj * HALF + 4 * n) : (f32x4){0.f, 0.f, 0.f, 0.f};
#pragma unroll
        for (int ai = 0; ai < 2; ++ai)
#pragma unroll
            for (int m = 0; m < 4; ++m) { bf16_t* rowp = base + (size_t)(row0 + ai * HALF + m * 16) * ldc + col0;
#pragma unroll
                for (int bj = 0; bj < 2; ++bj) { f32x4 v0 = acc[ai][bj][m][0] + bv[bj][0], v1 = acc[ai][bj][m][1] + bv[bj][1];
                    if (ACT == 1) { f32x2 a = gelu_pk((f32x2){v0[0], v0[1]}), b = gelu_pk((f32x2){v0[2], v0[3]}), c = gelu_pk((f32x2){v1[0], v1[1]}), d = gelu_pk((f32x2){v1[2], v1[3]});
                        v0 = (f32x4){a.x, a.y, b.x, b.y}; v1 = (f32x4){c.x, c.y, d.x, d.y}; }
                    v0 = v0 * sc; v1 = v1 * sc; u32x4 w; w.x = cvt_pk_bf16(v0[0], v0[1]); w.y = cvt_pk_bf16(v0[2], v0[3]); w.z = cvt_pk_bf16(v1[0], v1[1]); w.w = cvt_pk_bf16(v1[2], v1[3]);
                    *(u32x4*)(rowp + bj * HALF) = w; } }
    }
};
struct EpiResid {
    static constexpr bool PERM = true, AFTER_DRAIN = false;
    const float* res; float* out; int ldc; float alpha;
    __device__ __forceinline__ void operator()(const f32x4 (&acc)[2][2][4][2], const Unit& u, int wr, int wc, int fr, int fq) const {
        const int row0 = u.pm * BM + wr * 64 + fr; const int col0 = u.pn * BM + wc * 32 + 8 * fq;
#pragma unroll
        for (int ai = 0; ai < 2; ++ai)
#pragma unroll
            for (int m = 0; m < 4; ++m) { const size_t ro = (size_t)(row0 + ai * HALF + m * 16) * ldc + col0;
#pragma unroll
                for (int bj = 0; bj < 2; ++bj) {
                    const f32x4 r0 = *(const f32x4*)(res + ro + bj * HALF), r1 = *(const f32x4*)(res + ro + bj * HALF + 4);
                    const f32x4 v0 = acc[ai][bj][m][0] + r0 * alpha, v1 = acc[ai][bj][m][1] + r1 * alpha;
                    *(f32x4*)(out + ro + bj * HALF) = v0; *(f32x4*)(out + ro + bj * HALF + 4) = v1; } }
    }
};
struct EpiInProj {
    static constexpr bool PERM = true, AFTER_DRAIN = false;
    bf16_t* O; const float* rope;
    __device__ __forceinline__ void operator()(const f32x4 (&acc)[2][2][4][2], const Unit& u, int wr, int wc, int fr, int fq) const {
        const int row0 = u.pm * BM + wr * 64 + fr;
#pragma unroll
        for (int bj = 0; bj < 2; ++bj) {
            const int colg = u.pn * BM + bj * HALF + wc * 32, col0 = colg + 8 * fq, head = colg >> 6;
            const bool isrot = (head >= 6 && head < 12) || (head >= 22 && head < 28);
            const float sc = (head < 6 || (head >= 12 && head < 16)) ? 0.125f * 1.4426950408889634f : (head >= 16 ? 0.125f : 1.f);
            const bool issc = (head < 6 || (head >= 12 && head < 16));
            const int i0 = ((colg & 63) + 8 * fq) >> 1;
#pragma unroll
            for (int ai = 0; ai < 2; ++ai)
#pragma unroll
                for (int m = 0; m < 4; ++m) {
                    const int row = row0 + ai * HALF + m * 16;
                    f32x4 v0 = acc[ai][bj][m][0], v1 = acc[ai][bj][m][1];
                    if (isrot) {
                        const int pos = row & 2047;
                        const f32x4 c = *(const f32x4*)(rope + pos * 32 + i0), s = *(const f32x4*)(rope + 2048 * 32 + pos * 32 + i0);
                        f32x4 w0, w1;
                        w0[0] = (v0[0] * c[0] - v0[1] * s[0]) * sc; w0[1] = (v0[0] * s[0] + v0[1] * c[0]) * sc;
                        w0[2] = (v0[2] * c[1] - v0[3] * s[1]) * sc; w0[3] = (v0[2] * s[1] + v0[3] * c[1]) * sc;
                        w1[0] = (v1[0] * c[2] - v1[1] * s[2]) * sc; w1[1] = (v1[0] * s[2] + v1[1] * c[2]) * sc;
                        w1[2] = (v1[2] * c[3] - v1[3] * s[3]) * sc; w1[3] = (v1[2] * s[3] + v1[3] * c[3]) * sc;
                        v0 = w0; v1 = w1;
                    }
                    if (issc) { v0 = v0 * sc; v1 = v1 * sc; }
                    u32x4 w; w.x = cvt_pk_bf16(v0[0], v0[1]); w.y = cvt_pk_bf16(v0[2], v0[3]); w.z = cvt_pk_bf16(v1[0], v1[1]); w.w = cvt_pk_bf16(v1[2], v1[3]);
                    *(u32x4*)(O + (size_t)row * 4096 + col0) = w;
                }
        }
    }
};
template <class Epi, class Sched, bool ALIGN_EPI = false, bool SP2 = false>
__device__ __forceinline__ void gemm_phase(PG8_LAS unsigned char* lds, const Gemm g, const Sched& S, const Epi& E) {
    int tid = threadIdx.x; asm volatile("" : "+v"(tid));
    const int wid = __builtin_amdgcn_readfirstlane(tid >> 6), lane = tid & 63, wr = wid >> 2, wc = wid & 3, fr = lane & 15, fq = lane >> 4;
    const int K = g.K, nt = K / BK;
    unsigned voffA[2], voffB[2];
#pragma unroll
    for (int i = 0; i < 2; ++i) { int R, C; stage_rc(tid * 16 + i * 8192, R, C); const int Rb = Epi::PERM ? ((R & ~31) + perm32(R & 31)) : R;
        voffA[i] = (unsigned)(R * K + C) * 2u; voffB[i] = (unsigned)(Rb * K + C) * 2u; }
    const size_t kstep = (size_t)(BK * 2);
    const size_t hstep = (size_t)HALF * K * 2;
    const size_t tstep = 2 * hstep;
    const unsigned ldsw = (unsigned)wid * 1024u;
    const int aoff = lds_byte(wr * 64 + fr, fq * 8), boff = lds_byte(wc * 32 + fr, fq * 8);
#define PG8_SA(b, h) (((b) * 2 + (h)) * HTB)
#define PG8_SB(b, h) ((4 + (b) * 2 + (h)) * HTB)
#define PG8_STAGE(bufoff, gbase, voff) do { _Pragma("unroll") for (int _i = 0; _i < 2; ++_i) \
        __builtin_amdgcn_global_load_lds((const unsigned*)((const char*)(gbase) + (voff)[_i]), (PG8_LAS unsigned*)(lds + (bufoff) + ldsw + _i * 8192), 16, 0, 0); } while (0)
#define PG8_LDA(dst, b, h) do { _Pragma("unroll") for (int m = 0; m < 4; ++m) _Pragma("unroll") for (int k = 0; k < 2; ++k) dst[m][k] = *(const PG8_LAS bf16x8*)(lds + PG8_SA(b, h) + aoff + m * 2048 + k * 1024); } while (0)
#define PG8_LDB(dst, b, h) do { _Pragma("unroll") for (int n = 0; n < 2; ++n) _Pragma("unroll") for (int k = 0; k < 2; ++k) dst[n][k] = *(const PG8_LAS bf16x8*)(lds + PG8_SB(b, h) + boff + n * 2048 + k * 1024); } while (0)
#define PG8_MMA(ai, bj, At, Bt) do { __builtin_amdgcn_s_setprio(1); _Pragma("unroll") for (int m = 0; m < 4; ++m) _Pragma("unroll") for (int n = 0; n < 2; ++n) _Pragma("unroll") for (int k = 0; k < 2; ++k) \
        acc[ai][bj][m][n] = __builtin_amdgcn_mfma_f32_16x16x32_bf16(Bt[n][k], At[m][k], acc[ai][bj][m][n], 0, 0, 0); __builtin_amdgcn_s_setprio(0); } while (0)
#define PG8_WAIT_V(n) asm volatile("s_waitcnt vmcnt(" #n ")" ::: "memory")
#define PG8_WAIT_L(n) asm volatile("s_waitcnt lgkmcnt(" #n ")" ::: "memory")
#define PG8_BAR __builtin_amdgcn_s_barrier()
#define PG8_SCHED __builtin_amdgcn_sched_barrier(0)
    Unit cur, nxt; int ui = 0;
    if (!S.next(0, cur)) return;
    f32x4 acc[2][2][4][2];
#pragma unroll
    for (int a = 0; a < 2; ++a)
#pragma unroll
        for (int b = 0; b < 2; ++b)
#pragma unroll
            for (int m = 0; m < 4; ++m)
#pragma unroll
                for (int n = 0; n < 2; ++n) acc[a][b][m][n] = (f32x4){0.f, 0.f, 0.f, 0.f};
    bf16x8 At[4][2], B0[2][2], B1[2][2];
    const char* cA = (const char*)g.A + (size_t)cur.pm * tstep; const char* cB = (const char*)g.Bt + (size_t)cur.pn * tstep;
    S.a_ready(cur);
    if constexpr (SP2) {
        PG8_STAGE(PG8_SB(0, 0), cB, voffB); PG8_STAGE(PG8_SB(0, 1), cB + hstep, voffB); PG8_STAGE(PG8_SA(0, 0), cA, voffA); PG8_STAGE(PG8_SA(0, 1), cA + hstep, voffA);
        if (wr == 1) PG8_BAR;
        PG8_WAIT_V(2); PG8_BAR;
        PG8_STAGE(PG8_SB(1, 0), cB + kstep, voffB); PG8_STAGE(PG8_SA(1, 0), cA + kstep, voffA); PG8_STAGE(PG8_SB(1, 1), cB + hstep + kstep, voffB);
        PG8_WAIT_V(6); PG8_BAR;
    } else {
        PG8_STAGE(PG8_SB(0, 0), cB, voffB); PG8_STAGE(PG8_SA(0, 0), cA, voffA); PG8_STAGE(PG8_SB(0, 1), cB + hstep, voffB); PG8_STAGE(PG8_SA(0, 1), cA + hstep, voffA);
        if (wr == 1) PG8_BAR;
        PG8_WAIT_V(4); PG8_BAR;
        PG8_STAGE(PG8_SB(1, 0), cB + kstep, voffB); PG8_STAGE(PG8_SA(1, 0), cA + kstep, voffA); PG8_STAGE(PG8_SB(1, 1), cB + hstep + kstep, voffB);
        PG8_WAIT_V(6); PG8_BAR;
    }
    for (;;) {
        const bool has_next = S.next(ui + 1, nxt);
        const char* nA = has_next ? (const char*)g.A + (size_t)nxt.pm * tstep : cA; const char* nB = has_next ? (const char*)g.Bt + (size_t)nxt.pn * tstep : cB;
        for (int t = 0; t < nt; t += 2) {
            const bool last = (t == nt - 2);
            const char* a1 = cA + (size_t)(t + 1) * kstep;
            const char* a2 = last ? nA : cA + (size_t)(t + 2) * kstep; const char* b2 = last ? nB : cB + (size_t)(t + 2) * kstep;
            const char* a3 = a2 + kstep; const char* b3 = b2 + kstep;
            if (last && has_next) S.a_ready(nxt);
            if constexpr (SP2) {
            PG8_LDB(B0, 0, 0); PG8_LDB(B1, 0, 1); PG8_SCHED; PG8_LDA(At, 0, 0); PG8_STAGE(PG8_SA(1, 1), a1 + hstep, voffA);
            PG8_WAIT_V(8); PG8_WAIT_L(0); PG8_BAR; PG8_MMA(0, 0, At, B0); PG8_MMA(0, 1, At, B1); PG8_BAR; PG8_SCHED;
            PG8_LDA(At, 0, 1); PG8_STAGE(PG8_SB(0, 0), b2, voffB); PG8_STAGE(PG8_SB(0, 1), b2 + hstep, voffB); PG8_STAGE(PG8_SA(0, 0), a2, voffA);
            PG8_WAIT_V(8); PG8_WAIT_L(0); PG8_BAR; PG8_MMA(1, 0, At, B0); PG8_MMA(1, 1, At, B1); PG8_BAR; PG8_SCHED;
            PG8_LDB(B0, 1, 0); PG8_LDB(B1, 1, 1); PG8_SCHED; PG8_LDA(At, 1, 0); PG8_STAGE(PG8_SA(0, 1), a2 + hstep, voffA);
            PG8_WAIT_V(8); PG8_WAIT_L(0); PG8_BAR; PG8_MMA(0, 0, At, B0); PG8_MMA(0, 1, At, B1); PG8_BAR; PG8_SCHED;
            PG8_LDA(At, 1, 1); PG8_STAGE(PG8_SB(1, 0), b3, voffB); PG8_STAGE(PG8_SB(1, 1), b3 + hstep, voffB); PG8_STAGE(PG8_SA(1, 0), a3, voffA);
            PG8_WAIT_V(8); PG8_WAIT_L(0); PG8_BAR; PG8_MMA(1, 0, At, B0); PG8_MMA(1, 1, At, B1); PG8_BAR; PG8_SCHED;
            } else {
            PG8_LDB(B0, 0, 0); PG8_SCHED; PG8_LDA(At, 0, 0); PG8_STAGE(PG8_SA(1, 1), a1 + hstep, voffA);
            PG8_WAIT_L(8); PG8_BAR; PG8_WAIT_L(0); PG8_MMA(0, 0, At, B0); PG8_BAR; PG8_SCHED;
            PG8_LDB(B1, 0, 1); PG8_STAGE(PG8_SB(0, 0), b2, voffB);
            PG8_BAR; PG8_WAIT_L(0); PG8_MMA(0, 1, At, B1); PG8_BAR;
            PG8_LDA(At, 0, 1); PG8_STAGE(PG8_SA(0, 0), a2, voffA);
            PG8_BAR; PG8_WAIT_L(0); PG8_MMA(1, 0, At, B0); PG8_BAR; PG8_SCHED;
            PG8_STAGE(PG8_SB(0, 1), b2 + hstep, voffB);
            PG8_WAIT_V(6); PG8_BAR; PG8_MMA(1, 1, At, B1); PG8_BAR;
            PG8_LDB(B0, 1, 0); PG8_SCHED; PG8_LDA(At, 1, 0); PG8_STAGE(PG8_SA(0, 1), a2 + hstep, voffA);
            PG8_WAIT_L(8); PG8_BAR; PG8_WAIT_L(0); PG8_MMA(0, 0, At, B0); PG8_BAR; PG8_SCHED;
            PG8_LDB(B1, 1, 1); PG8_STAGE(PG8_SB(1, 0), b3, voffB);
            PG8_BAR; PG8_WAIT_L(0); PG8_MMA(0, 1, At, B1); PG8_BAR;
            PG8_LDA(At, 1, 1); PG8_STAGE(PG8_SA(1, 0), a3, voffA);
            PG8_BAR; PG8_WAIT_L(0); PG8_MMA(1, 0, At, B0); PG8_BAR; PG8_SCHED;
            PG8_STAGE(PG8_SB(1, 1), b3 + hstep, voffB);
            PG8_WAIT_V(6); PG8_BAR; PG8_MMA(1, 1, At, B1); PG8_BAR;
            }
        }
        if constexpr (ALIGN_EPI) { if (wr == 0) PG8_BAR; }
        if constexpr (!Epi::AFTER_DRAIN) { E(acc, cur, wr, wc, fr, fq); S.done(cur); }
        if (!has_next) break;
#pragma unroll
        for (int a = 0; a < 2; ++a)
#pragma unroll
            for (int b = 0; b < 2; ++b)
#pragma unroll
                for (int m = 0; m < 4; ++m)
#pragma unroll
                    for (int n = 0; n < 2; ++n) acc[a][b][m][n] = (f32x4){0.f, 0.f, 0.f, 0.f};
        cur = nxt; cA = nA; cB = nB; ++ui;
        if constexpr (ALIGN_EPI) { if (wr == 1) PG8_BAR; }
    }
    PG8_WAIT_V(0);
    if constexpr (!ALIGN_EPI) { if (wr == 0) PG8_BAR; }
    PG8_BAR;
    if constexpr (Epi::AFTER_DRAIN) { E.fused(acc, cur, wr, wc, fr, fq, lds, wid, lane); S.done(cur); }
#undef PG8_SA
#undef PG8_SB
#undef PG8_STAGE
#undef PG8_LDA
#undef PG8_LDB
#undef PG8_MMA
#undef PG8_WAIT_V
#undef PG8_WAIT_L
#undef PG8_BAR
#undef PG8_SCHED
}
}

#ifndef MIX_MASK
#define MIX_MASK 7
#endif
#define NAIVE_MIX (MIX_MASK != 7)
constexpr int NB = 16, SEQ = 2048, DM = 1024, MTOK = NB * SEQ, NQ = 4096, DIN = 4102, NL = 2;
constexpr int HF = 6, HR = 6, HS = 4, HD = 64;
constexpr float LN_EPS = 1e-5f, GN_EPS = 1e-5f;
constexpr float DN_ALPHA = 1.4142135623730951f;
constexpr float LOG2E = 1.4426950408889634f;
typedef unsigned short bf16_t;
typedef float f32x4 __attribute__((ext_vector_type(4)));
typedef unsigned u32x4 __attribute__((ext_vector_type(4)));
typedef unsigned u32x2 __attribute__((ext_vector_type(2)));

constexpr size_t MiB = 1u << 20;
constexpr size_t WS_QKVG = 0;
constexpr size_t WS_Y    = 256 * MiB;
constexpr size_t WS_XB   = 320 * MiB;
constexpr size_t WS_WIN  = 384 * MiB;
constexpr size_t WS_WOUT = 400 * MiB;
constexpr size_t WS_FLOG = 404 * MiB;
constexpr size_t WS_C    = 405 * MiB;
constexpr size_t WS_ROPE = 406 * MiB;
constexpr size_t WS_CTR  = 407 * MiB;
constexpr size_t WS_END  = 408 * MiB;

constexpr int LDS_BYTES = 147456;

struct Params {
    const float *x, *w_in, *b_fgate, *gn_gain, *w_out, *ln_gain, *ln_bias;
    float* out; unsigned char* ws;
    int ph_lo, ph_hi;
};

__device__ __forceinline__ unsigned f2bf(float f) { unsigned u = __builtin_bit_cast(unsigned, f); return (u + 0x7fffu + ((u >> 16) & 1u)) >> 16; }
__device__ __forceinline__ unsigned pk2(float lo, float hi) { return f2bf(lo) | (f2bf(hi) << 16); }
__device__ __forceinline__ float bflo(unsigned u) { return __builtin_bit_cast(float, u << 16); }
__device__ __forceinline__ float bfhi(unsigned u) { return __builtin_bit_cast(float, u & 0xffff0000u); }
__device__ __forceinline__ float wave_sum(float v) {
#pragma unroll
    for (int o = 1; o < 64; o <<= 1) v += __shfl_xor(v, o);
    return v;
}
__device__ __forceinline__ float logsig_acc(float z) { return fminf(z, 0.f) - log1pf(expf(-fabsf(z))); }

__device__ __forceinline__ int rowmap_in(int n) {
    const bool r = (n >= 384 && n < 768) || (n >= 1408 && n < 1792); const int d = n & 63; return r ? (n & ~63) + ((d & 31) << 1) + (d >> 5) : n;
}
template <bool MAP> __device__ __forceinline__ void transpose_item(const float* W, int ldw, int K, bf16_t* WT, float* scr, int kb, int nb, int lane) {
    const int k0 = 64 * kb, n0 = 32 * nb;
#pragma unroll 8
    for (int i = 0; i < 32; ++i) { const int kk = 2 * i + (lane >> 5); scr[kk * 33 + (lane & 31)] = W[(size_t)(k0 + kk) * ldw + n0 + (lane & 31)]; }
    __builtin_amdgcn_wave_barrier(); asm volatile("s_waitcnt lgkmcnt(0)" ::: "memory");
    const int c = lane & 7;
#pragma unroll
    for (int j = 0; j < 4; ++j) { const int n = (lane >> 3) + 8 * j; const float* s = scr + (8 * c) * 33 + n;
        u32x4 o; o.x = pk2(s[0 * 33], s[1 * 33]); o.y = pk2(s[2 * 33], s[3 * 33]); o.z = pk2(s[4 * 33], s[5 * 33]); o.w = pk2(s[6 * 33], s[7 * 33]);
        const int nr = MAP ? rowmap_in(n0 + n) : (n0 + n); *(u32x4*)(WT + (size_t)nr * K + k0 + 8 * c) = o; }
    __builtin_amdgcn_wave_barrier(); asm volatile("s_waitcnt lgkmcnt(0)" ::: "memory");
}

__device__ __forceinline__ void stage_wf(const Params& P, int l, float* wfs) {
    for (int i = threadIdx.x; i < 6 * 1024; i += 512) { const int k = i / 6, h = i % 6; wfs[h * 1024 + k] = P.w_in[((size_t)l * DM + k) * DIN + NQ + h]; }
}
__device__ __forceinline__ void row_emit(const f32x4 (&v)[4], bf16_t* xbrow, const float* wfs, float* flogrow, int lane) {
#pragma unroll
    for (int j = 0; j < 4; ++j) { u32x2 o; o.x = pk2(v[j].x, v[j].y); o.y = pk2(v[j].z, v[j].w); ((u32x2*)xbrow)[lane + 64 * j] = o; }
    float a0 = 0.f, a1 = 0.f, a2 = 0.f, a3 = 0.f, a4 = 0.f, a5 = 0.f;
#pragma unroll
    for (int j = 0; j < 4; ++j) {
        const float* wp = wfs + 4 * lane + 256 * j;
        f32x4 w;
        w = *(const f32x4*)(wp);          a0 += v[j].x * w.x + v[j].y * w.y + v[j].z * w.z + v[j].w * w.w;
        w = *(const f32x4*)(wp + 1024);   a1 += v[j].x * w.x + v[j].y * w.y + v[j].z * w.z + v[j].w * w.w;
        w = *(const f32x4*)(wp + 2048);   a2 += v[j].x * w.x + v[j].y * w.y + v[j].z * w.z + v[j].w * w.w;
        w = *(const f32x4*)(wp + 3072);   a3 += v[j].x * w.x + v[j].y * w.y + v[j].z * w.z + v[j].w * w.w;
        w = *(const f32x4*)(wp + 4096);   a4 += v[j].x * w.x + v[j].y * w.y + v[j].z * w.z + v[j].w * w.w;
        w = *(const f32x4*)(wp + 5120);   a5 += v[j].x * w.x + v[j].y * w.y + v[j].z * w.z + v[j].w * w.w;
    }
    a0 = wave_sum(a0); a1 = wave_sum(a1); a2 = wave_sum(a2); a3 = wave_sum(a3); a4 = wave_sum(a4); a5 = wave_sum(a5);
    float r = a0; if (lane == 1) r = a1; if (lane == 2) r = a2; if (lane == 3) r = a3; if (lane == 4) r = a4; if (lane == 5) r = a5;
    if (lane < 6) flogrow[lane] = r;
}

__device__ __forceinline__ void phase0(const Params& P, unsigned char* lds) {
    int tid = threadIdx.x; asm volatile("" : "+v"(tid));
    const int lane = tid & 63, wave = tid >> 6;
    const int gw = blockIdx.x * 8 + wave, NGW = gridDim.x * 8;
    unsigned char* ws = P.ws;
    if (blockIdx.x == 0 && tid < 64) ((unsigned*)(ws + WS_CTR))[tid] = 0u;
    float* scr = (float*)lds + wave * (64 * 33);
    float* wfs = (float*)(lds + 8 * 64 * 33 * 4);
    stage_wf(P, 0, wfs);
    constexpr int I_IN = (DM / 64) * (NQ / 32), I_OUT = (DM / 64) * (DM / 32);
    for (int it = gw; it < NL * (I_IN + I_OUT); it += NGW) {
        int r = it; const int l = r / (I_IN + I_OUT); r -= l * (I_IN + I_OUT);
        if (r < I_IN) transpose_item<true>(P.w_in + (size_t)l * DM * DIN, DIN, DM, (bf16_t*)(ws + WS_WIN) + (size_t)l * NQ * DM, scr, r / (NQ / 32), r % (NQ / 32), lane);
        else { r -= I_IN; transpose_item<false>(P.w_out + (size_t)l * DM * DM, DM, DM, (bf16_t*)(ws + WS_WOUT) + (size_t)l * DM * DM, scr, r / (DM / 32), r % (DM / 32), lane); }
    }
    for (int i = blockIdx.x * 512 + tid; i < SEQ * 32; i += gridDim.x * 512) {
        const int pos = i >> 5, f = i & 31; const float invf = (float)(1.0 / exp2((double)f * (13.287712379549449 / 32.0))); const float ang = (float)pos * invf;
        const double t = (double)ang * 0.15915494309189535; const float fr = (float)(t - floor(t));
        ((float*)(ws + WS_ROPE))[i] = __builtin_amdgcn_cosf(fr); ((float*)(ws + WS_ROPE))[SEQ * 32 + i] = __builtin_amdgcn_sinf(fr);
    }
    __syncthreads();
    for (int m = gw; m < MTOK; m += NGW) {
        const f32x4* xr = (const f32x4*)(P.x + (size_t)m * DM) + lane; f32x4 v[4];
#pragma unroll
        for (int j = 0; j < 4; ++j) v[j] = xr[64 * j];
        row_emit(v, (bf16_t*)(ws + WS_XB) + (size_t)m * DM, wfs, (float*)(ws + WS_FLOG) + (size_t)m * 8, lane);
    }
    __syncthreads();
}

__device__ __forceinline__ void fgate_cumsum(const Params& P, int l) {
    int tid = threadIdx.x; asm volatile("" : "+v"(tid));
    const int lane = tid & 63, wave = tid >> 6;
    const int gw = blockIdx.x * 8 + wave;
    if (gw >= NB * HF) return;
    const int b = gw / HF, h = gw % HF; const float bias = P.b_fgate[l * HF + h];
    const float* fl = (const float*)(P.ws + WS_FLOG) + ((size_t)b * SEQ + lane * 32) * 8 + h;
    float vals[32]; float run = 0.f;
#pragma unroll
    for (int i = 0; i < 32; ++i) { run += logsig_acc(fl[i * 8] + bias); vals[i] = run; }
    float incl = run;
#pragma unroll
    for (int o = 1; o < 64; o <<= 1) { const float t = __shfl_up(incl, o); if (lane >= o) incl += t; }
    const float excl = incl - run;
    float* c = (float*)(P.ws + WS_C) + ((size_t)(b * HF + h)) * SEQ + lane * 32;
#pragma unroll
    for (int i = 0; i < 32; ++i) c[i] = vals[i] + excl;
}

__device__ __forceinline__ void load_row64(const bf16_t* p, float (&f)[64]) {
    const u32x4* q = (const u32x4*)p;
#pragma unroll
    for (int i = 0; i < 8; ++i) { const u32x4 u = q[i];
        f[8 * i + 0] = bflo(u.x); f[8 * i + 1] = bfhi(u.x); f[8 * i + 2] = bflo(u.y); f[8 * i + 3] = bfhi(u.y);
        f[8 * i + 4] = bflo(u.z); f[8 * i + 5] = bfhi(u.z); f[8 * i + 6] = bflo(u.w); f[8 * i + 7] = bfhi(u.w); }
}
__device__ __forceinline__ void unpack8(const u32x4 u, float (&f)[8]) {
    f[0] = bflo(u.x); f[1] = bfhi(u.x); f[2] = bflo(u.y); f[3] = bfhi(u.y); f[4] = bflo(u.z); f[5] = bfhi(u.z); f[6] = bflo(u.w); f[7] = bfhi(u.w);
}
__device__ __forceinline__ float dot64(const float (&q)[64], const bf16_t* krow) {
    float dot = 0.f;
#pragma unroll
    for (int i = 0; i < 8; ++i) { float k[8]; unpack8(((const u32x4*)krow)[i], k);
#pragma unroll
        for (int e = 0; e < 8; ++e) dot += q[8 * i + e] * k[e]; }
    return dot;
}
__device__ __forceinline__ void axpy64(float (&o)[32], float f, float p, const bf16_t* vrow) {
#pragma unroll
    for (int i = 0; i < 4; ++i) { float v[8]; unpack8(((const u32x4*)vrow)[i], v);
#pragma unroll
        for (int e = 0; e < 8; ++e) o[8 * i + e] = o[8 * i + e] * f + p * v[e]; }
}
__device__ __forceinline__ void naive_mixers(const Params& P, int l) {
    const bf16_t* qkvg = (const bf16_t*)(P.ws + WS_QKVG);
    const float* cc = (const float*)(P.ws + WS_C);
    bf16_t* Y = (bf16_t*)(P.ws + WS_Y);
    for (int it = blockIdx.x * 512 + threadIdx.x; it < NB * 16 * SEQ * 2; it += gridDim.x * 512) {
        const int dh = it & 1, t = (it >> 1) % SEQ, hh = (it / (SEQ * 2)) % 16, b = it / (SEQ * 32);
        { const int ty = hh < HF ? 1 : (hh < HF + HR ? 2 : 4); if (MIX_MASK & ty) continue; }
        const bf16_t* base = qkvg + (size_t)b * SEQ * NQ + hh * 64;
        float q[64], o[32];
        load_row64(base + (size_t)t * NQ, q);
#pragma unroll
        for (int d = 0; d < 32; ++d) o[d] = 0.f;
        if (hh < HF) {
            const float* c = cc + (size_t)(b * HF + hh) * SEQ; const float ct = c[t];
            float m = -INFINITY, lsum = 0.f;
            for (int s = 0; s <= t; ++s) {
                const float sc = dot64(q, base + (size_t)s * NQ + 1024) * 0.125f + ct - c[s];
                const float mn = fmaxf(m, sc), f = expf(m - mn), p = expf(sc - mn);
                lsum = lsum * f + p; m = mn;
                axpy64(o, f, p, base + (size_t)s * NQ + 2048 + dh * 32);
            }
            const float inv = 1.f / lsum;
#pragma unroll
            for (int d = 0; d < 32; ++d) o[d] *= inv;
        } else if (hh < HF + HR) {
            const int hr = hh - HF; const float lg = logf(1.f - exp2f(-5.f - (float)hr));
            for (int s = 0; s <= t; ++s) {
                const float w = dot64(q, base + (size_t)s * NQ + 1024) * expf((float)(t - s) * lg);
                axpy64(o, 1.f, w, base + (size_t)s * NQ + 2048 + dh * 32);
            }
            float mu = 0.f;
#pragma unroll
            for (int d = 0; d < 32; ++d) mu += o[d];
            float var = 0.f;
            mu = (mu + __shfl_xor(mu, 1)) * (1.f / 64.f);
#pragma unroll
            for (int d = 0; d < 32; ++d) { o[d] -= mu; var += o[d] * o[d]; }
            var += __shfl_xor(var, 1);
            const float rs = rsqrtf(var * (1.f / 64.f) + GN_EPS); const float* gg = P.gn_gain + l * (HR * 64) + hr * 64 + dh * 32;
#pragma unroll
            for (int d = 0; d < 32; ++d) o[d] = o[d] * rs * gg[d];
        } else {
            float R = 0.f;
            for (int s = t - 1; s >= 0; --s) {
                const float z = dot64(q, base + (size_t)s * NQ + 1024) * 0.125f, ls = logsig_acc(z), a = expf(ls + R); R += ls - z;
                axpy64(o, 1.f, a, base + (size_t)s * NQ + 2048 + dh * 32);
            }
        }
        const bf16_t* gr = base + (size_t)t * NQ + 3072 + dh * 32;
        bf16_t* yr = Y + ((size_t)b * SEQ + t) * DM + hh * 64 + dh * 32;
#pragma unroll
        for (int i = 0; i < 4; ++i) { float g[8], gt[8]; unpack8(((const u32x4*)gr)[i], gt);
#pragma unroll
            for (int e = 0; e < 8; ++e) g[e] = o[8 * i + e] * gt[e] / (1.f + expf(-gt[e]));
            u32x4 w; w.x = pk2(g[0], g[1]); w.y = pk2(g[2], g[3]); w.z = pk2(g[4], g[5]); w.w = pk2(g[6], g[7]); ((u32x4*)yr)[i] = w; }
    }
}

typedef short bf16x8 __attribute__((ext_vector_type(8)));
typedef short s16x4 __attribute__((ext_vector_type(4)));
typedef float f32x16 __attribute__((ext_vector_type(16)));
typedef float f32x2_t __attribute__((ext_vector_type(2)));
typedef __bf16 bf16x2_t __attribute__((ext_vector_type(2)));
__device__ __forceinline__ unsigned cvtpk(float lo, float hi) { f32x2_t v = {lo, hi}; bf16x2_t b = __builtin_convertvector(v, bf16x2_t); return __builtin_bit_cast(unsigned, b); }
#define PACK8(P, B) __builtin_bit_cast(bf16x8, (u32x4){cvtpk(P[B], P[B + 1]), cvtpk(P[B + 2], P[B + 3]), cvtpk(P[B + 4], P[B + 5]), cvtpk(P[B + 6], P[B + 7])})
#define MFMA32(a, b, c) __builtin_amdgcn_mfma_f32_32x32x16_bf16((a), (b), (c), 0, 0, 0)
typedef short v4i16_t __attribute__((ext_vector_type(4)));
__device__ __forceinline__ s16x4 vtr(const bf16_t* p) { return __builtin_bit_cast(s16x4, __builtin_amdgcn_ds_read_tr16_b64_v4i16((__attribute__((address_space(3))) v4i16_t*)p)); }
__device__ __forceinline__ int crow(int r, int hi) { return (r & 3) + 8 * (r >> 2) + 4 * hi; }
constexpr int KP = 72, VP = 68, SP = 68;
constexpr int L_K = 0, L_V = L_K + 2 * 64 * KP * 2, L_C2 = L_V + 2 * 64 * KP * 2, L_WSF = L_C2 + SEQ * 4, L_STG = L_WSF + 8 * 64 * 4, L_FLG = L_STG + 8 * 32 * SP * 4, L_QW = L_FLG + 64, L_KT = L_QW + 16, L_ST = L_KT + 2 * 64 * KP * 2, L_MIX_END = L_ST + 64 * KP * 2;
static_assert(L_MIX_END <= LDS_BYTES, "mixer LDS map");
constexpr float C2S = 0.125f * 1.4426950408889634f;
constexpr float FOX_THR = 6.f;
constexpr float SB_CUT = -160.f;

template <int MODE> __device__ __forceinline__ void attn_unit(const Params& P, int l, int b, int hh, int qb_arg, unsigned char* lds) {
    int tid = threadIdx.x; asm volatile("" : "+v"(tid));
    const int lane = tid & 63, wave = __builtin_amdgcn_readfirstlane(tid >> 6), r32 = lane & 31, hi = lane >> 5;
    const bf16_t* base = (const bf16_t*)(P.ws + WS_QKVG) + (size_t)b * SEQ * NQ + hh * 64;
    bf16_t* Ks = (bf16_t*)(lds + L_K); bf16_t* Vt = (bf16_t*)(lds + L_V); float* c2s = (float*)(lds + L_C2);
    bf16_t* Ktt = (bf16_t*)(lds + L_KT); bf16_t* St = (bf16_t*)(lds + L_ST);
    float* wsf = (float*)(lds + L_WSF) + wave * 64; float* stg = (float*)(lds + L_STG) + wave * (32 * SP);
    const float lg2 = (MODE == 2) ? log2f(1.f - exp2f(-5.f - (float)(hh - HF))) : 0.f;
    f32x16 sacc;
#pragma unroll
    for (int r = 0; r < 16; ++r) sacc[r] = 0.f;
  for (int qb = (MODE == 2 ? 0 : qb_arg); qb <= (MODE == 2 ? 7 : qb_arg); ++qb) {
    const int q0 = qb * 256, qw0 = q0 + wave * 32, t = qw0 + r32;
    const int NT = (MODE == 2) ? 4 : 4 * (qb + 1);
    __syncthreads();
    float ct2 = 0.f;
    if (MODE == 0) {
        const float* cg_ = (const float*)(P.ws + WS_C) + (size_t)(b * HF + hh) * SEQ;
        for (int i = tid; i < q0 + 256; i += 512) c2s[i] = cg_[i] * LOG2E;
        ct2 = cg_[t] * LOG2E;
    }
    bf16x8 qf[4];
#pragma unroll
    for (int d0 = 0; d0 < 4; ++d0) qf[d0] = *(const bf16x8*)(base + (size_t)t * NQ + d0 * 16 + hi * 8);
    const int lk_key = tid >> 3, lk_ch = tid & 7, lv_key = tid & 63, lv_ch = tid >> 6;
    const bf16_t* kg = base + 1024 + (size_t)lk_key * NQ + lk_ch * 8;
    const bf16_t* vg = base + 2048 + (size_t)lk_key * NQ + lk_ch * 8;
    const int kt0 = (MODE != 2) ? NT - 1 : 4 * qb, kstep = (MODE != 2) ? -1 : 1;
    u32x4 kreg[2], vreg[2];
#pragma unroll
    for (int u = 0; u < 2; ++u) { kreg[u] = *(const u32x4*)(kg + (size_t)(kt0 + u * kstep) * 64 * NQ); vreg[u] = *(const u32x4*)(vg + (size_t)(kt0 + u * kstep) * 64 * NQ); }
    const int i16 = lane & 15, tq = i16 >> 2, tp = i16 & 3, tb = (lane >> 4) & 1;
    f32x16 o0, o1;
#pragma unroll
    for (int r = 0; r < 16; ++r) { o0[r] = 0.f; o1[r] = 0.f; }
    if (MODE == 2) {
        if (qb > 0) {
#pragma unroll
            for (int d0 = 0; d0 < 4; ++d0) {
                const bf16x8 s0 = *(const bf16x8*)(St + r32 * KP + d0 * 16 + hi * 8), s1 = *(const bf16x8*)(St + (32 + r32) * KP + d0 * 16 + hi * 8);
                o0 = MFMA32(qf[d0], s0, o0); o1 = MFMA32(qf[d0], s1, o1);
            }
            if (hi == 0) wsf[r32] = __builtin_amdgcn_exp2f((float)(t - q0) * lg2);
            __builtin_amdgcn_wave_barrier();
#pragma unroll
            for (int g = 0; g < 4; ++g) { const f32x4 a = *(const f32x4*)(wsf + 8 * g + 4 * hi);
#pragma unroll
                for (int j = 0; j < 4; ++j) { o0[4 * g + j] *= a[j]; o1[4 * g + j] *= a[j]; } }
            __builtin_amdgcn_wave_barrier();
            if (wave < 4) { const float gC = __builtin_amdgcn_exp2f(256.f * lg2);
#pragma unroll
                for (int r = 0; r < 16; ++r) sacc[r] *= gC; }
        }
    }
    float m_run = 0.f, lsum = 0.f, R = 0.f; bool first = true;
    bool wdone = false;
    volatile int* flg = (volatile int*)(lds + L_FLG);
    bool stop = false;
    for (int it0 = 0; it0 < NT && !stop; it0 += 2) {
#pragma unroll
      for (int u = 0; u < 2; ++u) {
        const int it = it0 + u;
        const int kt = kt0 + kstep * it;
        if (MODE == 1) { if (lane == 0) flg[(it & 1) * 8 + wave] = wdone ? 1 : 0; }
        bf16_t* Kb = Ks + (it & 1) * (64 * KP); bf16_t* Vb = Vt + (it & 1) * (64 * KP); bf16_t* Vd = Ktt + (it & 1) * (64 * KP);
        *(u32x4*)(Kb + lk_key * KP + lk_ch * 8) = kreg[u];
        *(u32x4*)(Vb + lk_key * KP + lk_ch * 8) = vreg[u];
        if (MODE == 2) {
            const float f = __builtin_amdgcn_exp2f((float)(q0 + 256 - (64 * kt + lk_key)) * lg2); const u32x4 vr = vreg[u]; u32x4 w;
            w.x = cvtpk(bflo(vr.x) * f, bfhi(vr.x) * f); w.y = cvtpk(bflo(vr.y) * f, bfhi(vr.y) * f); w.z = cvtpk(bflo(vr.z) * f, bfhi(vr.z) * f); w.w = cvtpk(bflo(vr.w) * f, bfhi(vr.w) * f);
            *(u32x4*)(Vd + lk_key * KP + lk_ch * 8) = w;
        }
        __syncthreads();
        if (MODE == 1) { int alld = 1;
#pragma unroll
            for (int w = 0; w < 8; ++w) alld &= flg[(it & 1) * 8 + w];
            if (alld) { stop = true; break; } }
        if (it + 2 < NT) { kreg[u] = *(const u32x4*)(kg + (size_t)(kt + 2 * kstep) * 64 * NQ); vreg[u] = *(const u32x4*)(vg + (size_t)(kt + 2 * kstep) * 64 * NQ); }
        if (64 * kt <= qw0 + 31 && !(MODE == 1 && wdone)) {
            f32x16 p0, p1;
            const int key0 = 64 * kt + 4 * hi;
            if (MODE == 0) {
                const float* cs = c2s + key0; const float bm = ct2 - m_run;
#pragma unroll
                for (int g = 0; g < 4; ++g) { const f32x4 ca = *(const f32x4*)(cs + 8 * g), cb = *(const f32x4*)(cs + 32 + 8 * g);
#pragma unroll
                    for (int j = 0; j < 4; ++j) { p0[4 * g + j] = bm - ca[j]; p1[4 * g + j] = bm - cb[j]; } }
            } else {
#pragma unroll
                for (int r = 0; r < 16; ++r) { p0[r] = 0.f; p1[r] = 0.f; }
            }
#pragma unroll
            for (int d0 = 0; d0 < 4; ++d0) {
                const bf16x8 ka = *(const bf16x8*)(Kb + r32 * KP + d0 * 16 + hi * 8), kb2 = *(const bf16x8*)(Kb + (32 + r32) * KP + d0 * 16 + hi * 8);
                p0 = MFMA32(ka, qf[d0], p0); p1 = MFMA32(kb2, qf[d0], p1);
            }
            if (MODE == 0) {
                if (64 * kt + 63 > qw0) {
#pragma unroll
                    for (int r = 0; r < 16; ++r) { const int key = key0 + (r & 3) + 8 * (r >> 2); if (key > t) p0[r] = -INFINITY; if (key + 32 > t) p1[r] = -INFINITY; }
                }
                float mx = fmaxf(p0[0], p1[0]);
#pragma unroll
                for (int r = 1; r < 16; ++r) mx = fmaxf(mx, fmaxf(p0[r], p1[r]));
                mx = fmaxf(mx, __shfl_xor(mx, 32));
                if (first || __any(mx > FOX_THR)) {
                    const float delta = first ? mx : fmaxf(mx, 0.f);
                    m_run += delta;
#pragma unroll
                    for (int r = 0; r < 16; ++r) { p0[r] -= delta; p1[r] -= delta; }
                    if (!first) {
                        const float alpha = __builtin_amdgcn_exp2f(-delta);
                        lsum *= alpha;
                        if (hi == 0) wsf[r32] = alpha;
                        __builtin_amdgcn_wave_barrier();
#pragma unroll
                        for (int g = 0; g < 4; ++g) { const f32x4 a = *(const f32x4*)(wsf + 8 * g + 4 * hi);
#pragma unroll
                            for (int j = 0; j < 4; ++j) { o0[4 * g + j] *= a[j]; o1[4 * g + j] *= a[j]; } }
                        __builtin_amdgcn_wave_barrier();
                    }
                    first = false;
                }
                float ps = 0.f;
#pragma unroll
                for (int r = 0; r < 16; ++r) { p0[r] = __builtin_amdgcn_exp2f(p0[r]); p1[r] = __builtin_amdgcn_exp2f(p1[r]); ps += p0[r] + p1[r]; }
                lsum += ps;
            } else if (MODE == 1) {
                const bool diag = (64 * kt + 63 >= qw0);
                if (diag) {
#pragma unroll
                    for (int r = 0; r < 16; ++r) { const int key = key0 + (r & 3) + 8 * (r >> 2); if (key >= t) p0[r] = -1e30f; if (key + 32 >= t) p1[r] = -1e30f; }
                }
                float lr[32];
#pragma unroll
                for (int r = 0; r < 16; ++r) {
                    const float za = p0[r], zb = p1[r];
                    const float spa = __builtin_amdgcn_logf(1.f + __builtin_amdgcn_exp2f(-fabsf(za))), spb = __builtin_amdgcn_logf(1.f + __builtin_amdgcn_exp2f(-fabsf(zb)));
                    lr[r] = (fminf(za, 0.f) - spa) - za; lr[16 + r] = (fminf(zb, 0.f) - spb) - zb;
                }
                float SI[9]; SI[8] = 0.f;
#pragma unroll
                for (int i = 7; i >= 0; --i) SI[i] = SI[i + 1] + ((lr[4 * i] + lr[4 * i + 1]) + (lr[4 * i + 2] + lr[4 * i + 3]));
                float E[8];
#pragma unroll
                for (int i = 0; i < 8; ++i) { const float snd = hi ? SI[i] : SI[i + 1]; E[i] = SI[i + 1] + __shfl_xor(snd, 32); }
                const float T = SI[0] + __shfl_xor(SI[0], 32);
#pragma unroll
                for (int i = 0; i < 8; ++i) {
                    const float bs = R + E[i];
                    const float w2 = lr[4 * i + 3], w1 = w2 + lr[4 * i + 2], w0 = w1 + lr[4 * i + 1];
                    if (i < 4) { p0[4 * i + 3] = __builtin_amdgcn_exp2f(p0[4 * i + 3] + lr[4 * i + 3] + bs); p0[4 * i + 2] = __builtin_amdgcn_exp2f(p0[4 * i + 2] + lr[4 * i + 2] + bs + w2);
                                 p0[4 * i + 1] = __builtin_amdgcn_exp2f(p0[4 * i + 1] + lr[4 * i + 1] + bs + w1); p0[4 * i + 0] = __builtin_amdgcn_exp2f(p0[4 * i + 0] + lr[4 * i + 0] + bs + w0); }
                    else { const int q = 4 * (i - 4);
                                 p1[q + 3] = __builtin_amdgcn_exp2f(p1[q + 3] + lr[4 * i + 3] + bs); p1[q + 2] = __builtin_amdgcn_exp2f(p1[q + 2] + lr[4 * i + 2] + bs + w2);
                                 p1[q + 1] = __builtin_amdgcn_exp2f(p1[q + 1] + lr[4 * i + 1] + bs + w1); p1[q + 0] = __builtin_amdgcn_exp2f(p1[q + 0] + lr[4 * i + 0] + bs + w0); }
                }
                R += T;
                wdone = __all(R < SB_CUT);
            } else {
                const bool diag = (64 * kt + 63 > qw0);
#pragma unroll
                for (int r = 0; r < 16; ++r) { const int key = key0 + (r & 3) + 8 * (r >> 2);
                    p0[r] *= __builtin_amdgcn_exp2f((float)(t - key) * lg2); p1[r] *= __builtin_amdgcn_exp2f((float)(t - key - 32) * lg2);
                    if (diag) { if (key > t) p0[r] = 0.f; if (key + 32 > t) p1[r] = 0.f; } }
            }
            { const bf16_t* vbase = Vb + (4 * hi + tq) * KP + 16 * tb + 4 * tp;
#pragma unroll
              for (int blk = 0; blk < 2; ++blk)
#pragma unroll
                for (int s = 0; s < 2; ++s) {
                    const bf16x8 pf = blk ? PACK8(p1, 8 * s) : PACK8(p0, 8 * s);
                    const bf16_t* vp = vbase + (blk * 32 + 16 * s) * KP;
                    const s16x4 a0 = vtr(vp), a1 = vtr(vp + 8 * KP), b0 = vtr(vp + 32), b1 = vtr(vp + 8 * KP + 32);
                    o0 = MFMA32(pf, __builtin_shufflevector(a0, a1, 0, 1, 2, 3, 4, 5, 6, 7), o0);
                    o1 = MFMA32(pf, __builtin_shufflevector(b0, b1, 0, 1, 2, 3, 4, 5, 6, 7), o1);
                } }
        }
        if (MODE == 2 && wave < 4) {
            const bf16_t* ka_base = Kb + (8 * hi + tq) * KP + 32 * (wave & 1) + 16 * tb + 4 * tp;
            const bf16_t* vb_base = Vd + (8 * hi + tq) * KP + 32 * (wave >> 1) + 16 * tb + 4 * tp;
#pragma unroll
            for (int ks = 0; ks < 4; ++ks) {
                const s16x4 a0 = vtr(ka_base + (16 * ks) * KP), a1 = vtr(ka_base + (16 * ks + 4) * KP), v0 = vtr(vb_base + (16 * ks) * KP), v1 = vtr(vb_base + (16 * ks + 4) * KP);
                sacc = MFMA32(__builtin_shufflevector(a0, a1, 0, 1, 2, 3, 4, 5, 6, 7), __builtin_shufflevector(v0, v1, 0, 1, 2, 3, 4, 5, 6, 7), sacc);
            }
        }
      }
    }
    u32x2 gts[8];
#pragma unroll
    for (int i = 0; i < 8; ++i) gts[i] = *(const u32x2*)(base + (size_t)(qw0 + i * 4 + (lane >> 4)) * NQ + 3072 + (lane & 15) * 4);
    if (MODE == 0) {
        lsum += __shfl_xor(lsum, 32);
        if (hi == 0) wsf[r32] = 1.f / lsum;
        __builtin_amdgcn_wave_barrier();
    }
#pragma unroll
    for (int g = 0; g < 4; ++g) {
        f32x4 a = {1.f, 1.f, 1.f, 1.f};
        if (MODE == 0) a = *(const f32x4*)(wsf + 8 * g + 4 * hi);
#pragma unroll
        for (int j = 0; j < 4; ++j) { const int row = 8 * g + 4 * hi + j; stg[row * SP + r32] = o0[4 * g + j] * a[j]; stg[row * SP + 32 + r32] = o1[4 * g + j] * a[j]; }
    }
    __builtin_amdgcn_wave_barrier();
    bf16_t* Y = (bf16_t*)(P.ws + WS_Y) + ((size_t)b * SEQ + qw0) * DM + hh * 64;
    const float* gg = P.gn_gain + l * (HR * 64) + (MODE == 2 ? (hh - HF) * 64 : 0);
#pragma unroll
    for (int i = 0; i < 8; ++i) {
        const int row = i * 4 + (lane >> 4), ch = lane & 15;
        f32x4 ov = *(const f32x4*)(stg + row * SP + ch * 4);
        if (MODE == 2) {
            float s = (ov[0] + ov[1]) + (ov[2] + ov[3]);
            s += __shfl_xor(s, 1); s += __shfl_xor(s, 2); s += __shfl_xor(s, 4); s += __shfl_xor(s, 8);
            const float mu = s * (1.f / 64.f); ov = ov - mu;
            float v2 = (ov[0] * ov[0] + ov[1] * ov[1]) + (ov[2] * ov[2] + ov[3] * ov[3]);
            v2 += __shfl_xor(v2, 1); v2 += __shfl_xor(v2, 2); v2 += __shfl_xor(v2, 4); v2 += __shfl_xor(v2, 8);
            const float rs = rsqrtf(v2 * (1.f / 64.f) + GN_EPS); const f32x4 gv = *(const f32x4*)(gg + ch * 4);
            ov = ov * rs * gv;
        }
        const u32x2 gt = gts[i];
        const float g0 = bflo(gt.x), g1 = bfhi(gt.x), g2 = bflo(gt.y), g3 = bfhi(gt.y);
        u32x2 w; w.x = cvtpk(ov[0] * g0 / (1.f + __expf(-g0)), ov[1] * g1 / (1.f + __expf(-g1))); w.y = cvtpk(ov[2] * g2 / (1.f + __expf(-g2)), ov[3] * g3 / (1.f + __expf(-g3)));
        *(u32x2*)(Y + (size_t)row * DM + ch * 4) = w;
    }
    if (MODE == 2 && wave < 4 && qb < 7) {
        bf16_t* sp = St + (32 * (wave >> 1) + r32) * KP + 32 * (wave & 1) + 4 * hi;
#pragma unroll
        for (int g = 0; g < 4; ++g) { u32x2 w; w.x = cvtpk(sacc[4 * g], sacc[4 * g + 1]); w.y = cvtpk(sacc[4 * g + 2], sacc[4 * g + 3]); *(u32x2*)(sp + 8 * g) = w; }
    }
  }
}

__device__ __forceinline__ void mixer_phase(const Params& P, int l, unsigned char* lds, int slot, int tmask = 7) {
    unsigned* ctr = (unsigned*)(P.ws + WS_CTR) + 16 * slot;
    volatile int* qw = (volatile int*)(lds + L_QW);
    for (;;) {
        __syncthreads();
        if (threadIdx.x == 0) qw[0] = (int)atomicAdd(ctr, 1u);
        __syncthreads();
        const int u = qw[0];
        if (u >= 96 + 8 * 160) break;
        if (u < 96) { if (tmask & 2) attn_unit<2>(P, l, u / 6, HF + u % 6, 0, lds); }
        else { const int v = u - 96, qb = 7 - v / 160, idx = v % 160;
            if (idx < 96) { if (tmask & 1) attn_unit<0>(P, l, idx / 6, idx % 6, qb, lds); }
            else { if (tmask & 4) attn_unit<1>(P, l, (idx - 96) / 4, HF + HR + (idx - 96) % 4, qb, lds); } }
    }
    __syncthreads();
}

__device__ __forceinline__ void phase4(const Params& P, int l, unsigned char* lds) {
    int tid = threadIdx.x; asm volatile("" : "+v"(tid));
    const int lane = tid & 63, wave = tid >> 6;
    const int gw = blockIdx.x * 8 + wave, NGW = gridDim.x * 8;
    float* wfs = (float*)lds;
    if (l + 1 < NL) { stage_wf(P, l + 1, wfs); }
    __syncthreads();
    const float* gp = P.ln_gain + l * DM; const float* bp = P.ln_bias + l * DM;
    f32x4 g[4], bb[4];
#pragma unroll
    for (int j = 0; j < 4; ++j) { g[j] = ((const f32x4*)gp)[lane + 64 * j]; bb[j] = ((const f32x4*)bp)[lane + 64 * j]; }
    for (int m = gw; m < MTOK; m += NGW) {
        f32x4* xr = (f32x4*)(P.out + (size_t)m * DM) + lane; f32x4 v[4]; float s = 0.f;
#pragma unroll
        for (int j = 0; j < 4; ++j) { v[j] = xr[64 * j]; s += (v[j].x + v[j].y) + (v[j].z + v[j].w); }
        const float mean = wave_sum(s) * (1.f / DM); float s2 = 0.f;
#pragma unroll
        for (int j = 0; j < 4; ++j) { v[j] = v[j] - mean; s2 += (v[j].x * v[j].x + v[j].y * v[j].y) + (v[j].z * v[j].z + v[j].w * v[j].w); }
        const float rstd = rsqrtf(wave_sum(s2) * (1.f / DM) + LN_EPS);
#pragma unroll
        for (int j = 0; j < 4; ++j) { v[j] = v[j] * rstd * g[j] + bb[j]; xr[64 * j] = v[j]; }
        if (l + 1 < NL) row_emit(v, (bf16_t*)(P.ws + WS_XB) + (size_t)m * DM, wfs, (float*)(P.ws + WS_FLOG) + (size_t)m * 8, lane);
    }
    __syncthreads();
}

#if NAIVE_MIX
__global__ void __launch_bounds__(512) naive_mix_kernel(Params P, int l) { naive_mixers(P, l); }
#endif
__global__ void __launch_bounds__(512) hybrid_fwd(Params P) {
    extern __shared__ __attribute__((aligned(16))) unsigned char lds[];
    cg::grid_group grid = cg::this_grid();
    unsigned char* ws = P.ws;
    const int lo = P.ph_lo, hi = P.ph_hi;
#define RUN(k) (lo <= (k) && (k) < hi)
#define SEAM(k) do { if (RUN(k) && RUN((k) + 1)) grid.sync(); } while (0)
    if (RUN(0)) phase0(P, lds);
    SEAM(0);
#pragma unroll
    for (int l = 0; l < NL; ++l) {
        if (RUN(1 + 4 * l)) {
          fgate_cumsum(P, l);
          pg8::Gemm g{(const bf16_t*)(ws + WS_XB), (const bf16_t*)(ws + WS_WIN) + (size_t)l * NQ * DM, MTOK, NQ, DM};
          pg8::StaticOrder S; S.init(MTOK, NQ, (int)gridDim.x, (int)blockIdx.x);
          pg8::EpiInProj E{(bf16_t*)(ws + WS_QKVG), (const float*)(ws + WS_ROPE)};
          pg8::gemm_phase<pg8::EpiInProj, pg8::StaticOrder, true, true>((PG8_LAS unsigned char*)lds, g, S, E);
#ifdef PROBE_GEMM2
          grid.sync(); pg8::gemm_phase<pg8::EpiInProj, pg8::StaticOrder, true, true>((PG8_LAS unsigned char*)lds, g, S, E);
#endif
        }
        SEAM(1 + 4 * l);
        if (RUN(2 + 4 * l)) { mixer_phase(P, l, lds, l);
#ifdef PROBE_MIX2
            grid.sync(); mixer_phase(P, l, lds, 2 + l, PROBE_MIX2);
#endif
        }
        SEAM(2 + 4 * l);
        if (RUN(3 + 4 * l)) {
          pg8::Gemm g{(const bf16_t*)(ws + WS_Y), (const bf16_t*)(ws + WS_WOUT) + (size_t)l * DM * DM, MTOK, DM, DM};
          pg8::StaticOrder S; S.init(MTOK, DM, (int)gridDim.x, (int)blockIdx.x);
          pg8::EpiResid E{l == 0 ? P.x : P.out, P.out, DM, DN_ALPHA};
          pg8::gemm_phase<pg8::EpiResid, pg8::StaticOrder, true, true>((PG8_LAS unsigned char*)lds, g, S, E); }
        SEAM(3 + 4 * l);
        if (RUN(4 + 4 * l)) phase4(P, l, lds);
        SEAM(4 + 4 * l);
    }
#undef RUN
#undef SEAM
}

extern "C" void kernel_launch(void* const* d_in, const int* in_sizes, int n_in, void* d_out, int out_size, void* d_ws, size_t ws_size, hipStream_t stream) {
    static int grid_blocks = 0;
    if (grid_blocks == 0) {
        if (n_in != 7 || out_size != MTOK * DM || ws_size < WS_END) { fprintf(stderr, "kernel_launch: unexpected shapes (n_in %d out %d ws %zu)\n", n_in, out_size, ws_size); grid_blocks = -1; return; }
        int dev = 0, cus = 0, per_cu = 0;
        (void)hipGetDevice(&dev);
        (void)hipDeviceGetAttribute(&cus, hipDeviceAttributeMultiprocessorCount, dev);
        if (hipFuncSetAttribute((const void*)hybrid_fwd, hipFuncAttributeMaxDynamicSharedMemorySize, LDS_BYTES) != hipSuccess) { fprintf(stderr, "kernel_launch: hipFuncSetAttribute failed\n"); grid_blocks = -1; return; }
        if (hipOccupancyMaxActiveBlocksPerMultiprocessor(&per_cu, (const void*)hybrid_fwd, 512, LDS_BYTES) != hipSuccess || per_cu < 1) { fprintf(stderr, "kernel_launch: occupancy query failed (%d)\n", per_cu); per_cu = 1; (void)hipGetLastError(); }
        grid_blocks = cus * per_cu;
    }
    if (grid_blocks < 0) return;
    Params p{};
    p.x = (const float*)d_in[0]; p.w_in = (const float*)d_in[1]; p.b_fgate = (const float*)d_in[2]; p.gn_gain = (const float*)d_in[3];
    p.w_out = (const float*)d_in[4]; p.ln_gain = (const float*)d_in[5]; p.ln_bias = (const float*)d_in[6];
    p.out = (float*)d_out; p.ws = (unsigned char*)d_ws;
#if NAIVE_MIX
    const int cuts[4] = {0, 3, 7, 9};
    for (int i = 0; i < 3; ++i) {
        p.ph_lo = cuts[i]; p.ph_hi = cuts[i + 1];
        void* args[] = {&p};
        hipError_t e = hipLaunchCooperativeKernel((const void*)hybrid_fwd, dim3(grid_blocks), dim3(512), args, LDS_BYTES, stream);
        if (e != hipSuccess) fprintf(stderr, "cooperative launch failed: %s (grid %d)\n", hipGetErrorString(e), grid_blocks);
        if (i < 2) hipLaunchKernelGGL(naive_mix_kernel, dim3(grid_blocks), dim3(512), 0, stream, p, i);
    }
#else
    p.ph_lo = 0; p.ph_hi = 9;
    void* args[] = {&p};
    hipError_t e = hipLaunchCooperativeKernel((const void*)hybrid_fwd, dim3(grid_blocks), dim3(512), args, LDS_BYTES, stream);
    if (e != hipSuccess) fprintf(stderr, "cooperative launch failed: %s (grid %d)\n", hipGetErrorString(e), grid_blocks);
#endif
}
```

```cpp
#include <hip/hip_runtime.h>
#include <hip/hip_cooperative_groups.h>
#include <cstdio>
#include <cstdint>
#include <cmath>
namespace cg = cooperative_groups;
namespace pg8 {
#define PG8_LAS __attribute__((address_space(3)))
typedef unsigned short bf16_t;
typedef short bf16x8 __attribute__((ext_vector_type(8)));
typedef float f32x4 __attribute__((ext_vector_type(4)));
typedef unsigned u32x4 __attribute__((ext_vector_type(4)));
constexpr int BM = 256, BK = 64, HALF = 128, HTB = HALF * BK * 2  , STAGE_BYTES = 8 * HTB, NXCD = 8, WGM = 8;

__host__ __device__ __forceinline__ int lds_byte(int r, int c) { const int st = (r >> 4) * 2 + (c >> 5), rr = r & 15, cc = c & 31, ob = rr * 64 + cc * 2; return st * 1024 + (ob ^ (((ob >> 9) & 1) << 5)); }
__host__ __device__ __forceinline__ void stage_rc(int b, int& R, int& C) { const int st = b / 1024, sb = b % 1024, swz = sb ^ (((sb >> 9) & 1) << 5); R = (st >> 1) * 16 + swz / 64; C = (st & 1) * 32 + (swz % 64) / 2; }
__host__ __device__ __forceinline__ int perm32(int rho) { const int n = rho >> 4, i = rho & 15; return 8 * (i >> 2) + 4 * n + (i & 3); }

struct Unit { int pm, pn; };
struct Gemm { const bf16_t* A; const bf16_t* Bt; int M, N, K; };

struct StaticOrder {
    int nM, nN, nwg, G, c;
    __host__ __device__ void init(int M, int N, int G_, int c_) { nM = M / BM; nN = N / BM; nwg = nM * nN; G = G_; c = c_; }
    __host__ __device__ bool next(int i, Unit& u) const {
        const long L = (long)i * G + c; if (L >= nwg) return false;
        int wgid = (int)L; { const int q = nwg / NXCD, r = nwg % NXCD, xcd = wgid % NXCD, off = wgid / NXCD; wgid = (xcd < r ? xcd * (q + 1) : r * (q + 1) + (xcd - r) * q) + off; }
        const int nig = WGM * nN, gid = wgid / nig, fm = gid * WGM, gsz = (nM - fm) < WGM ? (nM - fm) : WGM;
        u.pm = fm + ((wgid % nig) % gsz); u.pn = (wgid % nig) / gsz; return true;
    }
    __device__ __forceinline__ void a_ready(const Unit&) const {}
    __device__ __forceinline__ void done(const Unit&) const {}
};

__device__ __forceinline__ unsigned cvt_pk_bf16(float lo, float hi) { unsigned r; asm volatile("v_cvt_pk_bf16_f32 %0, %1, %2" : "=v"(r) : "v"(lo), "v"(hi)); return r; }
typedef float f32x2 __attribute__((ext_vector_type(2)));
__device__ __forceinline__ f32x2 gelu_pk(f32x2 v) {
    const f32x2 av = __builtin_elementwise_abs(v), d = av * 0.2316418882f + 1.0f;
    f32x2 t; t.x = __builtin_amdgcn_rcpf(d.x); t.y = __builtin_amdgcn_rcpf(d.y);
    f32x2 q = t * 0.5307027145f + (-0.7265760135f); q = q * t + 0.7107068705f; q = q * t + (-0.142248368f); q = q * t + 0.127414796f; q = q * t;
    const f32x2 s = (v * v) * (-0.72134752044f);
    f32x2 e; e.x = __builtin_amdgcn_exp2f(s.x); e.y = __builtin_amdgcn_exp2f(s.y);
    const f32x2 m = v * (q * e), r = v - m;
    f32x2 o; o.x = v.x < 0.f ? m.x : r.x; o.y = v.y < 0.f ? m.y : r.y; return o;
}

template <int ACT  > struct EpiBf16 {
    static constexpr bool PERM = true, AFTER_DRAIN = false; static_assert(ACT == 0 || ACT == 1, "EpiBf16: ACT is 0 (none) or 1 (gelu_pk)");
    bf16_t* O; int ldc; const float* bias; int split_cols; size_t split_stride; float scale0;
    __device__ __forceinline__ void operator()(const f32x4 (&acc)[2][2][4][2], const Unit& u, int wr, int wc, int fr, int fq) const {
        const int row0 = u.pm * BM + wr * 64 + fr; int colt = u.pn * BM; bf16_t* base = O;
        float sc = 1.f; if (split_cols) { const int t = colt / split_cols; base += (size_t)t * split_stride; colt -= t * split_cols; if (t == 0) sc = scale0; }
        const int col0 = colt + wc * 32 + 8 * fq, bcol0 = u.pn * BM + wc * 32 + 8 * fq;
        f32x4 bv[2][2];
#pragma unroll
        for (int bj = 0; bj < 2; ++bj)
#pragma unroll
            for (int n = 0; n < 2; ++n) bv[bj][n] = bias ? *(const f32x4*)(bias + bcol0 + bj * HALF + 4 * n) : (f32x4){0.f, 0.f, 0.f, 0.f};
#pragma unroll
        for (int ai = 0; ai < 2; ++ai)
#pragma unroll
            for (int m = 0; m < 4; ++m) { bf16_t* rowp = base + (size_t)(row0 + ai * HALF + m * 16) * ldc + col0;
#pragma unroll
                for (int bj = 0; bj < 2; ++bj) { f32x4 v0 = acc[ai][bj][m][0] + bv[bj][0], v1 = acc[ai][bj][m][1] + bv[bj][1];
                    if (ACT == 1) { f32x2 a = gelu_pk((f32x2){v0[0], v0[1]}), b = gelu_pk((f32x2){v0[2], v0[3]}), c = gelu_pk((f32x2){v1[0], v1[1]}), d = gelu_pk((f32x2){v1[2], v1[3]});
                        v0 = (f32x4){a.x, a.y, b.x, b.y}; v1 = (f32x4){c.x, c.y, d.x, d.y}; }
                    v0 = v0 * sc; v1 = v1 * sc; u32x4 w; w.x = cvt_pk_bf16(v0[0], v0[1]); w.y = cvt_pk_bf16(v0[2], v0[3]); w.z = cvt_pk_bf16(v1[0], v1[1]); w.w = cvt_pk_bf16(v1[2], v1[3]);
                    *(u32x4*)(rowp + bj * HALF) = w; } }
    }
};
struct EpiResid {
    static constexpr bool PERM = true, AFTER_DRAIN = false;
    const float* res; float* out; int ldc; float alpha;
    __device__ __forceinline__ void operator()(const f32x4 (&acc)[2][2][4][2], const Unit& u, int wr, int wc, int fr, int fq) const {
        const int row0 = u.pm * BM + wr * 64 + fr; const int col0 = u.pn * BM + wc * 32 + 8 * fq;
#pragma unroll
        for (int ai = 0; ai < 2; ++ai)
#pragma unroll
            for (int m = 0; m < 4; ++m) { const size_t ro = (size_t)(row0 + ai * HALF + m * 16) * ldc + col0;
#pragma unroll
                for (int bj = 0; bj < 2; ++bj) {
                    const f32x4 r0 = *(const f32x4*)(res + ro + bj * HALF), r1 = *(const f32x4*)(res + ro + bj * HALF + 4);
                    const f32x4 v0 = acc[ai][bj][m][0] + r0 * alpha, v1 = acc[ai][bj][m][1] + r1 * alpha;
                    *(f32x4*)(out + ro + bj * HALF) = v0; *(f32x4*)(out + ro + bj * HALF + 4) = v1; } }
    }
};
struct EpiInProj {
    static constexpr bool PERM = true, AFTER_DRAIN = false;
    bf16_t* O; const float* rope;
    __device__ __forceinline__ void operator()(const f32x4 (&acc)[2][2][4][2], const Unit& u, int wr, int wc, int fr, int fq) const {
        const int row0 = u.pm * BM + wr * 64 + fr;
#pragma unroll
        for (int bj = 0; bj < 2; ++bj) {
            const int colg = u.pn * BM + bj * HALF + wc * 32, col0 = colg + 8 * fq, head = colg >> 6;
            const bool isrot = (head >= 6 && head < 12) || (head >= 22 && head < 28);
            const float sc = (head < 6 || (head >= 12 && head < 16)) ? 0.125f * 1.4426950408889634f : (head >= 16 ? 0.125f : 1.f);
            const bool issc = (head < 6 || (head >= 12 && head < 16));
            const int i0 = ((colg & 63) + 8 * fq) >> 1;
#pragma unroll
            for (int ai = 0; ai < 2; ++ai)
#pragma unroll
                for (int m = 0; m < 4; ++m) {
                    const int row = row0 + ai * HALF + m * 16;
                    f32x4 v0 = acc[ai][bj][m][0], v1 = acc[ai][bj][m][1];
                    if (isrot) {
                        const int pos = row & 2047;
                        const f32x4 c = *(const f32x4*)(rope + pos * 32 + i0), s = *(const f32x4*)(rope + 2048 * 32 + pos * 32 + i0);
                        f32x4 w0, w1;
                        w0[0] = (v0[0] * c[0] - v0[1] * s[0]) * sc; w0[1] = (v0[0] * s[0] + v0[1] * c[0]) * sc;
                        w0[2] = (v0[2] * c[1] - v0[3] * s[1]) * sc; w0[3] = (v0[2] * s[1] + v0[3] * c[1]) * sc;
                        w1[0] = (v1[0] * c[2] - v1[1] * s[2]) * sc; w1[1] = (v1[0] * s[2] + v1[1] * c[2]) * sc;
                        w1[2] = (v1[2] * c[3] - v1[3] * s[3]) * sc; w1[3] = (v1[2] * s[3] + v1[3] * c[3]) * sc;
                        v0 = w0; v1 = w1;
                    }
                    if (issc) { v0 = v0 * sc; v1 = v1 * sc; }
                    u32x4 w; w.x = cvt_pk_bf16(v0[0], v0[1]); w.y = cvt_pk_bf16(v0[2], v0[3]); w.z = cvt_pk_bf16(v1[0], v1[1]); w.w = cvt_pk_bf16(v1[2], v1[3]);
                    *(u32x4*)(O + ((size_t)((row >> 11) * 64 + head) * 2048 + (row & 2047)) * 64 + (col0 & 63)) = w;
                }
        }
    }
};
template <class Epi, class Sched, bool ALIGN_EPI = false, bool SP2 = false>
__device__ __forceinline__ void gemm_phase(PG8_LAS unsigned char* lds, const Gemm g, const Sched& S, const Epi& E) {
    int tid = threadIdx.x; asm volatile("" : "+v"(tid));
    const int wid = __builtin_amdgcn_readfirstlane(tid >> 6), lane = tid & 63, wr = wid >> 2, wc = wid & 3, fr = lane & 15, fq = lane >> 4;
    const int K = g.K, nt = K / BK;
    unsigned voffA[2], voffB[2];
#pragma unroll
    for (int i = 0; i < 2; ++i) { int R, C; stage_rc(tid * 16 + i * 8192, R, C); const int Rb = Epi::PERM ? ((R & ~31) + perm32(R & 31)) : R;
        voffA[i] = (unsigned)(R * K + C) * 2u; voffB[i] = (unsigned)(Rb * K + C) * 2u; }
    const size_t kstep = (size_t)(BK * 2);
    const size_t hstep = (size_t)HALF * K * 2;
    const size_t tstep = 2 * hstep;
    const unsigned ldsw = (unsigned)wid * 1024u;
    const int aoff = lds_byte(wr * 64 + fr, fq * 8), boff = lds_byte(wc * 32 + fr, fq * 8);
#define PG8_SA(b, h) (((b) * 2 + (h)) * HTB)
#define PG8_SB(b, h) ((4 + (b) * 2 + (h)) * HTB)
#define PG8_STAGE(bufoff, gbase, voff) do { _Pragma("unroll") for (int _i = 0; _i < 2; ++_i) \
        __builtin_amdgcn_global_load_lds((const unsigned*)((const char*)(gbase) + (voff)[_i]), (PG8_LAS unsigned*)(lds + (bufoff) + ldsw + _i * 8192), 16, 0, 0); } while (0)
#define PG8_LDA(dst, b, h) do { _Pragma("unroll") for (int m = 0; m < 4; ++m) _Pragma("unroll") for (int k = 0; k < 2; ++k) dst[m][k] = *(const PG8_LAS bf16x8*)(lds + PG8_SA(b, h) + aoff + m * 2048 + k * 1024); } while (0)
#define PG8_LDB(dst, b, h) do { _Pragma("unroll") for (int n = 0; n < 2; ++n) _Pragma("unroll") for (int k = 0; k < 2; ++k) dst[n][k] = *(const PG8_LAS bf16x8*)(lds + PG8_SB(b, h) + boff + n * 2048 + k * 1024); } while (0)
#define PG8_MMA(ai, bj, At, Bt) do { __builtin_amdgcn_s_setprio(1); _Pragma("unroll") for (int m = 0; m < 4; ++m) _Pragma("unroll") for (int n = 0; n < 2; ++n) _Pragma("unroll") for (int k = 0; k < 2; ++k) \
        acc[ai][bj][m][n] = __builtin_amdgcn_mfma_f32_16x16x32_bf16(Bt[n][k], At[m][k], acc[ai][bj][m][n], 0, 0, 0); __builtin_amdgcn_s_setprio(0); } while (0)
#define PG8_WAIT_V(n) asm volatile("s_waitcnt vmcnt(" #n ")" ::: "memory")
#define PG8_WAIT_L(n) asm volatile("s_waitcnt lgkmcnt(" #n ")" ::: "memory")
#define PG8_BAR __builtin_amdgcn_s_barrier()
#define PG8_SCHED __builtin_amdgcn_sched_barrier(0)
    Unit cur, nxt; int ui = 0;
    if (!S.next(0, cur)) return;
    f32x4 acc[2][2][4][2];
#pragma unroll
    for (int a = 0; a < 2; ++a)
#pragma unroll
        for (int b = 0; b < 2; ++b)
#pragma unroll
            for (int m = 0; m < 4; ++m)
#pragma unroll
                for (int n = 0; n < 2; ++n) acc[a][b][m][n] = (f32x4){0.f, 0.f, 0.f, 0.f};
    bf16x8 At[4][2], B0[2][2], B1[2][2];
    const char* cA = (const char*)g.A + (size_t)cur.pm * tstep; const char* cB = (const char*)g.Bt + (size_t)cur.pn * tstep;
    S.a_ready(cur);
    if constexpr (SP2) {
        PG8_STAGE(PG8_SB(0, 0), cB, voffB); PG8_STAGE(PG8_SB(0, 1), cB + hstep, voffB); PG8_STAGE(PG8_SA(0, 0), cA, voffA); PG8_STAGE(PG8_SA(0, 1), cA + hstep, voffA);
        if (wr == 1) PG8_BAR;
        PG8_WAIT_V(2); PG8_BAR;
        PG8_STAGE(PG8_SB(1, 0), cB + kstep, voffB); PG8_STAGE(PG8_SA(1, 0), cA + kstep, voffA); PG8_STAGE(PG8_SB(1, 1), cB + hstep + kstep, voffB);
        PG8_WAIT_V(6); PG8_BAR;
    } else {
        PG8_STAGE(PG8_SB(0, 0), cB, voffB); PG8_STAGE(PG8_SA(0, 0), cA, voffA); PG8_STAGE(PG8_SB(0, 1), cB + hstep, voffB); PG8_STAGE(PG8_SA(0, 1), cA + hstep, voffA);
        if (wr == 1) PG8_BAR;
        PG8_WAIT_V(4); PG8_BAR;
        PG8_STAGE(PG8_SB(1, 0), cB + kstep, voffB); PG8_STAGE(PG8_SA(1, 0), cA + kstep, voffA); PG8_STAGE(PG8_SB(1, 1), cB + hstep + kstep, voffB);
        PG8_WAIT_V(6); PG8_BAR;
    }
    for (;;) {
        const bool has_next = S.next(ui + 1, nxt);
        const char* nA = has_next ? (const char*)g.A + (size_t)nxt.pm * tstep : cA; const char* nB = has_next ? (const char*)g.Bt + (size_t)nxt.pn * tstep : cB;
        for (int t = 0; t < nt; t += 2) {
            const bool last = (t == nt - 2);
            const char* a1 = cA + (size_t)(t + 1) * kstep;
            const char* a2 = last ? nA : cA + (size_t)(t + 2) * kstep; const char* b2 = last ? nB : cB + (size_t)(t + 2) * kstep;
            const char* a3 = a2 + kstep; const char* b3 = b2 + kstep;
            if (last && has_next) S.a_ready(nxt);
            if constexpr (SP2) {
            PG8_LDB(B0, 0, 0); PG8_LDB(B1, 0, 1); PG8_SCHED; PG8_LDA(At, 0, 0); PG8_STAGE(PG8_SA(1, 1), a1 + hstep, voffA);
            PG8_WAIT_V(8); PG8_WAIT_L(0); PG8_BAR; PG8_MMA(0, 0, At, B0); PG8_MMA(0, 1, At, B1); PG8_BAR; PG8_SCHED;
            PG8_LDA(At, 0, 1); PG8_STAGE(PG8_SB(0, 0), b2, voffB); PG8_STAGE(PG8_SB(0, 1), b2 + hstep, voffB); PG8_STAGE(PG8_SA(0, 0), a2, voffA);
            PG8_WAIT_V(8); PG8_WAIT_L(0); PG8_BAR; PG8_MMA(1, 0, At, B0); PG8_MMA(1, 1, At, B1); PG8_BAR; PG8_SCHED;
            PG8_LDB(B0, 1, 0); PG8_LDB(B1, 1, 1); PG8_SCHED; PG8_LDA(At, 1, 0); PG8_STAGE(PG8_SA(0, 1), a2 + hstep, voffA);
            PG8_WAIT_V(8); PG8_WAIT_L(0); PG8_BAR; PG8_MMA(0, 0, At, B0); PG8_MMA(0, 1, At, B1); PG8_BAR; PG8_SCHED;
            PG8_LDA(At, 1, 1); PG8_STAGE(PG8_SB(1, 0), b3, voffB); PG8_STAGE(PG8_SB(1, 1), b3 + hstep, voffB); PG8_STAGE(PG8_SA(1, 0), a3, voffA);
            PG8_WAIT_V(8); PG8_WAIT_L(0); PG8_BAR; PG8_MMA(1, 0, At, B0); PG8_MMA(1, 1, At, B1); PG8_BAR; PG8_SCHED;
            } else {
            PG8_LDB(B0, 0, 0); PG8_SCHED; PG8_LDA(At, 0, 0); PG8_STAGE(PG8_SA(1, 1), a1 + hstep, voffA);
            PG8_WAIT_L(8); PG8_BAR; PG8_WAIT_L(0); PG8_MMA(0, 0, At, B0); PG8_BAR; PG8_SCHED;
            PG8_LDB(B1, 0, 1); PG8_STAGE(PG8_SB(0, 0), b2, voffB);
            PG8_BAR; PG8_WAIT_L(0); PG8_MMA(0, 1, At, B1); PG8_BAR;
            PG8_LDA(At, 0, 1); PG8_STAGE(PG8_SA(0, 0), a2, voffA);
            PG8_BAR; PG8_WAIT_L(0); PG8_MMA(1, 0, At, B0); PG8_BAR; PG8_SCHED;
            PG8_STAGE(PG8_SB(0, 1), b2 + hstep, voffB);
            PG8_WAIT_V(6); PG8_BAR; PG8_MMA(1, 1, At, B1); PG8_BAR;
            PG8_LDB(B0, 1, 0); PG8_SCHED; PG8_LDA(At, 1, 0); PG8_STAGE(PG8_SA(0, 1), a2 + hstep, voffA);
            PG8_WAIT_L(8); PG8_BAR; PG8_WAIT_L(0); PG8_MMA(0, 0, At, B0); PG8_BAR; PG8_SCHED;
            PG8_LDB(B1, 1, 1); PG8_STAGE(PG8_SB(1, 0), b3, voffB);
            PG8_BAR; PG8_WAIT_L(0); PG8_MMA(0, 1, At, B1); PG8_BAR;
            PG8_LDA(At, 1, 1); PG8_STAGE(PG8_SA(1, 0), a3, voffA);
            PG8_BAR; PG8_WAIT_L(0); PG8_MMA(1, 0, At, B0); PG8_BAR; PG8_SCHED;
            PG8_STAGE(PG8_SB(1, 1), b3 + hstep, voffB);
            PG8_WAIT_V(6); PG8_BAR; PG8_MMA(1, 1, At, B1); PG8_BAR;
            }
        }
        if constexpr (ALIGN_EPI) { if (wr == 0) PG8_BAR; }
        if constexpr (!Epi::AFTER_DRAIN) { E(acc, cur, wr, wc, fr, fq); S.done(cur); }
        if (!has_next) break;
#pragma unroll
        for (int a = 0; a < 2; ++a)
#pragma unroll
            for (int b = 0; b < 2; ++b)
#pragma unroll
                for (int m = 0; m < 4; ++m)
#pragma unroll
                    for (int n = 0; n < 2; ++n) acc[a][b][m][n] = (f32x4){0.f, 0.f, 0.f, 0.f};
        cur = nxt; cA = nA; cB = nB; ++ui;
        if constexpr (ALIGN_EPI) { if (wr == 1) PG8_BAR; }
    }
    PG8_WAIT_V(0);
    if constexpr (!ALIGN_EPI) { if (wr == 0) PG8_BAR; }
    PG8_BAR;
    if constexpr (Epi::AFTER_DRAIN) { E.fused(acc, cur, wr, wc, fr, fq, lds, wid, lane); S.done(cur); }
#undef PG8_SA
#undef PG8_SB
#undef PG8_STAGE
#undef PG8_LDA
#undef PG8_LDB
#undef PG8_MMA
#undef PG8_WAIT_V
#undef PG8_WAIT_L
#undef PG8_BAR
#undef PG8_SCHED
}
}

#ifndef MIX_MASK
#define MIX_MASK 7
#endif
#define NAIVE_MIX (MIX_MASK != 7)
constexpr int NB = 16, SEQ = 2048, DM = 1024, MTOK = NB * SEQ, NQ = 4096, DIN = 4102, NL = 2;
constexpr int HF = 6, HR = 6, HS = 4, HD = 64;
constexpr float LN_EPS = 1e-5f, GN_EPS = 1e-5f;
constexpr float DN_ALPHA = 1.4142135623730951f;
constexpr float LOG2E = 1.4426950408889634f;
typedef unsigned short bf16_t;
typedef float f32x4 __attribute__((ext_vector_type(4)));
typedef unsigned u32x4 __attribute__((ext_vector_type(4)));
typedef unsigned u32x2 __attribute__((ext_vector_type(2)));

constexpr size_t MiB = 1u << 20;
constexpr size_t WS_QKVG = 0;
constexpr size_t WS_Y    = 256 * MiB;
constexpr size_t WS_XB   = 320 * MiB;
constexpr size_t WS_WIN  = 384 * MiB;
constexpr size_t WS_WOUT = 400 * MiB;
constexpr size_t WS_FLOG = 404 * MiB;
constexpr size_t WS_C    = 405 * MiB;
constexpr size_t WS_ROPE = 406 * MiB;
constexpr size_t WS_CTR  = 407 * MiB;
constexpr size_t WS_END  = 408 * MiB;

constexpr int LDS_BYTES = 147456;

struct Params {
    const float *x, *w_in, *b_fgate, *gn_gain, *w_out, *ln_gain, *ln_bias;
    float* out; unsigned char* ws;
    int ph_lo, ph_hi;
};

__device__ __forceinline__ unsigned f2bf(float f) { unsigned u = __builtin_bit_cast(unsigned, f); return (u + 0x7fffu + ((u >> 16) & 1u)) >> 16; }
__device__ __forceinline__ unsigned pk2(float lo, float hi) { return f2bf(lo) | (f2bf(hi) << 16); }
__device__ __forceinline__ float bflo(unsigned u) { return __builtin_bit_cast(float, u << 16); }
__device__ __forceinline__ float bfhi(unsigned u) { return __builtin_bit_cast(float, u & 0xffff0000u); }
__device__ __forceinline__ float wave_sum(float v) {
#pragma unroll
    for (int o = 1; o < 64; o <<= 1) v += __shfl_xor(v, o);
    return v;
}
__device__ __forceinline__ float logsig_acc(float z) { return fminf(z, 0.f) - log1pf(expf(-fabsf(z))); }

__device__ __forceinline__ int rowmap_in(int n) {
    const bool r = (n >= 384 && n < 768) || (n >= 1408 && n < 1792); const int d = n & 63; return r ? (n & ~63) + ((d & 31) << 1) + (d >> 5) : n;
}
template <bool MAP> __device__ __forceinline__ void transpose_item(const float* W, int ldw, int K, bf16_t* WT, float* scr, int kb, int nb, int lane) {
    const int k0 = 64 * kb, n0 = 32 * nb;
#pragma unroll 8
    for (int i = 0; i < 32; ++i) { const int kk = 2 * i + (lane >> 5); scr[kk * 33 + (lane & 31)] = W[(size_t)(k0 + kk) * ldw + n0 + (lane & 31)]; }
    __builtin_amdgcn_wave_barrier(); asm volatile("s_waitcnt lgkmcnt(0)" ::: "memory");
    const int c = lane & 7;
#pragma unroll
    for (int j = 0; j < 4; ++j) { const int n = (lane >> 3) + 8 * j; const float* s = scr + (8 * c) * 33 + n;
        u32x4 o; o.x = pk2(s[0 * 33], s[1 * 33]); o.y = pk2(s[2 * 33], s[3 * 33]); o.z = pk2(s[4 * 33], s[5 * 33]); o.w = pk2(s[6 * 33], s[7 * 33]);
        const int nr = MAP ? rowmap_in(n0 + n) : (n0 + n); *(u32x4*)(WT + (size_t)nr * K + k0 + 8 * c) = o; }
    __builtin_amdgcn_wave_barrier(); asm volatile("s_waitcnt lgkmcnt(0)" ::: "memory");
}

__device__ __forceinline__ void stage_wf(const Params& P, int l, float* wfs) {
    for (int i = threadIdx.x; i < 6 * 1024; i += 512) { const int k = i / 6, h = i % 6; wfs[h * 1024 + k] = P.w_in[((size_t)l * DM + k) * DIN + NQ + h]; }
}
__device__ __forceinline__ void row_emit(const f32x4 (&v)[4], bf16_t* xbrow, const float* wfs, float* flogrow, int lane) {
#pragma unroll
    for (int j = 0; j < 4; ++j) { u32x2 o; o.x = pk2(v[j].x, v[j].y); o.y = pk2(v[j].z, v[j].w); ((u32x2*)xbrow)[lane + 64 * j] = o; }
    float a0 = 0.f, a1 = 0.f, a2 = 0.f, a3 = 0.f, a4 = 0.f, a5 = 0.f;
#pragma unroll
    for (int j = 0; j < 4; ++j) {
        const float* wp = wfs + 4 * lane + 256 * j;
        f32x4 w;
        w = *(const f32x4*)(wp);          a0 += v[j].x * w.x + v[j].y * w.y + v[j].z * w.z + v[j].w * w.w;
        w = *(const f32x4*)(wp + 1024);   a1 += v[j].x * w.x + v[j].y * w.y + v[j].z * w.z + v[j].w * w.w;
        w = *(const f32x4*)(wp + 2048);   a2 += v[j].x * w.x + v[j].y * w.y + v[j].z * w.z + v[j].w * w.w;
        w = *(const f32x4*)(wp + 3072);   a3 += v[j].x * w.x + v[j].y * w.y + v[j].z * w.z + v[j].w * w.w;
        w = *(const f32x4*)(wp + 4096);   a4 += v[j].x * w.x + v[j].y * w.y + v[j].z * w.z + v[j].w * w.w;
        w = *(const f32x4*)(wp + 5120);   a5 += v[j].x * w.x + v[j].y * w.y + v[j].z * w.z + v[j].w * w.w;
    }
    a0 = wave_sum(a0); a1 = wave_sum(a1); a2 = wave_sum(a2); a3 = wave_sum(a3); a4 = wave_sum(a4); a5 = wave_sum(a5);
    float r = a0; if (lane == 1) r = a1; if (lane == 2) r = a2; if (lane == 3) r = a3; if (lane == 4) r = a4; if (lane == 5) r = a5;
    if (lane < 6) flogrow[lane] = r;
}

__device__ __forceinline__ void phase0(const Params& P, unsigned char* lds) {
    int tid = threadIdx.x; asm volatile("" : "+v"(tid));
    const int lane = tid & 63, wave = tid >> 6;
    const int gw = blockIdx.x * 8 + wave, NGW = gridDim.x * 8;
    unsigned char* ws = P.ws;
    if (blockIdx.x == 0 && tid < 64) ((unsigned*)(ws + WS_CTR))[tid] = 0u;
    float* scr = (float*)lds + wave * (64 * 33);
    float* wfs = (float*)(lds + 8 * 64 * 33 * 4);
    stage_wf(P, 0, wfs);
    constexpr int I_IN = (DM / 64) * (NQ / 32), I_OUT = (DM / 64) * (DM / 32);
    for (int it = gw; it < NL * (I_IN + I_OUT); it += NGW) {
        int r = it; const int l = r / (I_IN + I_OUT); r -= l * (I_IN + I_OUT);
        if (r < I_IN) transpose_item<true>(P.w_in + (size_t)l * DM * DIN, DIN, DM, (bf16_t*)(ws + WS_WIN) + (size_t)l * NQ * DM, scr, r / (NQ / 32), r % (NQ / 32), lane);
        else { r -= I_IN; transpose_item<false>(P.w_out + (size_t)l * DM * DM, DM, DM, (bf16_t*)(ws + WS_WOUT) + (size_t)l * DM * DM, scr, r / (DM / 32), r % (DM / 32), lane); }
    }
    for (int i = blockIdx.x * 512 + tid; i < SEQ * 32; i += gridDim.x * 512) {
        const int pos = i >> 5, f = i & 31; const float invf = (float)(1.0 / exp2((double)f * (13.287712379549449 / 32.0))); const float ang = (float)pos * invf;
        const double t = (double)ang * 0.15915494309189535; const float fr = (float)(t - floor(t));
        ((float*)(ws + WS_ROPE))[i] = __builtin_amdgcn_cosf(fr); ((float*)(ws + WS_ROPE))[SEQ * 32 + i] = __builtin_amdgcn_sinf(fr);
    }
    __syncthreads();
    for (int m = gw; m < MTOK; m += NGW) {
        const f32x4* xr = (const f32x4*)(P.x + (size_t)m * DM) + lane; f32x4 v[4];
#pragma unroll
        for (int j = 0; j < 4; ++j) v[j] = xr[64 * j];
        row_emit(v, (bf16_t*)(ws + WS_XB) + (size_t)m * DM, wfs, (float*)(ws + WS_FLOG) + (size_t)m * 8, lane);
    }
    __syncthreads();
}

__device__ __forceinline__ void fgate_cumsum(const Params& P, int l) {
    int tid = threadIdx.x; asm volatile("" : "+v"(tid));
    const int lane = tid & 63, wave = tid >> 6;
    const int gw = blockIdx.x * 8 + wave;
    if (gw >= NB * HF) return;
    const int b = gw / HF, h = gw % HF; const float bias = P.b_fgate[l * HF + h];
    const float* fl = (const float*)(P.ws + WS_FLOG) + ((size_t)b * SEQ + lane * 32) * 8 + h;
    float vals[32]; float run = 0.f;
#pragma unroll
    for (int i = 0; i < 32; ++i) { run += logsig_acc(fl[i * 8] + bias); vals[i] = run; }
    float incl = run;
#pragma unroll
    for (int o = 1; o < 64; o <<= 1) { const float t = __shfl_up(incl, o); if (lane >= o) incl += t; }
    const float excl = incl - run;
    float* c = (float*)(P.ws + WS_C) + ((size_t)(b * HF + h)) * SEQ + lane * 32;
#pragma unroll
    for (int i = 0; i < 32; ++i) c[i] = vals[i] + excl;
}

typedef short bf16x8 __attribute__((ext_vector_type(8)));
typedef short s16x4 __attribute__((ext_vector_type(4)));
typedef float f32x16 __attribute__((ext_vector_type(16)));
typedef float f32x2_t __attribute__((ext_vector_type(2)));
typedef __bf16 bf16x2_t __attribute__((ext_vector_type(2)));
__device__ __forceinline__ unsigned cvtpk(float lo, float hi) { f32x2_t v = {lo, hi}; bf16x2_t b = __builtin_convertvector(v, bf16x2_t); return __builtin_bit_cast(unsigned, b); }
#define PACK8(P, B) __builtin_bit_cast(bf16x8, (u32x4){cvtpk(P[B], P[B + 1]), cvtpk(P[B + 2], P[B + 3]), cvtpk(P[B + 4], P[B + 5]), cvtpk(P[B + 6], P[B + 7])})
#define MFMA32(a, b, c) __builtin_amdgcn_mfma_f32_32x32x16_bf16((a), (b), (c), 0, 0, 0)
typedef short v4i16_t __attribute__((ext_vector_type(4)));
__device__ __forceinline__ s16x4 vtr(const bf16_t* p) { return __builtin_bit_cast(s16x4, __builtin_amdgcn_ds_read_tr16_b64_v4i16((__attribute__((address_space(3))) v4i16_t*)p)); }
__device__ __forceinline__ int crow(int r, int hi) { return (r & 3) + 8 * (r >> 2) + 4 * hi; }
constexpr int KP = 72, VP = 68, SP = 68;
constexpr int L_K = 0, L_V = L_K + 2 * 64 * KP * 2, L_C2 = L_V + 2 * 64 * KP * 2, L_WSF = L_C2 + SEQ * 4, L_STG = L_WSF + 8 * 64 * 4, L_FLG = L_STG + 8 * 32 * SP * 4, L_QW = L_FLG + 64, L_KT = L_QW + 16, L_ST = L_KT + 2 * 64 * KP * 2, L_MIX_END = L_ST + 64 * KP * 2;
static_assert(L_MIX_END <= LDS_BYTES, "mixer LDS map");
constexpr float C2S = 0.125f * 1.4426950408889634f;
#ifndef RS
#define RS 4
#endif
#define TILE_BARRIER() asm volatile("s_waitcnt lgkmcnt(0)\n\ts_barrier" ::: "memory")
constexpr float FOX_THR = 6.f;
constexpr float SB_CUT = -160.f;

template <int MODE> __device__ __forceinline__ void attn_unit(const Params& P, int l, int b, int hh, int qb_arg, unsigned char* lds) {
    int tid = threadIdx.x; asm volatile("" : "+v"(tid));
    const int lane = tid & 63, wave = __builtin_amdgcn_readfirstlane(tid >> 6), r32 = lane & 31, hi = lane >> 5;
    const bf16_t* base = (const bf16_t*)(P.ws + WS_QKVG) + ((size_t)(b * 64 + hh) * SEQ) * 64;
    constexpr size_t KOFF = (size_t)16 * SEQ * 64, VOFF = 2 * KOFF, GOFF = 3 * KOFF;
    bf16_t* Ks = (bf16_t*)(lds + L_K); bf16_t* Vt = (bf16_t*)(lds + L_V); float* c2s = (float*)(lds + L_C2);
    bf16_t* Ktt = (bf16_t*)(lds + L_KT); bf16_t* St = (bf16_t*)(lds + L_ST);
    float* wsf = (float*)(lds + L_WSF) + wave * 64; float* stg = (float*)(lds + L_STG) + wave * (32 * SP);
    const float lg2 = (MODE == 2) ? log2f(1.f - exp2f(-5.f - (float)(hh - HF))) : 0.f;
    f32x16 sacc;
#pragma unroll
    for (int r = 0; r < 16; ++r) sacc[r] = 0.f;
  for (int qb = (MODE == 2 ? 0 : qb_arg); qb <= (MODE == 2 ? 7 : qb_arg); ++qb) {
    const int q0 = qb * 256, qw0 = q0 + wave * 32, t = qw0 + r32;
    const int NT = (MODE == 2) ? 4 : 4 * (qb + 1);
    if (MODE == 2 && qb > 0) __syncthreads();
    float ct2 = 0.f;
    const float* cg_ = (const float*)(P.ws + WS_C) + (size_t)(b * HF + (MODE == 0 ? hh : 0)) * SEQ;
    if (MODE == 0) ct2 = cg_[t] * LOG2E;
    bf16x8 qf[4];
#pragma unroll
    for (int d0 = 0; d0 < 4; ++d0) qf[d0] = *(const bf16x8*)(base + (size_t)t * 64 + d0 * 16 + hi * 8);
    const int lk_key = tid >> 3, lk_ch = tid & 7, lv_key = tid & 63, lv_ch = tid >> 6;
    const bf16_t* kg = base + KOFF + (size_t)lk_key * 64 + lk_ch * 8;
    const bf16_t* vg = base + VOFF + (size_t)lk_key * 64 + lk_ch * 8;
    const int kt0 = (MODE != 2) ? NT - 1 : 4 * qb, kstep = (MODE != 2) ? -1 : 1;
    u32x4 kreg[RS], vreg[RS]; float creg[RS];
#pragma unroll
    for (int u = 0; u < RS; ++u) { creg[u] = 0.f; if (MODE == 0 && tid < 64) creg[u] = cg_[64 * (kt0 + u * kstep) + tid]; kreg[u] = *(const u32x4*)(kg + (size_t)(kt0 + u * kstep) * 64 * 64); vreg[u] = *(const u32x4*)(vg + (size_t)(kt0 + u * kstep) * 64 * 64); }
    const int i16 = lane & 15, tq = i16 >> 2, tp = i16 & 3, tb = (lane >> 4) & 1;
    f32x16 o0, o1;
#pragma unroll
    for (int r = 0; r < 16; ++r) { o0[r] = 0.f; o1[r] = 0.f; }
    if (MODE == 2) {
        if (qb > 0) {
#pragma unroll
            for (int d0 = 0; d0 < 4; ++d0) {
                const bf16x8 s0 = *(const bf16x8*)(St + r32 * KP + d0 * 16 + hi * 8), s1 = *(const bf16x8*)(St + (32 + r32) * KP + d0 * 16 + hi * 8);
                o0 = MFMA32(qf[d0], s0, o0); o1 = MFMA32(qf[d0], s1, o1);
            }
            if (hi == 0) wsf[r32] = __builtin_amdgcn_exp2f((float)(t - q0) * lg2);
            __builtin_amdgcn_wave_barrier();
#pragma unroll
            for (int g = 0; g < 4; ++g) { const f32x4 a = *(const f32x4*)(wsf + 8 * g + 4 * hi);
#pragma unroll
                for (int j = 0; j < 4; ++j) { o0[4 * g + j] *= a[j]; o1[4 * g + j] *= a[j]; } }
            __builtin_amdgcn_wave_barrier();
            if (wave < 4) { const float gC = __builtin_amdgcn_exp2f(256.f * lg2);
#pragma unroll
                for (int r = 0; r < 16; ++r) sacc[r] *= gC; }
        }
    }
    float m_run = 0.f, lsum = 0.f, R = 0.f; bool first = true;
    bool wdone = false;
    volatile int* flg = (volatile int*)(lds + L_FLG);
    bool stop = false;
    for (int it0 = 0; it0 < NT && !stop; it0 += RS) {
#pragma unroll
      for (int u = 0; u < RS; ++u) {
        const int it = it0 + u;
        const int kt = kt0 + kstep * it;
        if (MODE == 1) { if (lane == 0) flg[(it & 1) * 8 + wave] = wdone ? 1 : 0; }
        bf16_t* Kb = Ks + (it & 1) * (64 * KP); bf16_t* Vb = Vt + (it & 1) * (64 * KP); bf16_t* Vd = Ktt + (it & 1) * (64 * KP);
        *(u32x4*)(Kb + lk_key * KP + lk_ch * 8) = kreg[u];
        *(u32x4*)(Vb + lk_key * KP + lk_ch * 8) = vreg[u];
        if (MODE == 0 && tid < 64) c2s[(it & 1) * 64 + tid] = creg[u] * LOG2E;
        if (MODE == 2) {
            const float f = __builtin_amdgcn_exp2f((float)(q0 + 256 - (64 * kt + lk_key)) * lg2); const u32x4 vr = vreg[u]; u32x4 w;
            w.x = cvtpk(bflo(vr.x) * f, bfhi(vr.x) * f); w.y = cvtpk(bflo(vr.y) * f, bfhi(vr.y) * f); w.z = cvtpk(bflo(vr.z) * f, bfhi(vr.z) * f); w.w = cvtpk(bflo(vr.w) * f, bfhi(vr.w) * f);
            *(u32x4*)(Vd + lk_key * KP + lk_ch * 8) = w;
        }
        TILE_BARRIER();
        if (MODE == 1) { int alld = 1;
#pragma unroll
            for (int w = 0; w < 8; ++w) alld &= flg[(it & 1) * 8 + w];
            if (alld) { stop = true; break; } }
        if (it + RS < NT) { if (MODE == 0 && tid < 64) creg[u] = cg_[64 * (kt + RS * kstep) + tid];
            kreg[u] = *(const u32x4*)(kg + (size_t)(kt + RS * kstep) * 64 * 64); vreg[u] = *(const u32x4*)(vg + (size_t)(kt + RS * kstep) * 64 * 64); }
        if (64 * kt <= qw0 + 31 && !(MODE == 1 && wdone)) {
            f32x16 p0, p1;
            const int key0 = 64 * kt + 4 * hi;
            if (MODE == 0) {
                const float* cs = c2s + (it & 1) * 64 + 4 * hi; const float bm = ct2 - m_run;
#pragma unroll
                for (int g = 0; g < 4; ++g) { const f32x4 ca = *(const f32x4*)(cs + 8 * g), cb = *(const f32x4*)(cs + 32 + 8 * g);
#pragma unroll
                    for (int j = 0; j < 4; ++j) { p0[4 * g + j] = bm - ca[j]; p1[4 * g + j] = bm - cb[j]; } }
            } else {
#pragma unroll
                for (int r = 0; r < 16; ++r) { p0[r] = 0.f; p1[r] = 0.f; }
            }
#pragma unroll
            for (int d0 = 0; d0 < 4; ++d0) {
                const bf16x8 ka = *(const bf16x8*)(Kb + r32 * KP + d0 * 16 + hi * 8), kb2 = *(const bf16x8*)(Kb + (32 + r32) * KP + d0 * 16 + hi * 8);
                p0 = MFMA32(ka, qf[d0], p0); p1 = MFMA32(kb2, qf[d0], p1);
            }
            if (MODE == 0) {
                if (64 * kt + 63 > qw0) {
#pragma unroll
                    for (int r = 0; r < 16; ++r) { const int key = key0 + (r & 3) + 8 * (r >> 2); if (key > t) p0[r] = -INFINITY; if (key + 32 > t) p1[r] = -INFINITY; }
                }
                float mx = fmaxf(p0[0], p1[0]);
#pragma unroll
                for (int r = 1; r < 16; ++r) mx = fmaxf(mx, fmaxf(p0[r], p1[r]));
                mx = fmaxf(mx, __shfl_xor(mx, 32));
                if (first || __any(mx > FOX_THR)) {
                    const float delta = first ? mx : fmaxf(mx, 0.f);
                    m_run += delta;
#pragma unroll
                    for (int r = 0; r < 16; ++r) { p0[r] -= delta; p1[r] -= delta; }
                    if (!first) {
                        const float alpha = __builtin_amdgcn_exp2f(-delta);
                        lsum *= alpha;
                        if (hi == 0) wsf[r32] = alpha;
                        __builtin_amdgcn_wave_barrier();
#pragma unroll
                        for (int g = 0; g < 4; ++g) { const f32x4 a = *(const f32x4*)(wsf + 8 * g + 4 * hi);
#pragma unroll
                            for (int j = 0; j < 4; ++j) { o0[4 * g + j] *= a[j]; o1[4 * g + j] *= a[j]; } }
                        __builtin_amdgcn_wave_barrier();
                    }
                    first = false;
                }
                float ps = 0.f;
#pragma unroll
                for (int r = 0; r < 16; ++r) { p0[r] = __builtin_amdgcn_exp2f(p0[r]); p1[r] = __builtin_amdgcn_exp2f(p1[r]); ps += p0[r] + p1[r]; }
                lsum += ps;
            } else if (MODE == 1) {
                const bool diag = (64 * kt + 63 >= qw0);
                if (diag) {
#pragma unroll
                    for (int r = 0; r < 16; ++r) { const int key = key0 + (r & 3) + 8 * (r >> 2); if (key >= t) p0[r] = -1e30f; if (key + 32 >= t) p1[r] = -1e30f; }
                }
                float lr[32];
#pragma unroll
                for (int r = 0; r < 16; ++r) {
                    const float za = p0[r], zb = p1[r];
                    const float spa = __builtin_amdgcn_logf(1.f + __builtin_amdgcn_exp2f(-fabsf(za))), spb = __builtin_amdgcn_logf(1.f + __builtin_amdgcn_exp2f(-fabsf(zb)));
                    lr[r] = (fminf(za, 0.f) - spa) - za; lr[16 + r] = (fminf(zb, 0.f) - spb) - zb;
                }
                float SI[9]; SI[8] = 0.f;
#pragma unroll
                for (int i = 7; i >= 0; --i) SI[i] = SI[i + 1] + ((lr[4 * i] + lr[4 * i + 1]) + (lr[4 * i + 2] + lr[4 * i + 3]));
                float E[8];
#pragma unroll
                for (int i = 0; i < 8; ++i) { const float snd = hi ? SI[i] : SI[i + 1]; E[i] = SI[i + 1] + __shfl_xor(snd, 32); }
                const float T = SI[0] + __shfl_xor(SI[0], 32);
#pragma unroll
                for (int i = 0; i < 8; ++i) {
                    const float bs = R + E[i];
                    const float w2 = lr[4 * i + 3], w1 = w2 + lr[4 * i + 2], w0 = w1 + lr[4 * i + 1];
                    if (i < 4) { p0[4 * i + 3] = __builtin_amdgcn_exp2f(p0[4 * i + 3] + lr[4 * i + 3] + bs); p0[4 * i + 2] = __builtin_amdgcn_exp2f(p0[4 * i + 2] + lr[4 * i + 2] + bs + w2);
                                 p0[4 * i + 1] = __builtin_amdgcn_exp2f(p0[4 * i + 1] + lr[4 * i + 1] + bs + w1); p0[4 * i + 0] = __builtin_amdgcn_exp2f(p0[4 * i + 0] + lr[4 * i + 0] + bs + w0); }
                    else { const int q = 4 * (i - 4);
                                 p1[q + 3] = __builtin_amdgcn_exp2f(p1[q + 3] + lr[4 * i + 3] + bs); p1[q + 2] = __builtin_amdgcn_exp2f(p1[q + 2] + lr[4 * i + 2] + bs + w2);
                                 p1[q + 1] = __builtin_amdgcn_exp2f(p1[q + 1] + lr[4 * i + 1] + bs + w1); p1[q + 0] = __builtin_amdgcn_exp2f(p1[q + 0] + lr[4 * i + 0] + bs + w0); }
                }
                R += T;
                wdone = __all(R < SB_CUT);
            } else {
                const bool diag = (64 * kt + 63 > qw0);
#pragma unroll
                for (int r = 0; r < 16; ++r) { const int key = key0 + (r & 3) + 8 * (r >> 2);
                    p0[r] *= __builtin_amdgcn_exp2f((float)(t - key) * lg2); p1[r] *= __builtin_amdgcn_exp2f((float)(t - key - 32) * lg2);
                    if (diag) { if (key > t) p0[r] = 0.f; if (key + 32 > t) p1[r] = 0.f; } }
            }
            { const bf16_t* vbase = Vb + (4 * hi + tq) * KP + 16 * tb + 4 * tp;
#pragma unroll
              for (int blk = 0; blk < 2; ++blk)
#pragma unroll
                for (int s = 0; s < 2; ++s) {
                    const bf16x8 pf = blk ? PACK8(p1, 8 * s) : PACK8(p0, 8 * s);
                    const bf16_t* vp = vbase + (blk * 32 + 16 * s) * KP;
                    const s16x4 a0 = vtr(vp), a1 = vtr(vp + 8 * KP), b0 = vtr(vp + 32), b1 = vtr(vp + 8 * KP + 32);
                    o0 = MFMA32(pf, __builtin_shufflevector(a0, a1, 0, 1, 2, 3, 4, 5, 6, 7), o0);
                    o1 = MFMA32(pf, __builtin_shufflevector(b0, b1, 0, 1, 2, 3, 4, 5, 6, 7), o1);
                } }
        }
        if (MODE == 2 && wave < 4) {
            const bf16_t* ka_base = Kb + (8 * hi + tq) * KP + 32 * (wave & 1) + 16 * tb + 4 * tp;
            const bf16_t* vb_base = Vd + (8 * hi + tq) * KP + 32 * (wave >> 1) + 16 * tb + 4 * tp;
#pragma unroll
            for (int ks = 0; ks < 4; ++ks) {
                const s16x4 a0 = vtr(ka_base + (16 * ks) * KP), a1 = vtr(ka_base + (16 * ks + 4) * KP), v0 = vtr(vb_base + (16 * ks) * KP), v1 = vtr(vb_base + (16 * ks + 4) * KP);
                sacc = MFMA32(__builtin_shufflevector(a0, a1, 0, 1, 2, 3, 4, 5, 6, 7), __builtin_shufflevector(v0, v1, 0, 1, 2, 3, 4, 5, 6, 7), sacc);
            }
        }
      }
    }
    u32x2 gts[8];
#pragma unroll
    for (int i = 0; i < 8; ++i) gts[i] = *(const u32x2*)(base + GOFF + (size_t)(qw0 + i * 4 + (lane >> 4)) * 64 + (lane & 15) * 4);
    if (MODE == 0) {
        lsum += __shfl_xor(lsum, 32);
        if (hi == 0) wsf[r32] = 1.f / lsum;
        __builtin_amdgcn_wave_barrier();
    }
#pragma unroll
    for (int g = 0; g < 4; ++g) {
        f32x4 a = {1.f, 1.f, 1.f, 1.f};
        if (MODE == 0) a = *(const f32x4*)(wsf + 8 * g + 4 * hi);
#pragma unroll
        for (int j = 0; j < 4; ++j) { const int row = 8 * g + 4 * hi + j; stg[row * SP + r32] = o0[4 * g + j] * a[j]; stg[row * SP + 32 + r32] = o1[4 * g + j] * a[j]; }
    }
    __builtin_amdgcn_wave_barrier();
    bf16_t* Y = (bf16_t*)(P.ws + WS_Y) + ((size_t)b * SEQ + qw0) * DM + hh * 64;
    const float* gg = P.gn_gain + l * (HR * 64) + (MODE == 2 ? (hh - HF) * 64 : 0);
#pragma unroll
    for (int i = 0; i < 8; ++i) {
        const int row = i * 4 + (lane >> 4), ch = lane & 15;
        f32x4 ov = *(const f32x4*)(stg + row * SP + ch * 4);
        if (MODE == 2) {
            float s = (ov[0] + ov[1]) + (ov[2] + ov[3]);
            s += __shfl_xor(s, 1); s += __shfl_xor(s, 2); s += __shfl_xor(s, 4); s += __shfl_xor(s, 8);
            const float mu = s * (1.f / 64.f); ov = ov - mu;
            float v2 = (ov[0] * ov[0] + ov[1] * ov[1]) + (ov[2] * ov[2] + ov[3] * ov[3]);
            v2 += __shfl_xor(v2, 1); v2 += __shfl_xor(v2, 2); v2 += __shfl_xor(v2, 4); v2 += __shfl_xor(v2, 8);
            const float rs = rsqrtf(v2 * (1.f / 64.f) + GN_EPS); const f32x4 gv = *(const f32x4*)(gg + ch * 4);
            ov = ov * rs * gv;
        }
        const u32x2 gt = gts[i];
        const float g0 = bflo(gt.x), g1 = bfhi(gt.x), g2 = bflo(gt.y), g3 = bfhi(gt.y);
        u32x2 w; w.x = cvtpk(ov[0] * g0 / (1.f + __expf(-g0)), ov[1] * g1 / (1.f + __expf(-g1))); w.y = cvtpk(ov[2] * g2 / (1.f + __expf(-g2)), ov[3] * g3 / (1.f + __expf(-g3)));
        *(u32x2*)(Y + (size_t)row * DM + ch * 4) = w;
    }
    if (MODE == 2 && wave < 4 && qb < 7) {
        bf16_t* sp = St + (32 * (wave >> 1) + r32) * KP + 32 * (wave & 1) + 4 * hi;
#pragma unroll
        for (int g = 0; g < 4; ++g) { u32x2 w; w.x = cvtpk(sacc[4 * g], sacc[4 * g + 1]); w.y = cvtpk(sacc[4 * g + 2], sacc[4 * g + 3]); *(u32x2*)(sp + 8 * g) = w; }
    }
  }
}

__device__ __forceinline__ void mixer_phase(const Params& P, int l, unsigned char* lds, int slot, int tmask = 7) {
    unsigned* ctr = (unsigned*)(P.ws + WS_CTR) + 16 * slot;
    volatile int* qw = (volatile int*)(lds + L_QW);
    int nxt = 0;
    if (threadIdx.x == 0) nxt = (int)atomicAdd(ctr, 1u);
    for (;;) {
        __syncthreads();
        if (threadIdx.x == 0) qw[0] = nxt;
        __syncthreads();
        const int u = qw[0];
        if (u >= 96 + 8 * 160) break;
        if (threadIdx.x == 0) nxt = (int)atomicAdd(ctr, 1u);
        if (u < 96) { if (tmask & 2) attn_unit<2>(P, l, u / 6, HF + u % 6, 0, lds); }
        else { const int v = u - 96, qb = 7 - v / 160, idx = v % 160;
            if (idx < 96) { if (tmask & 1) attn_unit<0>(P, l, idx / 6, idx % 6, qb, lds); }
            else { if (tmask & 4) attn_unit<1>(P, l, (idx - 96) / 4, HF + HR + (idx - 96) % 4, qb, lds); } }
    }
    __syncthreads();
}

__device__ __forceinline__ void phase4(const Params& P, int l, unsigned char* lds) {
    int tid = threadIdx.x; asm volatile("" : "+v"(tid));
    const int lane = tid & 63, wave = tid >> 6;
    const int gw = blockIdx.x * 8 + wave, NGW = gridDim.x * 8;
    float* wfs = (float*)lds;
    if (l + 1 < NL) { stage_wf(P, l + 1, wfs); }
    __syncthreads();
    const float* gp = P.ln_gain + l * DM; const float* bp = P.ln_bias + l * DM;
    f32x4 g[4], bb[4];
#pragma unroll
    for (int j = 0; j < 4; ++j) { g[j] = ((const f32x4*)gp)[lane + 64 * j]; bb[j] = ((const f32x4*)bp)[lane + 64 * j]; }
    for (int m = gw; m < MTOK; m += NGW) {
        f32x4* xr = (f32x4*)(P.out + (size_t)m * DM) + lane; f32x4 v[4]; float s = 0.f;
#pragma unroll
        for (int j = 0; j < 4; ++j) { v[j] = xr[64 * j]; s += (v[j].x + v[j].y) + (v[j].z + v[j].w); }
        const float mean = wave_sum(s) * (1.f / DM); float s2 = 0.f;
#pragma unroll
        for (int j = 0; j < 4; ++j) { v[j] = v[j] - mean; s2 += (v[j].x * v[j].x + v[j].y * v[j].y) + (v[j].z * v[j].z + v[j].w * v[j].w); }
        const float rstd = rsqrtf(wave_sum(s2) * (1.f / DM) + LN_EPS);
#pragma unroll
        for (int j = 0; j < 4; ++j) { v[j] = v[j] * rstd * g[j] + bb[j]; xr[64 * j] = v[j]; }
        if (l + 1 < NL) row_emit(v, (bf16_t*)(P.ws + WS_XB) + (size_t)m * DM, wfs, (float*)(P.ws + WS_FLOG) + (size_t)m * 8, lane);
    }
    __syncthreads();
}

#define LAS __attribute__((address_space(3)))
#define XB_TMO      128
#define XB_XCNT(j)  (256  + 64 * (j))
#define XB_XSUB(j)  (1280 + 64 * (j))
#define XB_XGEN(j)  (2304 + 64 * (j))
#define XB_TOP      3328
#define XB_TOPGEN   3392
#define XCD_BAR_WORDS 3456
#define XB_SPIN_CAP (1u << 18)

__device__ __forceinline__ unsigned xb_ld(unsigned* p)              { return __hip_atomic_load(p, __ATOMIC_RELAXED, __HIP_MEMORY_SCOPE_AGENT); }
__device__ __forceinline__ unsigned xb_add(unsigned* p, unsigned v) { return __hip_atomic_fetch_add(p, v, __ATOMIC_RELAXED, __HIP_MEMORY_SCOPE_AGENT); }
__device__ __forceinline__ unsigned xb_xcc_id() { return (unsigned)__builtin_amdgcn_s_getreg((3 << 11) | 20) & 0xFu; }
#define XB_SPIN(cond, bar) do { unsigned _sp = 0; while (cond) { __builtin_amdgcn_s_sleep(1); \
    if ((++_sp & 255u) == 0u) { if (xb_ld(&(bar)[XB_TMO])) break; if (_sp > XB_SPIN_CAP) { atomicAdd(&(bar)[XB_TMO], 1u); break; } } } } while (0)

struct XcdBarrier {
    unsigned* bar; unsigned x;
    volatile LAS unsigned* st;
};

__device__ __forceinline__ XcdBarrier xcd_barrier_post(unsigned* bar, volatile LAS unsigned* st) {
    XcdBarrier b; b.bar = bar; b.x = xb_xcc_id(); b.st = st;
    if (threadIdx.x == 0) (void)xb_add(&bar[XB_XCNT(b.x)], 1u);
    return b;
}
__device__ __forceinline__ void xcd_barrier_complete(unsigned* bar, unsigned x, unsigned& nloc, unsigned& nx) {
    const unsigned G = gridDim.x * gridDim.y * gridDim.z;
    unsigned sum, cnt, mine, sp = 0u;
    for (;;) {
        sum = 0u; cnt = 0u; mine = 0u;
#pragma unroll
        for (unsigned j = 0; j < 16; ++j) { const unsigned c = xb_ld(&bar[XB_XCNT(j)]); sum += c; cnt += (c > 0u) ? 1u : 0u; mine = (j == x) ? c : mine; }
        if (sum == G) break;
        __builtin_amdgcn_s_sleep(1);
        if ((++sp & 255u) == 0u) { if (xb_ld(&bar[XB_TMO])) break; if (sp > XB_SPIN_CAP) { atomicAdd(&bar[XB_TMO], 1u); break; } }
    }
    nloc = mine > 0u ? mine : 1u; nx = cnt > 0u ? cnt : 1u;
}

__device__ __forceinline__ void xcd_barrier(const XcdBarrier& b) {
    asm volatile("s_waitcnt vmcnt(0)" ::: "memory");
    __syncthreads();
    if (threadIdx.x == 0) {
        unsigned* bar = b.bar;
        __builtin_amdgcn_s_waitcnt(0);
        unsigned nloc = b.st[0], nx = b.st[1];
        if (nloc == 0u) { xcd_barrier_complete(bar, b.x, nloc, nx); b.st[0] = nloc; b.st[1] = nx; }
        const unsigned old = xb_add(&bar[XB_XSUB(b.x)], 1u);
        const unsigned gen = old / nloc;
        if (old + 1u == (gen + 1u) * nloc) {
            __builtin_amdgcn_fence(__ATOMIC_RELEASE, "agent");
            asm volatile("s_waitcnt vmcnt(0)" ::: "memory");
            const unsigned og = xb_add(&bar[XB_TOP], 1u);
            const unsigned tg = og / nx;
            if (og + 1u == (tg + 1u) * nx) xb_add(&bar[XB_TOPGEN], 1u);
            else XB_SPIN(xb_ld(&bar[XB_TOPGEN]) == tg, bar);
            __builtin_amdgcn_fence(__ATOMIC_ACQUIRE, "agent");
            xb_add(&bar[XB_XGEN(b.x)], 1u);
            asm volatile("s_waitcnt vmcnt(0)" ::: "memory");
        } else {
            XB_SPIN(xb_ld(&bar[XB_XGEN(b.x)]) == gen, bar);
            __builtin_amdgcn_fence(__ATOMIC_ACQUIRE, "agent");
            asm volatile("s_waitcnt vmcnt(0)" ::: "memory");
        }
    }
    __syncthreads();
}


__global__ void __launch_bounds__(512) hybrid_fwd(Params P) {
    extern __shared__ __attribute__((aligned(16))) unsigned char lds[];
    cg::grid_group grid = cg::this_grid();
    unsigned char* ws = P.ws;
    const int lo = P.ph_lo, hi = P.ph_hi;
#define RUN(k) (lo <= (k) && (k) < hi)
    unsigned* gbar = (unsigned*)(ws + WS_CTR) + 4096;
    volatile LAS unsigned* bst = (volatile LAS unsigned*)((LAS unsigned char*)lds + (LDS_BYTES - 16));
    if (threadIdx.x < 2) bst[threadIdx.x] = 0u;
    if (blockIdx.x == 0) for (int i = threadIdx.x; i < XCD_BAR_WORDS; i += 512) gbar[i] = 0u;
    __syncthreads();
    XcdBarrier xb; xb.bar = gbar; xb.x = 0; xb.st = bst;
#define SEAM(k) do { if (RUN(k) && RUN((k) + 1)) { if ((k) == 0) { grid.sync(); xb = xcd_barrier_post(gbar, bst); } else xcd_barrier(xb); } } while (0)
    if (RUN(0)) phase0(P, lds);
    SEAM(0);
#pragma unroll
    for (int l = 0; l < NL; ++l) {
        if (RUN(1 + 4 * l)) {
          fgate_cumsum(P, l);
          pg8::Gemm g{(const bf16_t*)(ws + WS_XB), (const bf16_t*)(ws + WS_WIN) + (size_t)l * NQ * DM, MTOK, NQ, DM};
          pg8::StaticOrder S; S.init(MTOK, NQ, (int)gridDim.x, (int)blockIdx.x);
          pg8::EpiInProj E{(bf16_t*)(ws + WS_QKVG), (const float*)(ws + WS_ROPE)};
          pg8::gemm_phase<pg8::EpiInProj, pg8::StaticOrder, true, true>((PG8_LAS unsigned char*)lds, g, S, E);
#ifdef PROBE_GEMM2
          xcd_barrier(xb); pg8::gemm_phase<pg8::EpiInProj, pg8::StaticOrder, true, true>((PG8_LAS unsigned char*)lds, g, S, E);
#endif
        }
        SEAM(1 + 4 * l);
        if (RUN(2 + 4 * l)) { mixer_phase(P, l, lds, l);
#ifdef PROBE_MIX2
            xcd_barrier(xb); mixer_phase(P, l, lds, 2 + l, PROBE_MIX2);
#endif
        }
        SEAM(2 + 4 * l);
        if (RUN(3 + 4 * l)) {
          pg8::Gemm g{(const bf16_t*)(ws + WS_Y), (const bf16_t*)(ws + WS_WOUT) + (size_t)l * DM * DM, MTOK, DM, DM};
          pg8::StaticOrder S; S.init(MTOK, DM, (int)gridDim.x, (int)blockIdx.x);
          pg8::EpiResid E{l == 0 ? P.x : P.out, P.out, DM, DN_ALPHA};
          pg8::gemm_phase<pg8::EpiResid, pg8::StaticOrder, true, true>((PG8_LAS unsigned char*)lds, g, S, E); }
        SEAM(3 + 4 * l);
        if (RUN(4 + 4 * l)) phase4(P, l, lds);
        SEAM(4 + 4 * l);
    }
#ifdef PROBE_SYNC
    for (int i = 0; i < 20; ++i) xcd_barrier(xb);
#endif
#undef RUN
#undef SEAM
}

extern "C" void kernel_launch(void* const* d_in, const int* in_sizes, int n_in, void* d_out, int out_size, void* d_ws, size_t ws_size, hipStream_t stream) {
    static int grid_blocks = 0;
    if (grid_blocks == 0) {
        if (n_in != 7 || out_size != MTOK * DM || ws_size < WS_END) { fprintf(stderr, "kernel_launch: unexpected shapes (n_in %d out %d ws %zu)\n", n_in, out_size, ws_size); grid_blocks = -1; return; }
        int dev = 0, cus = 0, per_cu = 0;
        (void)hipGetDevice(&dev);
        (void)hipDeviceGetAttribute(&cus, hipDeviceAttributeMultiprocessorCount, dev);
        if (hipFuncSetAttribute((const void*)hybrid_fwd, hipFuncAttributeMaxDynamicSharedMemorySize, LDS_BYTES) != hipSuccess) { fprintf(stderr, "kernel_launch: hipFuncSetAttribute failed\n"); grid_blocks = -1; return; }
        if (hipOccupancyMaxActiveBlocksPerMultiprocessor(&per_cu, (const void*)hybrid_fwd, 512, LDS_BYTES) != hipSuccess || per_cu < 1) { fprintf(stderr, "kernel_launch: occupancy query failed (%d)\n", per_cu); per_cu = 1; (void)hipGetLastError(); }
        grid_blocks = cus * per_cu;
    }
    if (grid_blocks < 0) return;
    Params p{};
    p.x = (const float*)d_in[0]; p.w_in = (const float*)d_in[1]; p.b_fgate = (const float*)d_in[2]; p.gn_gain = (const float*)d_in[3];
    p.w_out = (const float*)d_in[4]; p.ln_gain = (const float*)d_in[5]; p.ln_bias = (const float*)d_in[6];
    p.out = (float*)d_out; p.ws = (unsigned char*)d_ws;
    p.ph_lo = 0; p.ph_hi = 9;
    void* args[] = {&p};
    hipError_t e = hipLaunchCooperativeKernel((const void*)hybrid_fwd, dim3(grid_blocks), dim3(512), args, LDS_BYTES, stream);
    if (e != hipSuccess) fprintf(stderr, "cooperative launch failed: %s (grid %d)\n", hipGetErrorString(e), grid_blocks);
}
```

```cpp
#include <hip/hip_runtime.h>
#include <hip/hip_cooperative_groups.h>
#include <cstdio>
#include <cstdint>
#include <cmath>
namespace cg = cooperative_groups;
namespace pg8 {
#define PG8_LAS __attribute__((address_space(3)))
typedef unsigned short bf16_t;
typedef short bf16x8 __attribute__((ext_vector_type(8)));
typedef float f32x4 __attribute__((ext_vector_type(4)));
typedef unsigned u32x4 __attribute__((ext_vector_type(4)));
constexpr int BM = 256, BK = 64, HALF = 128, HTB = HALF * BK * 2  , STAGE_BYTES = 8 * HTB, NXCD = 8, WGM = 8;

__host__ __device__ __forceinline__ int lds_byte(int r, int c) { const int st = (r >> 4) * 2 + (c >> 5), rr = r & 15, cc = c & 31, ob = rr * 64 + cc * 2; return st * 1024 + (ob ^ (((ob >> 9) & 1) << 5)); }
__host__ __device__ __forceinline__ void stage_rc(int b, int& R, int& C) { const int st = b / 1024, sb = b % 1024, swz = sb ^ (((sb >> 9) & 1) << 5); R = (st >> 1) * 16 + swz / 64; C = (st & 1) * 32 + (swz % 64) / 2; }
__host__ __device__ __forceinline__ int perm32(int rho) { const int n = rho >> 4, i = rho & 15; return 8 * (i >> 2) + 4 * n + (i & 3); }

struct Unit { int pm, pn; };
struct Gemm { const bf16_t* A; const bf16_t* Bt; int M, N, K; };

struct StaticOrder {
    int nM, nN, nwg, G, c;
    __host__ __device__ void init(int M, int N, int G_, int c_) { nM = M / BM; nN = N / BM; nwg = nM * nN; G = G_; c = c_; }
    __host__ __device__ bool next(int i, Unit& u) const {
        const long L = (long)i * G + c; if (L >= nwg) return false;
        int wgid = (int)L; { const int q = nwg / NXCD, r = nwg % NXCD, xcd = wgid % NXCD, off = wgid / NXCD; wgid = (xcd < r ? xcd * (q + 1) : r * (q + 1) + (xcd - r) * q) + off; }
        const int nig = WGM * nN, gid = wgid / nig, fm = gid * WGM, gsz = (nM - fm) < WGM ? (nM - fm) : WGM;
        u.pm = fm + ((wgid % nig) % gsz); u.pn = (wgid % nig) / gsz; return true;
    }
    __device__ __forceinline__ void a_ready(const Unit&) const {}
    __device__ __forceinline__ void done(const Unit&) const {}
};

__device__ __forceinline__ unsigned cvt_pk_bf16(float lo, float hi) { unsigned r; asm volatile("v_cvt_pk_bf16_f32 %0, %1, %2" : "=v"(r) : "v"(lo), "v"(hi)); return r; }
typedef float f32x2 __attribute__((ext_vector_type(2)));
__device__ __forceinline__ f32x2 gelu_pk(f32x2 v) {
    const f32x2 av = __builtin_elementwise_abs(v), d = av * 0.2316418882f + 1.0f;
    f32x2 t; t.x = __builtin_amdgcn_rcpf(d.x); t.y = __builtin_amdgcn_rcpf(d.y);
    f32x2 q = t * 0.5307027145f + (-0.7265760135f); q = q * t + 0.7107068705f; q = q * t + (-0.142248368f); q = q * t + 0.127414796f; q = q * t;
    const f32x2 s = (v * v) * (-0.72134752044f);
    f32x2 e; e.x = __builtin_amdgcn_exp2f(s.x); e.y = __builtin_amdgcn_exp2f(s.y);
    const f32x2 m = v * (q * e), r = v - m;
    f32x2 o; o.x = v.x < 0.f ? m.x : r.x; o.y = v.y < 0.f ? m.y : r.y; return o;
}

template <int ACT  > struct EpiBf16 {
    static constexpr bool PERM = true, AFTER_DRAIN = false; static_assert(ACT == 0 || ACT == 1, "EpiBf16: ACT is 0 (none) or 1 (gelu_pk)");
    bf16_t* O; int ldc; const float* bias; int split_cols; size_t split_stride; float scale0;
    __device__ __forceinline__ void operator()(const f32x4 (&acc)[2][2][4][2], const Unit& u, int wr, int wc, int fr, int fq) const {
        const int row0 = u.pm * BM + wr * 64 + fr; int colt = u.pn * BM; bf16_t* base = O;
        float sc = 1.f; if (split_cols) { const int t = colt / split_cols; base += (size_t)t * split_stride; colt -= t * split_cols; if (t == 0) sc = scale0; }
        const int col0 = colt + wc * 32 + 8 * fq, bcol0 = u.pn * BM + wc * 32 + 8 * fq;
        f32x4 bv[2][2];
#pragma unroll
        for (int bj = 0; bj < 2; ++bj)
#pragma unroll
            for (int n = 0; n < 2; ++n) bv[bj][n] = bias ? *(const f32x4*)(bias + bcol0 + bj * HALF + 4 * n) : (f32x4){0.f, 0.f, 0.f, 0.f};
#pragma unroll
        for (int ai = 0; ai < 2; ++ai)
#pragma unroll
            for (int m = 0; m < 4; ++m) { bf16_t* rowp = base + (size_t)(row0 + ai * HALF + m * 16) * ldc + col0;
#pragma unroll
                for (int bj = 0; bj < 2; ++bj) { f32x4 v0 = acc[ai][bj][m][0] + bv[bj][0], v1 = acc[ai][bj][m][1] + bv[bj][1];
                    if (ACT == 1) { f32x2 a = gelu_pk((f32x2){v0[0], v0[1]}), b = gelu_pk((f32x2){v0[2], v0[3]}), c = gelu_pk((f32x2){v1[0], v1[1]}), d = gelu_pk((f32x2){v1[2], v1[3]});
                        v0 = (f32x4){a.x, a.y, b.x, b.y}; v1 = (f32x4){c.x, c.y, d.x, d.y}; }
                    v0 = v0 * sc; v1 = v1 * sc; u32x4 w; w.x = cvt_pk_bf16(v0[0], v0[1]); w.y = cvt_pk_bf16(v0[2], v0[3]); w.z = cvt_pk_bf16(v1[0], v1[1]); w.w = cvt_pk_bf16(v1[2], v1[3]);
                    *(u32x4*)(rowp + bj * HALF) = w; } }
    }
};
struct EpiResid {
    static constexpr bool PERM = true, AFTER_DRAIN = false;
    const float* res; float* out; int ldc; float alpha; const float* stats; const float* gain; const float* lnb;
    __device__ __forceinline__ void operator()(const f32x4 (&acc)[2][2][4][2], const Unit& u, int wr, int wc, int fr, int fq) const {
        const int row0 = u.pm * BM + wr * 64 + fr; const int col0 = u.pn * BM + wc * 32 + 8 * fq;
        const bool ln = stats != nullptr;
#pragma unroll
        for (int bj = 0; bj < 2; ++bj) {
            f32x4 g0 = {1.f, 1.f, 1.f, 1.f}, g1 = g0, b0 = {0.f, 0.f, 0.f, 0.f}, b1 = b0;
            if (ln) { g0 = *(const f32x4*)(gain + col0 + bj * HALF); g1 = *(const f32x4*)(gain + col0 + bj * HALF + 4); b0 = *(const f32x4*)(lnb + col0 + bj * HALF); b1 = *(const f32x4*)(lnb + col0 + bj * HALF + 4); }
#pragma unroll
            for (int ai = 0; ai < 2; ++ai)
#pragma unroll
                for (int m = 0; m < 4; ++m) { const int row = row0 + ai * HALF + m * 16; const size_t ro = (size_t)row * ldc + col0 + bj * HALF;
                    f32x4 r0 = *(const f32x4*)(res + ro), r1 = *(const f32x4*)(res + ro + 4);
                    if (ln) { const float mean = stats[2 * row], rstd = stats[2 * row + 1]; r0 = (r0 - mean) * rstd * g0 + b0; r1 = (r1 - mean) * rstd * g1 + b1; }
                    const f32x4 v0 = acc[ai][bj][m][0] + r0 * alpha, v1 = acc[ai][bj][m][1] + r1 * alpha;
                    *(f32x4*)(out + ro) = v0; *(f32x4*)(out + ro + 4) = v1; }
        }
    }
};
struct EpiInProj {
    static constexpr bool PERM = true, AFTER_DRAIN = false;
    bf16_t* O; const float* rope;
    __device__ __forceinline__ void operator()(const f32x4 (&acc)[2][2][4][2], const Unit& u, int wr, int wc, int fr, int fq) const {
        const int row0 = u.pm * BM + wr * 64 + fr;
#pragma unroll
        for (int bj = 0; bj < 2; ++bj) {
            const int colg = u.pn * BM + bj * HALF + wc * 32, col0 = colg + 8 * fq, head = colg >> 6;
            const bool isrot = (head >= 6 && head < 12) || (head >= 22 && head < 28);
            const float sc = (head < 6 || (head >= 12 && head < 16)) ? 0.125f * 1.4426950408889634f : (head >= 16 ? 0.125f : 1.f);
            const bool issc = (head < 6 || (head >= 12 && head < 16));
            const int i0 = ((colg & 63) + 8 * fq) >> 1;
#pragma unroll
            for (int ai = 0; ai < 2; ++ai)
#pragma unroll
                for (int m = 0; m < 4; ++m) {
                    const int row = row0 + ai * HALF + m * 16;
                    f32x4 v0 = acc[ai][bj][m][0], v1 = acc[ai][bj][m][1];
                    if (isrot) {
                        const int pos = row & 2047;
                        const f32x4 c = *(const f32x4*)(rope + pos * 32 + i0), s = *(const f32x4*)(rope + 2048 * 32 + pos * 32 + i0);
                        f32x4 w0, w1;
                        w0[0] = (v0[0] * c[0] - v0[1] * s[0]) * sc; w0[1] = (v0[0] * s[0] + v0[1] * c[0]) * sc;
                        w0[2] = (v0[2] * c[1] - v0[3] * s[1]) * sc; w0[3] = (v0[2] * s[1] + v0[3] * c[1]) * sc;
                        w1[0] = (v1[0] * c[2] - v1[1] * s[2]) * sc; w1[1] = (v1[0] * s[2] + v1[1] * c[2]) * sc;
                        w1[2] = (v1[2] * c[3] - v1[3] * s[3]) * sc; w1[3] = (v1[2] * s[3] + v1[3] * c[3]) * sc;
                        v0 = w0; v1 = w1;
                    }
                    if (issc) { v0 = v0 * sc; v1 = v1 * sc; }
                    u32x4 w; w.x = cvt_pk_bf16(v0[0], v0[1]); w.y = cvt_pk_bf16(v0[2], v0[3]); w.z = cvt_pk_bf16(v1[0], v1[1]); w.w = cvt_pk_bf16(v1[2], v1[3]);
                    *(u32x4*)(O + ((size_t)((row >> 11) * 64 + head) * 2048 + (row & 2047)) * 64 + (col0 & 63)) = w;
                }
        }
    }
};
template <class Epi, class Sched, bool ALIGN_EPI = false, bool SP2 = false>
__device__ __forceinline__ void gemm_phase(PG8_LAS unsigned char* lds, const Gemm g, const Sched& S, const Epi& E) {
    int tid = threadIdx.x; asm volatile("" : "+v"(tid));
    const int wid = __builtin_amdgcn_readfirstlane(tid >> 6), lane = tid & 63, wr = wid >> 2, wc = wid & 3, fr = lane & 15, fq = lane >> 4;
    const int K = g.K, nt = K / BK;
    unsigned voffA[2], voffB[2];
#pragma unroll
    for (int i = 0; i < 2; ++i) { int R, C; stage_rc(tid * 16 + i * 8192, R, C); const int Rb = Epi::PERM ? ((R & ~31) + perm32(R & 31)) : R;
        voffA[i] = (unsigned)(R * K + C) * 2u; voffB[i] = (unsigned)(Rb * K + C) * 2u; }
    const size_t kstep = (size_t)(BK * 2);
    const size_t hstep = (size_t)HALF * K * 2;
    const size_t tstep = 2 * hstep;
    const unsigned ldsw = (unsigned)wid * 1024u;
    const int aoff = lds_byte(wr * 64 + fr, fq * 8), boff = lds_byte(wc * 32 + fr, fq * 8);
#define PG8_SA(b, h) (((b) * 2 + (h)) * HTB)
#define PG8_SB(b, h) ((4 + (b) * 2 + (h)) * HTB)
#define PG8_STAGE(bufoff, gbase, voff) do { _Pragma("unroll") for (int _i = 0; _i < 2; ++_i) \
        __builtin_amdgcn_global_load_lds((const unsigned*)((const char*)(gbase) + (voff)[_i]), (PG8_LAS unsigned*)(lds + (bufoff) + ldsw + _i * 8192), 16, 0, 0); } while (0)
#define PG8_LDA(dst, b, h) do { _Pragma("unroll") for (int m = 0; m < 4; ++m) _Pragma("unroll") for (int k = 0; k < 2; ++k) dst[m][k] = *(const PG8_LAS bf16x8*)(lds + PG8_SA(b, h) + aoff + m * 2048 + k * 1024); } while (0)
#define PG8_LDB(dst, b, h) do { _Pragma("unroll") for (int n = 0; n < 2; ++n) _Pragma("unroll") for (int k = 0; k < 2; ++k) dst[n][k] = *(const PG8_LAS bf16x8*)(lds + PG8_SB(b, h) + boff + n * 2048 + k * 1024); } while (0)
#define PG8_MMA(ai, bj, At, Bt) do { __builtin_amdgcn_s_setprio(1); _Pragma("unroll") for (int m = 0; m < 4; ++m) _Pragma("unroll") for (int n = 0; n < 2; ++n) _Pragma("unroll") for (int k = 0; k < 2; ++k) \
        acc[ai][bj][m][n] = __builtin_amdgcn_mfma_f32_16x16x32_bf16(Bt[n][k], At[m][k], acc[ai][bj][m][n], 0, 0, 0); __builtin_amdgcn_s_setprio(0); } while (0)
#define PG8_WAIT_V(n) asm volatile("s_waitcnt vmcnt(" #n ")" ::: "memory")
#define PG8_WAIT_L(n) asm volatile("s_waitcnt lgkmcnt(" #n ")" ::: "memory")
#define PG8_BAR __builtin_amdgcn_s_barrier()
#define PG8_SCHED __builtin_amdgcn_sched_barrier(0)
    Unit cur, nxt; int ui = 0;
    if (!S.next(0, cur)) return;
    f32x4 acc[2][2][4][2];
#pragma unroll
    for (int a = 0; a < 2; ++a)
#pragma unroll
        for (int b = 0; b < 2; ++b)
#pragma unroll
            for (int m = 0; m < 4; ++m)
#pragma unroll
                for (int n = 0; n < 2; ++n) acc[a][b][m][n] = (f32x4){0.f, 0.f, 0.f, 0.f};
    bf16x8 At[4][2], B0[2][2], B1[2][2];
    const char* cA = (const char*)g.A + (size_t)cur.pm * tstep; const char* cB = (const char*)g.Bt + (size_t)cur.pn * tstep;
    S.a_ready(cur);
    if constexpr (SP2) {
        PG8_STAGE(PG8_SB(0, 0), cB, voffB); PG8_STAGE(PG8_SB(0, 1), cB + hstep, voffB); PG8_STAGE(PG8_SA(0, 0), cA, voffA); PG8_STAGE(PG8_SA(0, 1), cA + hstep, voffA);
        if (wr == 1) PG8_BAR;
        PG8_WAIT_V(2); PG8_BAR;
        PG8_STAGE(PG8_SB(1, 0), cB + kstep, voffB); PG8_STAGE(PG8_SA(1, 0), cA + kstep, voffA); PG8_STAGE(PG8_SB(1, 1), cB + hstep + kstep, voffB);
        PG8_WAIT_V(6); PG8_BAR;
    } else {
        PG8_STAGE(PG8_SB(0, 0), cB, voffB); PG8_STAGE(PG8_SA(0, 0), cA, voffA); PG8_STAGE(PG8_SB(0, 1), cB + hstep, voffB); PG8_STAGE(PG8_SA(0, 1), cA + hstep, voffA);
        if (wr == 1) PG8_BAR;
        PG8_WAIT_V(4); PG8_BAR;
        PG8_STAGE(PG8_SB(1, 0), cB + kstep, voffB); PG8_STAGE(PG8_SA(1, 0), cA + kstep, voffA); PG8_STAGE(PG8_SB(1, 1), cB + hstep + kstep, voffB);
        PG8_WAIT_V(6); PG8_BAR;
    }
    for (;;) {
        const bool has_next = S.next(ui + 1, nxt);
        const char* nA = has_next ? (const char*)g.A + (size_t)nxt.pm * tstep : cA; const char* nB = has_next ? (const char*)g.Bt + (size_t)nxt.pn * tstep : cB;
        for (int t = 0; t < nt; t += 2) {
            const bool last = (t == nt - 2);
            const char* a1 = cA + (size_t)(t + 1) * kstep;
            const char* a2 = last ? nA : cA + (size_t)(t + 2) * kstep; const char* b2 = last ? nB : cB + (size_t)(t + 2) * kstep;
            const char* a3 = a2 + kstep; const char* b3 = b2 + kstep;
            if (last && has_next) S.a_ready(nxt);
            if constexpr (SP2) {
            PG8_LDB(B0, 0, 0); PG8_LDB(B1, 0, 1); PG8_SCHED; PG8_LDA(At, 0, 0); PG8_STAGE(PG8_SA(1, 1), a1 + hstep, voffA);
            PG8_WAIT_V(8); PG8_WAIT_L(0); PG8_BAR; PG8_MMA(0, 0, At, B0); PG8_MMA(0, 1, At, B1); PG8_BAR; PG8_SCHED;
            PG8_LDA(At, 0, 1); PG8_STAGE(PG8_SB(0, 0), b2, voffB); PG8_STAGE(PG8_SB(0, 1), b2 + hstep, voffB); PG8_STAGE(PG8_SA(0, 0), a2, voffA);
            PG8_WAIT_V(8); PG8_WAIT_L(0); PG8_BAR; PG8_MMA(1, 0, At, B0); PG8_MMA(1, 1, At, B1); PG8_BAR; PG8_SCHED;
            PG8_LDB(B0, 1, 0); PG8_LDB(B1, 1, 1); PG8_SCHED; PG8_LDA(At, 1, 0); PG8_STAGE(PG8_SA(0, 1), a2 + hstep, voffA);
            PG8_WAIT_V(8); PG8_WAIT_L(0); PG8_BAR; PG8_MMA(0, 0, At, B0); PG8_MMA(0, 1, At, B1); PG8_BAR; PG8_SCHED;
            PG8_LDA(At, 1, 1); PG8_STAGE(PG8_SB(1, 0), b3, voffB); PG8_STAGE(PG8_SB(1, 1), b3 + hstep, voffB); PG8_STAGE(PG8_SA(1, 0), a3, voffA);
            PG8_WAIT_V(8); PG8_WAIT_L(0); PG8_BAR; PG8_MMA(1, 0, At, B0); PG8_MMA(1, 1, At, B1); PG8_BAR; PG8_SCHED;
            } else {
            PG8_LDB(B0, 0, 0); PG8_SCHED; PG8_LDA(At, 0, 0); PG8_STAGE(PG8_SA(1, 1), a1 + hstep, voffA);
            PG8_WAIT_L(8); PG8_BAR; PG8_WAIT_L(0); PG8_MMA(0, 0, At, B0); PG8_BAR; PG8_SCHED;
            PG8_LDB(B1, 0, 1); PG8_STAGE(PG8_SB(0, 0), b2, voffB);
            PG8_BAR; PG8_WAIT_L(0); PG8_MMA(0, 1, At, B1); PG8_BAR;
            PG8_LDA(At, 0, 1); PG8_STAGE(PG8_SA(0, 0), a2, voffA);
            PG8_BAR; PG8_WAIT_L(0); PG8_MMA(1, 0, At, B0); PG8_BAR; PG8_SCHED;
            PG8_STAGE(PG8_SB(0, 1), b2 + hstep, voffB);
            PG8_WAIT_V(6); PG8_BAR; PG8_MMA(1, 1, At, B1); PG8_BAR;
            PG8_LDB(B0, 1, 0); PG8_SCHED; PG8_LDA(At, 1, 0); PG8_STAGE(PG8_SA(0, 1), a2 + hstep, voffA);
            PG8_WAIT_L(8); PG8_BAR; PG8_WAIT_L(0); PG8_MMA(0, 0, At, B0); PG8_BAR; PG8_SCHED;
            PG8_LDB(B1, 1, 1); PG8_STAGE(PG8_SB(1, 0), b3, voffB);
            PG8_BAR; PG8_WAIT_L(0); PG8_MMA(0, 1, At, B1); PG8_BAR;
            PG8_LDA(At, 1, 1); PG8_STAGE(PG8_SA(1, 0), a3, voffA);
            PG8_BAR; PG8_WAIT_L(0); PG8_MMA(1, 0, At, B0); PG8_BAR; PG8_SCHED;
            PG8_STAGE(PG8_SB(1, 1), b3 + hstep, voffB);
            PG8_WAIT_V(6); PG8_BAR; PG8_MMA(1, 1, At, B1); PG8_BAR;
            }
        }
        if constexpr (ALIGN_EPI) { if (wr == 0) PG8_BAR; }
        if constexpr (!Epi::AFTER_DRAIN) { E(acc, cur, wr, wc, fr, fq); S.done(cur); }
        if (!has_next) break;
#pragma unroll
        for (int a = 0; a < 2; ++a)
#pragma unroll
            for (int b = 0; b < 2; ++b)
#pragma unroll
                for (int m = 0; m < 4; ++m)
#pragma unroll
                    for (int n = 0; n < 2; ++n) acc[a][b][m][n] = (f32x4){0.f, 0.f, 0.f, 0.f};
        cur = nxt; cA = nA; cB = nB; ++ui;
        if constexpr (ALIGN_EPI) { if (wr == 1) PG8_BAR; }
    }
    PG8_WAIT_V(0);
    if constexpr (!ALIGN_EPI) { if (wr == 0) PG8_BAR; }
    PG8_BAR;
    if constexpr (Epi::AFTER_DRAIN) { E.fused(acc, cur, wr, wc, fr, fq, lds, wid, lane); S.done(cur); }
#undef PG8_SA
#undef PG8_SB
#undef PG8_STAGE
#undef PG8_LDA
#undef PG8_LDB
#undef PG8_MMA
#undef PG8_WAIT_V
#undef PG8_WAIT_L
#undef PG8_BAR
#undef PG8_SCHED
}
}

#ifndef MIX_MASK
#define MIX_MASK 7
#endif
#define NAIVE_MIX (MIX_MASK != 7)
constexpr int NB = 16, SEQ = 2048, DM = 1024, MTOK = NB * SEQ, NQ = 4096, DIN = 4102, NL = 2;
constexpr int HF = 6, HR = 6, HS = 4, HD = 64;
constexpr float LN_EPS = 1e-5f, GN_EPS = 1e-5f;
constexpr float DN_ALPHA = 1.4142135623730951f;
constexpr float LOG2E = 1.4426950408889634f;
typedef unsigned short bf16_t;
typedef float f32x4 __attribute__((ext_vector_type(4)));
typedef unsigned u32x4 __attribute__((ext_vector_type(4)));
typedef unsigned u32x2 __attribute__((ext_vector_type(2)));

constexpr size_t MiB = 1u << 20;
constexpr size_t WS_QKVG = 0;
constexpr size_t WS_Y    = 256 * MiB;
constexpr size_t WS_XB   = 320 * MiB;
constexpr size_t WS_WIN  = 384 * MiB;
constexpr size_t WS_WOUT = 400 * MiB;
constexpr size_t WS_FLOG = 404 * MiB;
constexpr size_t WS_C    = 405 * MiB;
constexpr size_t WS_ROPE = 406 * MiB;
constexpr size_t WS_CTR  = 407 * MiB;
constexpr size_t WS_STATS = 408 * MiB;
constexpr size_t WS_END  = 409 * MiB;

constexpr int LDS_BYTES = 147456;

struct Params {
    const float *x, *w_in, *b_fgate, *gn_gain, *w_out, *ln_gain, *ln_bias;
    float* out; unsigned char* ws;
    int ph_lo, ph_hi;
};

__device__ __forceinline__ unsigned f2bf(float f) { unsigned u = __builtin_bit_cast(unsigned, f); return (u + 0x7fffu + ((u >> 16) & 1u)) >> 16; }
__device__ __forceinline__ unsigned pk2(float lo, float hi) { return f2bf(lo) | (f2bf(hi) << 16); }
__device__ __forceinline__ float bflo(unsigned u) { return __builtin_bit_cast(float, u << 16); }
__device__ __forceinline__ float bfhi(unsigned u) { return __builtin_bit_cast(float, u & 0xffff0000u); }
__device__ __forceinline__ float wave_sum(float v) {
#pragma unroll
    for (int o = 1; o < 64; o <<= 1) v += __shfl_xor(v, o);
    return v;
}
__device__ __forceinline__ float logsig_acc(float z) { return fminf(z, 0.f) - log1pf(expf(-fabsf(z))); }

__device__ __forceinline__ int rowmap_in(int n) {
    const bool r = (n >= 384 && n < 768) || (n >= 1408 && n < 1792); const int d = n & 63; return r ? (n & ~63) + ((d & 31) << 1) + (d >> 5) : n;
}
template <bool MAP> __device__ __forceinline__ void transpose_item(const float* W, int ldw, int K, bf16_t* WT, float* scr, int kb, int nb, int lane) {
    const int k0 = 64 * kb, n0 = 32 * nb;
#pragma unroll 8
    for (int i = 0; i < 32; ++i) { const int kk = 2 * i + (lane >> 5); scr[kk * 33 + (lane & 31)] = W[(size_t)(k0 + kk) * ldw + n0 + (lane & 31)]; }
    __builtin_amdgcn_wave_barrier(); asm volatile("s_waitcnt lgkmcnt(0)" ::: "memory");
    const int c = lane & 7;
#pragma unroll
    for (int j = 0; j < 4; ++j) { const int n = (lane >> 3) + 8 * j; const float* s = scr + (8 * c) * 33 + n;
        u32x4 o; o.x = pk2(s[0 * 33], s[1 * 33]); o.y = pk2(s[2 * 33], s[3 * 33]); o.z = pk2(s[4 * 33], s[5 * 33]); o.w = pk2(s[6 * 33], s[7 * 33]);
        const int nr = MAP ? rowmap_in(n0 + n) : (n0 + n); *(u32x4*)(WT + (size_t)nr * K + k0 + 8 * c) = o; }
    __builtin_amdgcn_wave_barrier(); asm volatile("s_waitcnt lgkmcnt(0)" ::: "memory");
}

__device__ __forceinline__ void stage_wf(const Params& P, int l, float* wfs) {
    for (int i = threadIdx.x; i < 6 * 1024; i += 512) { const int k = i / 6, h = i % 6; wfs[h * 1024 + k] = P.w_in[((size_t)l * DM + k) * DIN + NQ + h]; }
}
__device__ __forceinline__ void row_emit(const f32x4 (&v)[4], bf16_t* xbrow, const float* wfs, float* flogrow, const float* bias6, int lane) {
#pragma unroll
    for (int j = 0; j < 4; ++j) { u32x2 o; o.x = pk2(v[j].x, v[j].y); o.y = pk2(v[j].z, v[j].w); ((u32x2*)xbrow)[lane + 64 * j] = o; }
    float a0 = 0.f, a1 = 0.f, a2 = 0.f, a3 = 0.f, a4 = 0.f, a5 = 0.f;
#pragma unroll
    for (int j = 0; j < 4; ++j) {
        const float* wp = wfs + 4 * lane + 256 * j;
        f32x4 w;
        w = *(const f32x4*)(wp);          a0 += v[j].x * w.x + v[j].y * w.y + v[j].z * w.z + v[j].w * w.w;
        w = *(const f32x4*)(wp + 1024);   a1 += v[j].x * w.x + v[j].y * w.y + v[j].z * w.z + v[j].w * w.w;
        w = *(const f32x4*)(wp + 2048);   a2 += v[j].x * w.x + v[j].y * w.y + v[j].z * w.z + v[j].w * w.w;
        w = *(const f32x4*)(wp + 3072);   a3 += v[j].x * w.x + v[j].y * w.y + v[j].z * w.z + v[j].w * w.w;
        w = *(const f32x4*)(wp + 4096);   a4 += v[j].x * w.x + v[j].y * w.y + v[j].z * w.z + v[j].w * w.w;
        w = *(const f32x4*)(wp + 5120);   a5 += v[j].x * w.x + v[j].y * w.y + v[j].z * w.z + v[j].w * w.w;
    }
    a0 = wave_sum(a0); a1 = wave_sum(a1); a2 = wave_sum(a2); a3 = wave_sum(a3); a4 = wave_sum(a4); a5 = wave_sum(a5);
    float r = a0; if (lane == 1) r = a1; if (lane == 2) r = a2; if (lane == 3) r = a3; if (lane == 4) r = a4; if (lane == 5) r = a5;
    if (lane < 6) flogrow[lane] = logsig_acc(r + bias6[lane]);
}

__device__ __forceinline__ void phase0(const Params& P, unsigned char* lds) {
    int tid = threadIdx.x; asm volatile("" : "+v"(tid));
    const int lane = tid & 63, wave = tid >> 6;
    const int gw = blockIdx.x * 8 + wave, NGW = gridDim.x * 8;
    unsigned char* ws = P.ws;
    float* scr = (float*)lds + wave * (64 * 33);
    float* wfs = (float*)(lds + 8 * 64 * 33 * 4);
    stage_wf(P, 0, wfs);
    constexpr int I_IN = (DM / 64) * (NQ / 32), I_OUT = (DM / 64) * (DM / 32);
    for (int it = gw; it < NL * (I_IN + I_OUT); it += NGW) {
        int r = it; const int l = r / (I_IN + I_OUT); r -= l * (I_IN + I_OUT);
        if (r < I_IN) transpose_item<true>(P.w_in + (size_t)l * DM * DIN, DIN, DM, (bf16_t*)(ws + WS_WIN) + (size_t)l * NQ * DM, scr, r / (NQ / 32), r % (NQ / 32), lane);
        else { r -= I_IN; transpose_item<false>(P.w_out + (size_t)l * DM * DM, DM, DM, (bf16_t*)(ws + WS_WOUT) + (size_t)l * DM * DM, scr, r / (DM / 32), r % (DM / 32), lane); }
    }
    for (int i = blockIdx.x * 512 + tid; i < SEQ * 32; i += gridDim.x * 512) {
        const int pos = i >> 5, f = i & 31; const float invf = (float)(1.0 / exp2((double)f * (13.287712379549449 / 32.0))); const float ang = (float)pos * invf;
        const double t = (double)ang * 0.15915494309189535; const float fr = (float)(t - floor(t));
        ((float*)(ws + WS_ROPE))[i] = __builtin_amdgcn_cosf(fr); ((float*)(ws + WS_ROPE))[SEQ * 32 + i] = __builtin_amdgcn_sinf(fr);
    }
    __syncthreads();
    for (int m = gw; m < MTOK; m += NGW) {
        const f32x4* xr = (const f32x4*)(P.x + (size_t)m * DM) + lane; f32x4 v[4];
#pragma unroll
        for (int j = 0; j < 4; ++j) v[j] = xr[64 * j];
        row_emit(v, (bf16_t*)(ws + WS_XB) + (size_t)m * DM, wfs, (float*)(ws + WS_FLOG) + (size_t)m * 8, P.b_fgate, lane);
    }
    __syncthreads();
}

__device__ __forceinline__ void fgate_cumsum(const Params& P, int l, unsigned char* lds) {
    if (blockIdx.x >= NB * HF) return;
    int tid = threadIdx.x; asm volatile("" : "+v"(tid));
    const int lane = tid & 63, wave = tid >> 6;
    const int b = blockIdx.x / HF, h = blockIdx.x % HF;
    const float* fl = (const float*)(P.ws + WS_FLOG) + ((size_t)b * SEQ + 4 * tid) * 8 + h;
    float v0 = fl[0], v1 = v0 + fl[8], v2 = v1 + fl[16], v3 = v2 + fl[24];
    float incl = v3;
#pragma unroll
    for (int o = 1; o < 64; o <<= 1) { const float t = __shfl_up(incl, o); if (lane >= o) incl += t; }
    float* tot = (float*)lds;
    if (lane == 63) tot[wave] = incl;
    __syncthreads();
    float base = incl - v3;
#pragma unroll
    for (int w = 0; w < 7; ++w) if (w < wave) base += tot[w];
    *(f32x4*)((float*)(P.ws + WS_C) + (size_t)(b * HF + h) * SEQ + 4 * tid) = (f32x4){v0 + base, v1 + base, v2 + base, v3 + base};
    __syncthreads();
}

typedef short bf16x8 __attribute__((ext_vector_type(8)));
typedef short s16x4 __attribute__((ext_vector_type(4)));
typedef float f32x16 __attribute__((ext_vector_type(16)));
typedef float f32x2_t __attribute__((ext_vector_type(2)));
typedef __bf16 bf16x2_t __attribute__((ext_vector_type(2)));
__device__ __forceinline__ unsigned cvtpk(float lo, float hi) { f32x2_t v = {lo, hi}; bf16x2_t b = __builtin_convertvector(v, bf16x2_t); return __builtin_bit_cast(unsigned, b); }
#define PACK8(P, B) __builtin_bit_cast(bf16x8, (u32x4){cvtpk(P[B], P[B + 1]), cvtpk(P[B + 2], P[B + 3]), cvtpk(P[B + 4], P[B + 5]), cvtpk(P[B + 6], P[B + 7])})
#define MFMA32(a, b, c) __builtin_amdgcn_mfma_f32_32x32x16_bf16((a), (b), (c), 0, 0, 0)
typedef short v4i16_t __attribute__((ext_vector_type(4)));
__device__ __forceinline__ s16x4 vtr(const bf16_t* p) { return __builtin_bit_cast(s16x4, __builtin_amdgcn_ds_read_tr16_b64_v4i16((__attribute__((address_space(3))) v4i16_t*)p)); }
__device__ __forceinline__ int crow(int r, int hi) { return (r & 3) + 8 * (r >> 2) + 4 * hi; }
constexpr int KP = 72, VP = 68, SP = 68;
constexpr int L_K = 0, L_V = L_K + 2 * 64 * KP * 2, L_C2 = L_V + 2 * 64 * KP * 2, L_WSF = L_C2 + SEQ * 4, L_STG = L_WSF + 8 * 64 * 4, L_FLG = L_STG + 8 * 32 * SP * 4, L_QW = L_FLG + 64, L_KT = L_QW + 16, L_ST = L_KT + 2 * 64 * KP * 2, L_MIX_END = L_ST + 64 * KP * 2;
static_assert(L_MIX_END <= LDS_BYTES, "mixer LDS map");
constexpr float C2S = 0.125f * 1.4426950408889634f;
#ifndef RS
#define RS 4
#endif
#define TILE_BARRIER() asm volatile("s_waitcnt lgkmcnt(0)\n\ts_barrier" ::: "memory")
constexpr float FOX_THR = 6.f;
constexpr float SB_CUT = -160.f;

template <int MODE> __device__ __forceinline__ void attn_unit(const Params& P, int l, int b, int hh, int qb_arg, unsigned char* lds) {
    int tid = threadIdx.x; asm volatile("" : "+v"(tid));
    const int lane = tid & 63, wave = __builtin_amdgcn_readfirstlane(tid >> 6), r32 = lane & 31, hi = lane >> 5;
    const bf16_t* base = (const bf16_t*)(P.ws + WS_QKVG) + ((size_t)(b * 64 + hh) * SEQ) * 64;
    constexpr size_t KOFF = (size_t)16 * SEQ * 64, VOFF = 2 * KOFF, GOFF = 3 * KOFF;
    bf16_t* Ks = (bf16_t*)(lds + L_K); bf16_t* Vt = (bf16_t*)(lds + L_V); float* c2s = (float*)(lds + L_C2);
    bf16_t* Ktt = (bf16_t*)(lds + L_KT); bf16_t* St = (bf16_t*)(lds + L_ST);
    float* wsf = (float*)(lds + L_WSF) + wave * 64; float* stg = (float*)(lds + L_STG) + wave * (32 * SP);
    const float lg2 = (MODE == 2) ? log2f(1.f - exp2f(-5.f - (float)(hh - HF))) : 0.f;
    f32x16 sacc;
#pragma unroll
    for (int r = 0; r < 16; ++r) sacc[r] = 0.f;
  for (int qb = (MODE == 2 ? 0 : qb_arg); qb <= (MODE == 2 ? 7 : qb_arg); ++qb) {
    const int q0 = qb * 256, qw0 = q0 + wave * 32, t = qw0 + r32;
    const int NT = (MODE == 2) ? 4 : 4 * (qb + 1);
    if (MODE == 2 && qb > 0) __syncthreads();
    float ct2 = 0.f;
    const float* cg_ = (const float*)(P.ws + WS_C) + (size_t)(b * HF + (MODE == 0 ? hh : 0)) * SEQ;
    if (MODE == 0) ct2 = cg_[t] * LOG2E;
    bf16x8 qf[4];
#pragma unroll
    for (int d0 = 0; d0 < 4; ++d0) qf[d0] = *(const bf16x8*)(base + (size_t)t * 64 + d0 * 16 + hi * 8);
    const int lk_key = tid >> 3, lk_ch = tid & 7, lv_key = tid & 63, lv_ch = tid >> 6;
    const bf16_t* kg = base + KOFF + (size_t)lk_key * 64 + lk_ch * 8;
    const bf16_t* vg = base + VOFF + (size_t)lk_key * 64 + lk_ch * 8;
    const int kt0 = (MODE != 2) ? NT - 1 : 4 * qb, kstep = (MODE != 2) ? -1 : 1;
    u32x4 kreg[RS], vreg[RS]; float creg[RS];
#pragma unroll
    for (int u = 0; u < RS; ++u) { creg[u] = 0.f; if (MODE == 0 && tid < 64) creg[u] = cg_[64 * (kt0 + u * kstep) + tid]; kreg[u] = *(const u32x4*)(kg + (size_t)(kt0 + u * kstep) * 64 * 64); vreg[u] = *(const u32x4*)(vg + (size_t)(kt0 + u * kstep) * 64 * 64); }
    const int i16 = lane & 15, tq = i16 >> 2, tp = i16 & 3, tb = (lane >> 4) & 1;
    f32x16 o0, o1;
#pragma unroll
    for (int r = 0; r < 16; ++r) { o0[r] = 0.f; o1[r] = 0.f; }
    if (MODE == 2) {
        if (qb > 0) {
#pragma unroll
            for (int d0 = 0; d0 < 4; ++d0) {
                const bf16x8 s0 = *(const bf16x8*)(St + r32 * KP + d0 * 16 + hi * 8), s1 = *(const bf16x8*)(St + (32 + r32) * KP + d0 * 16 + hi * 8);
                o0 = MFMA32(qf[d0], s0, o0); o1 = MFMA32(qf[d0], s1, o1);
            }
            if (hi == 0) wsf[r32] = __builtin_amdgcn_exp2f((float)(t - q0) * lg2);
            __builtin_amdgcn_wave_barrier();
#pragma unroll
            for (int g = 0; g < 4; ++g) { const f32x4 a = *(const f32x4*)(wsf + 8 * g + 4 * hi);
#pragma unroll
                for (int j = 0; j < 4; ++j) { o0[4 * g + j] *= a[j]; o1[4 * g + j] *= a[j]; } }
            __builtin_amdgcn_wave_barrier();
            if (wave < 4) { const float gC = __builtin_amdgcn_exp2f(256.f * lg2);
#pragma unroll
                for (int r = 0; r < 16; ++r) sacc[r] *= gC; }
        }
    }
    float m_run = 0.f, lsum = 0.f, R = 0.f; bool first = true;
    bool wdone = false;
    volatile int* flg = (volatile int*)(lds + L_FLG);
    bool stop = false;
    for (int it0 = 0; it0 < NT && !stop; it0 += RS) {
#pragma unroll
      for (int u = 0; u < RS; ++u) {
        const int it = it0 + u;
        const int kt = kt0 + kstep * it;
        if (MODE == 1) { if (lane == 0) flg[(it & 1) * 8 + wave] = wdone ? 1 : 0; }
        bf16_t* Kb = Ks + (it & 1) * (64 * KP); bf16_t* Vb = Vt + (it & 1) * (64 * KP); bf16_t* Vd = Ktt + (it & 1) * (64 * KP);
        *(u32x4*)(Kb + lk_key * KP + lk_ch * 8) = kreg[u];
        *(u32x4*)(Vb + lk_key * KP + lk_ch * 8) = vreg[u];
        if (MODE == 0 && tid < 64) c2s[(it & 1) * 64 + tid] = creg[u] * LOG2E;
        if (MODE == 2) {
            const float f = __builtin_amdgcn_exp2f((float)(q0 + 256 - (64 * kt + lk_key)) * lg2); const u32x4 vr = vreg[u]; u32x4 w;
            w.x = cvtpk(bflo(vr.x) * f, bfhi(vr.x) * f); w.y = cvtpk(bflo(vr.y) * f, bfhi(vr.y) * f); w.z = cvtpk(bflo(vr.z) * f, bfhi(vr.z) * f); w.w = cvtpk(bflo(vr.w) * f, bfhi(vr.w) * f);
            *(u32x4*)(Vd + lk_key * KP + lk_ch * 8) = w;
        }
        TILE_BARRIER();
        if (MODE == 1) { int alld = 1;
#pragma unroll
            for (int w = 0; w < 8; ++w) alld &= flg[(it & 1) * 8 + w];
            if (alld) { stop = true; break; } }
        if (it + RS < NT) { if (MODE == 0 && tid < 64) creg[u] = cg_[64 * (kt + RS * kstep) + tid];
            kreg[u] = *(const u32x4*)(kg + (size_t)(kt + RS * kstep) * 64 * 64); vreg[u] = *(const u32x4*)(vg + (size_t)(kt + RS * kstep) * 64 * 64); }
        if (64 * kt <= qw0 + 31 && !(MODE == 1 && wdone)) {
            f32x16 p0, p1;
            const int key0 = 64 * kt + 4 * hi;
            if (MODE == 0) {
                const float* cs = c2s + (it & 1) * 64 + 4 * hi; const float bm = ct2 - m_run;
#pragma unroll
                for (int g = 0; g < 4; ++g) { const f32x4 ca = *(const f32x4*)(cs + 8 * g), cb = *(const f32x4*)(cs + 32 + 8 * g);
#pragma unroll
                    for (int j = 0; j < 4; ++j) { p0[4 * g + j] = bm - ca[j]; p1[4 * g + j] = bm - cb[j]; } }
            } else {
#pragma unroll
                for (int r = 0; r < 16; ++r) { p0[r] = 0.f; p1[r] = 0.f; }
            }
#pragma unroll
            for (int d0 = 0; d0 < 4; ++d0) {
                const bf16x8 ka = *(const bf16x8*)(Kb + r32 * KP + d0 * 16 + hi * 8), kb2 = *(const bf16x8*)(Kb + (32 + r32) * KP + d0 * 16 + hi * 8);
                p0 = MFMA32(ka, qf[d0], p0); p1 = MFMA32(kb2, qf[d0], p1);
            }
            if (MODE == 0) {
                if (64 * kt + 63 > qw0) {
#pragma unroll
                    for (int r = 0; r < 16; ++r) { const int key = key0 + (r & 3) + 8 * (r >> 2); if (key > t) p0[r] = -INFINITY; if (key + 32 > t) p1[r] = -INFINITY; }
                }
                float mx = fmaxf(p0[0], p1[0]);
#pragma unroll
                for (int r = 1; r < 16; ++r) mx = fmaxf(mx, fmaxf(p0[r], p1[r]));
                mx = fmaxf(mx, __shfl_xor(mx, 32));
                if (first || __any(mx > FOX_THR)) {
                    const float delta = first ? mx : fmaxf(mx, 0.f);
                    m_run += delta;
#pragma unroll
                    for (int r = 0; r < 16; ++r) { p0[r] -= delta; p1[r] -= delta; }
                    if (!first) {
                        const float alpha = __builtin_amdgcn_exp2f(-delta);
                        lsum *= alpha;
                        if (hi == 0) wsf[r32] = alpha;
                        __builtin_amdgcn_wave_barrier();
#pragma unroll
                        for (int g = 0; g < 4; ++g) { const f32x4 a = *(const f32x4*)(wsf + 8 * g + 4 * hi);
#pragma unroll
                            for (int j = 0; j < 4; ++j) { o0[4 * g + j] *= a[j]; o1[4 * g + j] *= a[j]; } }
                        __builtin_amdgcn_wave_barrier();
                    }
                    first = false;
                }
                float ps = 0.f;
#pragma unroll
                for (int r = 0; r < 16; ++r) { p0[r] = __builtin_amdgcn_exp2f(p0[r]); p1[r] = __builtin_amdgcn_exp2f(p1[r]); ps += p0[r] + p1[r]; }
                lsum += ps;
            } else if (MODE == 1) {
                const bool diag = (64 * kt + 63 >= qw0);
                if (diag) {
#pragma unroll
                    for (int r = 0; r < 16; ++r) { const int key = key0 + (r & 3) + 8 * (r >> 2); if (key >= t) p0[r] = -1e30f; if (key + 32 >= t) p1[r] = -1e30f; }
                }
                float lr[32];
#pragma unroll
                for (int r = 0; r < 16; ++r) {
                    const float za = p0[r], zb = p1[r];
                    const float spa = __builtin_amdgcn_logf(1.f + __builtin_amdgcn_exp2f(-fabsf(za))), spb = __builtin_amdgcn_logf(1.f + __builtin_amdgcn_exp2f(-fabsf(zb)));
                    lr[r] = (fminf(za, 0.f) - spa) - za; lr[16 + r] = (fminf(zb, 0.f) - spb) - zb;
                }
                float SI[9]; SI[8] = 0.f;
#pragma unroll
                for (int i = 7; i >= 0; --i) SI[i] = SI[i + 1] + ((lr[4 * i] + lr[4 * i + 1]) + (lr[4 * i + 2] + lr[4 * i + 3]));
                float E[8];
#pragma unroll
                for (int i = 0; i < 8; ++i) { const float snd = hi ? SI[i] : SI[i + 1]; E[i] = SI[i + 1] + __shfl_xor(snd, 32); }
                const float T = SI[0] + __shfl_xor(SI[0], 32);
#pragma unroll
                for (int i = 0; i < 8; ++i) {
                    const float bs = R + E[i];
                    const float w2 = lr[4 * i + 3], w1 = w2 + lr[4 * i + 2], w0 = w1 + lr[4 * i + 1];
                    if (i < 4) { p0[4 * i + 3] = __builtin_amdgcn_exp2f(p0[4 * i + 3] + lr[4 * i + 3] + bs); p0[4 * i + 2] = __builtin_amdgcn_exp2f(p0[4 * i + 2] + lr[4 * i + 2] + bs + w2);
                                 p0[4 * i + 1] = __builtin_amdgcn_exp2f(p0[4 * i + 1] + lr[4 * i + 1] + bs + w1); p0[4 * i + 0] = __builtin_amdgcn_exp2f(p0[4 * i + 0] + lr[4 * i + 0] + bs + w0); }
                    else { const int q = 4 * (i - 4);
                                 p1[q + 3] = __builtin_amdgcn_exp2f(p1[q + 3] + lr[4 * i + 3] + bs); p1[q + 2] = __builtin_amdgcn_exp2f(p1[q + 2] + lr[4 * i + 2] + bs + w2);
                                 p1[q + 1] = __builtin_amdgcn_exp2f(p1[q + 1] + lr[4 * i + 1] + bs + w1); p1[q + 0] = __builtin_amdgcn_exp2f(p1[q + 0] + lr[4 * i + 0] + bs + w0); }
                }
                R += T;
                wdone = __all(R < SB_CUT);
            } else {
                const bool diag = (64 * kt + 63 > qw0);
#pragma unroll
                for (int r = 0; r < 16; ++r) { const int key = key0 + (r & 3) + 8 * (r >> 2);
                    p0[r] *= __builtin_amdgcn_exp2f((float)(t - key) * lg2); p1[r] *= __builtin_amdgcn_exp2f((float)(t - key - 32) * lg2);
                    if (diag) { if (key > t) p0[r] = 0.f; if (key + 32 > t) p1[r] = 0.f; } }
            }
            { const bf16_t* vbase = Vb + (4 * hi + tq) * KP + 16 * tb + 4 * tp;
#pragma unroll
              for (int blk = 0; blk < 2; ++blk)
#pragma unroll
                for (int s = 0; s < 2; ++s) {
                    const bf16x8 pf = blk ? PACK8(p1, 8 * s) : PACK8(p0, 8 * s);
                    const bf16_t* vp = vbase + (blk * 32 + 16 * s) * KP;
                    const s16x4 a0 = vtr(vp), a1 = vtr(vp + 8 * KP), b0 = vtr(vp + 32), b1 = vtr(vp + 8 * KP + 32);
                    o0 = MFMA32(pf, __builtin_shufflevector(a0, a1, 0, 1, 2, 3, 4, 5, 6, 7), o0);
                    o1 = MFMA32(pf, __builtin_shufflevector(b0, b1, 0, 1, 2, 3, 4, 5, 6, 7), o1);
                } }
        }
        if (MODE == 2 && wave < 4) {
            const bf16_t* ka_base = Kb + (8 * hi + tq) * KP + 32 * (wave & 1) + 16 * tb + 4 * tp;
            const bf16_t* vb_base = Vd + (8 * hi + tq) * KP + 32 * (wave >> 1) + 16 * tb + 4 * tp;
#pragma unroll
            for (int ks = 0; ks < 4; ++ks) {
                const s16x4 a0 = vtr(ka_base + (16 * ks) * KP), a1 = vtr(ka_base + (16 * ks + 4) * KP), v0 = vtr(vb_base + (16 * ks) * KP), v1 = vtr(vb_base + (16 * ks + 4) * KP);
                sacc = MFMA32(__builtin_shufflevector(a0, a1, 0, 1, 2, 3, 4, 5, 6, 7), __builtin_shufflevector(v0, v1, 0, 1, 2, 3, 4, 5, 6, 7), sacc);
            }
        }
      }
    }
    u32x2 gts[8];
#pragma unroll
    for (int i = 0; i < 8; ++i) gts[i] = *(const u32x2*)(base + GOFF + (size_t)(qw0 + i * 4 + (lane >> 4)) * 64 + (lane & 15) * 4);
    if (MODE == 0) {
        lsum += __shfl_xor(lsum, 32);
        if (hi == 0) wsf[r32] = 1.f / lsum;
        __builtin_amdgcn_wave_barrier();
    }
#pragma unroll
    for (int g = 0; g < 4; ++g) {
        f32x4 a = {1.f, 1.f, 1.f, 1.f};
        if (MODE == 0) a = *(const f32x4*)(wsf + 8 * g + 4 * hi);
#pragma unroll
        for (int j = 0; j < 4; ++j) { const int row = 8 * g + 4 * hi + j; stg[row * SP + r32] = o0[4 * g + j] * a[j]; stg[row * SP + 32 + r32] = o1[4 * g + j] * a[j]; }
    }
    __builtin_amdgcn_wave_barrier();
    bf16_t* Y = (bf16_t*)(P.ws + WS_Y) + ((size_t)b * SEQ + qw0) * DM + hh * 64;
    const float* gg = P.gn_gain + l * (HR * 64) + (MODE == 2 ? (hh - HF) * 64 : 0);
#pragma unroll
    for (int i = 0; i < 8; ++i) {
        const int row = i * 4 + (lane >> 4), ch = lane & 15;
        f32x4 ov = *(const f32x4*)(stg + row * SP + ch * 4);
        if (MODE == 2) {
            float s = (ov[0] + ov[1]) + (ov[2] + ov[3]);
            s += __shfl_xor(s, 1); s += __shfl_xor(s, 2); s += __shfl_xor(s, 4); s += __shfl_xor(s, 8);
            const float mu = s * (1.f / 64.f); ov = ov - mu;
            float v2 = (ov[0] * ov[0] + ov[1] * ov[1]) + (ov[2] * ov[2] + ov[3] * ov[3]);
            v2 += __shfl_xor(v2, 1); v2 += __shfl_xor(v2, 2); v2 += __shfl_xor(v2, 4); v2 += __shfl_xor(v2, 8);
            const float rs = rsqrtf(v2 * (1.f / 64.f) + GN_EPS); const f32x4 gv = *(const f32x4*)(gg + ch * 4);
            ov = ov * rs * gv;
        }
        const u32x2 gt = gts[i];
        const float g0 = bflo(gt.x), g1 = bfhi(gt.x), g2 = bflo(gt.y), g3 = bfhi(gt.y);
        u32x2 w; w.x = cvtpk(ov[0] * g0 / (1.f + __expf(-g0)), ov[1] * g1 / (1.f + __expf(-g1))); w.y = cvtpk(ov[2] * g2 / (1.f + __expf(-g2)), ov[3] * g3 / (1.f + __expf(-g3)));
        *(u32x2*)(Y + (size_t)row * DM + ch * 4) = w;
    }
    if (MODE == 2 && wave < 4 && qb < 7) {
        bf16_t* sp = St + (32 * (wave >> 1) + r32) * KP + 32 * (wave & 1) + 4 * hi;
#pragma unroll
        for (int g = 0; g < 4; ++g) { u32x2 w; w.x = cvtpk(sacc[4 * g], sacc[4 * g + 1]); w.y = cvtpk(sacc[4 * g + 2], sacc[4 * g + 3]); *(u32x2*)(sp + 8 * g) = w; }
    }
  }
}

__device__ __forceinline__ void mixer_phase(const Params& P, int l, unsigned char* lds, int slot, int tmask = 7) {
    unsigned* ctr = (unsigned*)(P.ws + WS_CTR) + 16 * slot;
    volatile int* qw = (volatile int*)(lds + L_QW);
    int nxt = 0;
    if (threadIdx.x == 0) nxt = (int)atomicAdd(ctr, 1u);
    for (;;) {
        __syncthreads();
        if (threadIdx.x == 0) qw[0] = nxt;
        __syncthreads();
        const int u = qw[0];
        if (u >= 96 + 8 * 160) break;
        if (threadIdx.x == 0) nxt = (int)atomicAdd(ctr, 1u);
        if (u < 96) { if (tmask & 2) attn_unit<2>(P, l, u / 6, HF + u % 6, 0, lds); }
        else { const int v = u - 96, qb = 7 - v / 160, idx = v % 160;
            if (idx < 96) { if (tmask & 1) attn_unit<0>(P, l, idx / 6, idx % 6, qb, lds); }
            else { if (tmask & 4) attn_unit<1>(P, l, (idx - 96) / 4, HF + HR + (idx - 96) % 4, qb, lds); } }
    }
    __syncthreads();
}

__device__ __forceinline__ void phase4(const Params& P, int l, unsigned char* lds) {
    int tid = threadIdx.x; asm volatile("" : "+v"(tid));
    const int lane = tid & 63, wave = tid >> 6;
    const int gw = blockIdx.x * 8 + wave, NGW = gridDim.x * 8;
    float* wfs = (float*)lds;
    if (l + 1 < NL) { stage_wf(P, l + 1, wfs); }
    __syncthreads();
    const float* gp = P.ln_gain + l * DM; const float* bp = P.ln_bias + l * DM;
    f32x4 g[4], bb[4];
#pragma unroll
    for (int j = 0; j < 4; ++j) { g[j] = ((const f32x4*)gp)[lane + 64 * j]; bb[j] = ((const f32x4*)bp)[lane + 64 * j]; }
    for (int m = gw; m < MTOK; m += NGW) {
        f32x4* xr = (f32x4*)(P.out + (size_t)m * DM) + lane; f32x4 v[4]; float s = 0.f;
#pragma unroll
        for (int j = 0; j < 4; ++j) { v[j] = xr[64 * j]; s += (v[j].x + v[j].y) + (v[j].z + v[j].w); }
        const float mean = wave_sum(s) * (1.f / DM); float s2 = 0.f;
#pragma unroll
        for (int j = 0; j < 4; ++j) { v[j] = v[j] - mean; s2 += (v[j].x * v[j].x + v[j].y * v[j].y) + (v[j].z * v[j].z + v[j].w * v[j].w); }
        const float rstd = rsqrtf(wave_sum(s2) * (1.f / DM) + LN_EPS);
#pragma unroll
        for (int j = 0; j < 4; ++j) { v[j] = v[j] * rstd * g[j] + bb[j]; if (l + 1 == NL) xr[64 * j] = v[j]; }
        if (l + 1 < NL) { row_emit(v, (bf16_t*)(P.ws + WS_XB) + (size_t)m * DM, wfs, (float*)(P.ws + WS_FLOG) + (size_t)m * 8, P.b_fgate + (l + 1) * HF, lane);
            if (lane == 0) { ((float*)(P.ws + WS_STATS))[2 * m] = mean; ((float*)(P.ws + WS_STATS))[2 * m + 1] = rstd; } }
    }
    __syncthreads();
}

#define LAS __attribute__((address_space(3)))
#define XB_TMO      128
#define XB_XCNT(j)  (256  + 64 * (j))
#define XB_XSUB(j)  (1280 + 64 * (j))
#define XB_XGEN(j)  (2304 + 64 * (j))
#define XB_TOP      3328
#define XB_TOPGEN   3392
#define XCD_BAR_WORDS 3456
#define XB_SPIN_CAP (1u << 18)

__device__ __forceinline__ unsigned xb_ld(unsigned* p)              { return __hip_atomic_load(p, __ATOMIC_RELAXED, __HIP_MEMORY_SCOPE_AGENT); }
__device__ __forceinline__ unsigned xb_add(unsigned* p, unsigned v) { return __hip_atomic_fetch_add(p, v, __ATOMIC_RELAXED, __HIP_MEMORY_SCOPE_AGENT); }
__device__ __forceinline__ unsigned xb_xcc_id() { return (unsigned)__builtin_amdgcn_s_getreg((3 << 11) | 20) & 0xFu; }
#define XB_SPIN(cond, bar) do { unsigned _sp = 0; while (cond) { __builtin_amdgcn_s_sleep(1); \
    if ((++_sp & 255u) == 0u) { if (xb_ld(&(bar)[XB_TMO])) break; if (_sp > XB_SPIN_CAP) { atomicAdd(&(bar)[XB_TMO], 1u); break; } } } } while (0)

struct XcdBarrier {
    unsigned* bar; unsigned x;
    volatile LAS unsigned* st;
};

__device__ __forceinline__ XcdBarrier xcd_barrier_post(unsigned* bar, volatile LAS unsigned* st) {
    XcdBarrier b; b.bar = bar; b.x = xb_xcc_id(); b.st = st;
    if (threadIdx.x == 0) (void)xb_add(&bar[XB_XCNT(b.x)], 1u);
    return b;
}
__device__ __forceinline__ void xcd_barrier_complete(unsigned* bar, unsigned x, unsigned& nloc, unsigned& nx) {
    const unsigned G = gridDim.x * gridDim.y * gridDim.z;
    unsigned sum, cnt, mine, sp = 0u;
    for (;;) {
        sum = 0u; cnt = 0u; mine = 0u;
#pragma unroll
        for (unsigned j = 0; j < 16; ++j) { const unsigned c = xb_ld(&bar[XB_XCNT(j)]); sum += c; cnt += (c > 0u) ? 1u : 0u; mine = (j == x) ? c : mine; }
        if (sum == G) break;
        __builtin_amdgcn_s_sleep(1);
        if ((++sp & 255u) == 0u) { if (xb_ld(&bar[XB_TMO])) break; if (sp > XB_SPIN_CAP) { atomicAdd(&bar[XB_TMO], 1u); break; } }
    }
    nloc = mine > 0u ? mine : 1u; nx = cnt > 0u ? cnt : 1u;
}

__device__ __forceinline__ void xcd_barrier(const XcdBarrier& b) {
    asm volatile("s_waitcnt vmcnt(0)" ::: "memory");
    __syncthreads();
    if (threadIdx.x == 0) {
        unsigned* bar = b.bar;
        __builtin_amdgcn_s_waitcnt(0);
        unsigned nloc = b.st[0], nx = b.st[1];
        if (nloc == 0u) { xcd_barrier_complete(bar, b.x, nloc, nx); b.st[0] = nloc; b.st[1] = nx; }
        const unsigned old = xb_add(&bar[XB_XSUB(b.x)], 1u);
        const unsigned gen = old / nloc;
        if (old + 1u == (gen + 1u) * nloc) {
            __builtin_amdgcn_fence(__ATOMIC_RELEASE, "agent");
            asm volatile("s_waitcnt vmcnt(0)" ::: "memory");
            const unsigned og = xb_add(&bar[XB_TOP], 1u);
            const unsigned tg = og / nx;
            if (og + 1u == (tg + 1u) * nx) xb_add(&bar[XB_TOPGEN], 1u);
            else XB_SPIN(xb_ld(&bar[XB_TOPGEN]) == tg, bar);
            __builtin_amdgcn_fence(__ATOMIC_ACQUIRE, "agent");
            xb_add(&bar[XB_XGEN(b.x)], 1u);
            asm volatile("s_waitcnt vmcnt(0)" ::: "memory");
        } else {
            XB_SPIN(xb_ld(&bar[XB_XGEN(b.x)]) == gen, bar);
            __builtin_amdgcn_fence(__ATOMIC_ACQUIRE, "agent");
            asm volatile("s_waitcnt vmcnt(0)" ::: "memory");
        }
    }
    __syncthreads();
}


__global__ void __launch_bounds__(512) hybrid_fwd(Params P) {
    extern __shared__ __attribute__((aligned(16))) unsigned char lds[];
    cg::grid_group grid = cg::this_grid();
    unsigned char* ws = P.ws;
    const int lo = P.ph_lo, hi = P.ph_hi;
#define RUN(k) (lo <= (k) && (k) < hi)
    unsigned* gbar = (unsigned*)(ws + WS_CTR) + 4096;
    volatile LAS unsigned* bst = (volatile LAS unsigned*)((LAS unsigned char*)lds + (LDS_BYTES - 16));
    if (threadIdx.x < 2) bst[threadIdx.x] = 0u;
    __syncthreads();
    XcdBarrier xb = xcd_barrier_post(gbar, bst);
    if (hi < 0) grid.sync();
#define SEAM(k) do { if (RUN(k) && RUN((k) + 1)) xcd_barrier(xb); } while (0)
    if (RUN(0)) phase0(P, lds);
    SEAM(0);
#pragma unroll
    for (int l = 0; l < NL; ++l) {
        if (RUN(1 + 4 * l)) {
          fgate_cumsum(P, l, lds);
          pg8::Gemm g{(const bf16_t*)(ws + WS_XB), (const bf16_t*)(ws + WS_WIN) + (size_t)l * NQ * DM, MTOK, NQ, DM};
          pg8::StaticOrder S; S.init(MTOK, NQ, (int)gridDim.x, (int)blockIdx.x);
          pg8::EpiInProj E{(bf16_t*)(ws + WS_QKVG), (const float*)(ws + WS_ROPE)};
          pg8::gemm_phase<pg8::EpiInProj, pg8::StaticOrder, true, true>((PG8_LAS unsigned char*)lds, g, S, E);
#ifdef PROBE_GEMM2
          xcd_barrier(xb); pg8::gemm_phase<pg8::EpiInProj, pg8::StaticOrder, true, true>((PG8_LAS unsigned char*)lds, g, S, E);
#endif
        }
        SEAM(1 + 4 * l);
        if (RUN(2 + 4 * l)) { mixer_phase(P, l, lds, l);
#ifdef PROBE_MIX2
            xcd_barrier(xb); mixer_phase(P, l, lds, 2 + l, PROBE_MIX2);
#endif
        }
        SEAM(2 + 4 * l);
        if (RUN(3 + 4 * l)) {
          pg8::Gemm g{(const bf16_t*)(ws + WS_Y), (const bf16_t*)(ws + WS_WOUT) + (size_t)l * DM * DM, MTOK, DM, DM};
          pg8::StaticOrder S; S.init(MTOK, DM, (int)gridDim.x, (int)blockIdx.x);
          pg8::EpiResid E{l == 0 ? P.x : P.out, P.out, DM, DN_ALPHA, l == 0 ? (const float*)nullptr : (const float*)(ws + WS_STATS), P.ln_gain + (l - 1) * DM, P.ln_bias + (l - 1) * DM};
          pg8::gemm_phase<pg8::EpiResid, pg8::StaticOrder, true, true>((PG8_LAS unsigned char*)lds, g, S, E); }
        SEAM(3 + 4 * l);
        if (RUN(4 + 4 * l)) phase4(P, l, lds);
        SEAM(4 + 4 * l);
    }
#ifdef PROBE_SYNC
    for (int i = 0; i < 20; ++i) xcd_barrier(xb);
#endif
#undef RUN
#undef SEAM
}

extern "C" void kernel_launch(void* const* d_in, const int* in_sizes, int n_in, void* d_out, int out_size, void* d_ws, size_t ws_size, hipStream_t stream) {
    static int grid_blocks = 0;
    if (grid_blocks == 0) {
        if (n_in != 7 || out_size != MTOK * DM || ws_size < WS_END) { fprintf(stderr, "kernel_launch: unexpected shapes (n_in %d out %d ws %zu)\n", n_in, out_size, ws_size); grid_blocks = -1; return; }
        int dev = 0, cus = 0, per_cu = 0;
        (void)hipGetDevice(&dev);
        (void)hipDeviceGetAttribute(&cus, hipDeviceAttributeMultiprocessorCount, dev);
        if (hipFuncSetAttribute((const void*)hybrid_fwd, hipFuncAttributeMaxDynamicSharedMemorySize, LDS_BYTES) != hipSuccess) { fprintf(stderr, "kernel_launch: hipFuncSetAttribute failed\n"); grid_blocks = -1; return; }
        if (hipOccupancyMaxActiveBlocksPerMultiprocessor(&per_cu, (const void*)hybrid_fwd, 512, LDS_BYTES) != hipSuccess || per_cu < 1) { fprintf(stderr, "kernel_launch: occupancy query failed (%d)\n", per_cu); per_cu = 1; (void)hipGetLastError(); }
        grid_blocks = cus * per_cu;
    }
    if (grid_blocks < 0) return;
    Params p{};
    p.x = (const float*)d_in[0]; p.w_in = (const float*)d_in[1]; p.b_fgate = (const float*)d_in[2]; p.gn_gain = (const float*)d_in[3];
    p.w_out = (const float*)d_in[4]; p.ln_gain = (const float*)d_in[5]; p.ln_bias = (const float*)d_in[6];
    p.out = (float*)d_out; p.ws = (unsigned char*)d_ws;
    p.ph_lo = 0; p.ph_hi = 9;
    if (hipMemsetAsync((char*)d_ws + WS_CTR, 0, 65536, stream) != hipSuccess) { fprintf(stderr, "kernel_launch: hipMemsetAsync failed\n"); return; }
    void* args[] = {&p};
    hipError_t e = hipLaunchCooperativeKernel((const void*)hybrid_fwd, dim3(grid_blocks), dim3(512), args, LDS_BYTES, stream);
    if (e != hipSuccess) fprintf(stderr, "cooperative launch failed: %s (grid %d)\n", hipGetErrorString(e), grid_blocks);
}
```
